# Optimizing an MI355X kernel written in HIP

```python
import math
import jax, jax.numpy as jnp
from jax import lax
import numpy as np

D_MODEL = 4096
BATCH = 2
SEQ = 8192
DEPTH = 1

GRID_W = 64
CTX_LEN = 256
D_MIX = D_MODEL
HY_WIDTH = D_MIX // 2
HY_GROUP = 128
HY_ORDER = 2
HY_POS_BANDS = 16
HY_POS_DIM = 1 + 2 * HY_POS_BANDS
HY_FILT_HIDDEN = 64
HY_DECAY_TARGET = 1e-2
HY_FAST_DECAY_PCT = 0.3
HY_SLOW_DECAY_PCT = 1.5
MLA_NOPE = 128
MLA_ROPE = 64
MLA_QK = MLA_NOPE + MLA_ROPE
MLA_V = 128
MLA_HEADS = (D_MIX - HY_WIDTH) // MLA_V
Q_LORA = 1024
KV_LORA = 512
ROPE_THETA = 10000.0
D_FF = 4 * D_MODEL
Q_BLOCK = 128
NORM_EPS = 1e-6
N_MOD = 6
HY_COLS = 3 * HY_WIDTH
IN_COLS = HY_COLS + Q_LORA + KV_LORA + MLA_ROPE

kernel_name = 'hyena_mla_parallel_heads_dit_block'


def rms_norm(x, g):
    xf = x.astype(jnp.float32)
    y = xf * lax.rsqrt(jnp.mean(xf * xf, axis=-1, keepdims=True) + NORM_EPS)
    return (y * g.astype(jnp.float32)).astype(x.dtype)


def modulate(x, g, shift, scale):
    return rms_norm(x, g) * (1.0 + scale) + shift


def adaln_chunks(cvec, w, b, n):
    m = jax.nn.silu(cvec) @ w[:, :n * D_MODEL] + b[:n * D_MODEL]
    return jnp.split(m, n, axis=-1)


def short_conv_centred(u, w, b):
    L = u.shape[1]
    up = jnp.pad(u, ((0, 0), (1, 1), (0, 0)))
    return up[:, :L] * w[0] + up[:, 1:L + 1] * w[1] + up[:, 2:] * w[2] + b


def hyena_filters(L, w1, b1, w2, b2, w3, freq):
    f32 = jnp.float32
    pos = jnp.arange(L, dtype=f32)
    t = jnp.linspace(0.0, 1.0, L, dtype=f32)[:, None]
    bands = jnp.linspace(1e-4, HY_POS_BANDS - 1, HY_POS_BANDS, dtype=f32)
    ang = (2.0 * math.pi / L) * pos[:, None] * bands[None, :]
    feats = jnp.concatenate([t, jnp.cos(ang), -jnp.sin(ang)], axis=-1)
    fr = freq.astype(f32)
    h = jnp.sin(fr * (feats @ w1.astype(f32) + b1.astype(f32)))
    h = jnp.sin(fr * (h @ w2.astype(f32) + b2.astype(f32)))
    filt = (h @ w3.astype(f32)).reshape(L, 2, HY_ORDER, HY_WIDTH)
    deltas = jnp.abs(jnp.linspace(math.log(HY_DECAY_TARGET) / HY_SLOW_DECAY_PCT,
                                  math.log(HY_DECAY_TARGET) / HY_FAST_DECAY_PCT, HY_WIDTH, dtype=f32))
    decay = jnp.exp(-t * deltas[None, :])
    return filt * decay[:, None, None, :]


def bidir_long_conv(u, h_fwd, h_bwd, bias):
    L = u.shape[1]
    k = jnp.concatenate([h_fwd, jnp.zeros_like(h_fwd[:1]), h_bwd[:0:-1]], axis=0)
    k_f = jnp.fft.rfft(k, n=2 * L, axis=0)
    u_f = jnp.fft.rfft(u.astype(jnp.float32), n=2 * L, axis=1)
    y = jnp.fft.irfft(u_f * k_f[None], n=2 * L, axis=1)[:, :L]
    return (y + u.astype(jnp.float32) * bias.astype(jnp.float32)).astype(u.dtype)


def hyena_mixer(hy_in, conv_w, conv_b, filt, hy_bias):
    u = short_conv_centred(hy_in, conv_w, conv_b)
    v, x1, x2 = jnp.split(u, 3, axis=-1)
    z = x1 * bidir_long_conv(v, filt[:, 0, 0], filt[:, 1, 0], hy_bias[0])
    return x2 * bidir_long_conv(z, filt[:, 0, 1], filt[:, 1, 1], hy_bias[1])


def axial_rope_tables(L):
    rows = L // GRID_W
    row = jnp.repeat(jnp.arange(rows, dtype=jnp.float32), GRID_W)
    col = jnp.tile(jnp.arange(GRID_W, dtype=jnp.float32), rows)
    half = MLA_ROPE // 2
    inv = ROPE_THETA ** (-jnp.arange(0, half, 2, dtype=jnp.float32) / half)
    ang = jnp.concatenate([row[:, None] * inv, col[:, None] * inv], axis=-1)
    return jnp.cos(ang), jnp.sin(ang)


def apply_axial_rope(x, cos, sin):
    B, L, H, _ = x.shape
    nf = MLA_ROPE // 4
    xr = x.reshape(B, L, H, 2, 2, nf)
    x1, x2 = xr[..., 0, :], xr[..., 1, :]
    c = cos.reshape(L, 2, nf)[None, :, None]
    s = sin.reshape(L, 2, nf)[None, :, None]
    out = jnp.stack([x1 * c - x2 * s, x1 * s + x2 * c], axis=-2)
    return out.reshape(B, L, H, MLA_ROPE).astype(x.dtype)


def mla_queries(q_a, g_qa, w_qb, q_norm_g, rope):
    B, L, _ = q_a.shape
    q = (rms_norm(q_a, g_qa) @ w_qb).reshape(B, L, MLA_HEADS, MLA_QK)
    q = rms_norm(q, q_norm_g)
    if rope is not None:
        q = jnp.concatenate([q[..., :MLA_NOPE], apply_axial_rope(q[..., MLA_NOPE:], *rope)], axis=-1)
    return q


def mla_keys_values(kv_a, k_rope, g_kva, w_kvb, k_norm_g, rope):
    B, L, _ = kv_a.shape
    kv = (rms_norm(kv_a, g_kva) @ w_kvb).reshape(B, L, MLA_HEADS, MLA_NOPE + MLA_V)
    k_nope, v = kv[..., :MLA_NOPE], kv[..., MLA_NOPE:]
    k_r = jnp.broadcast_to(k_rope[:, :, None, :], (B, L, MLA_HEADS, MLA_ROPE)).astype(k_nope.dtype)
    k = rms_norm(jnp.concatenate([k_nope, k_r], axis=-1), k_norm_g)
    if rope is not None:
        k = jnp.concatenate([k[..., :MLA_NOPE], apply_axial_rope(k[..., MLA_NOPE:], *rope)], axis=-1)
    return k, v


def attend_latent(q, k_lat, v_lat, k_ctx, v_ctx):
    B, L, H, _ = q.shape
    k = jnp.concatenate([k_ctx, k_lat], axis=1)
    v = jnp.concatenate([v_ctx, v_lat], axis=1)
    nblk = L // Q_BLOCK
    qb = q.reshape(B, nblk, Q_BLOCK, H, MLA_QK).transpose(1, 0, 2, 3, 4)
    scale = MLA_QK ** -0.5

    def one_block(qi):
        s = jnp.einsum('bqhd,bkhd->bhqk', qi, k, preferred_element_type=jnp.float32) * scale
        p = jax.nn.softmax(s, axis=-1)
        return jnp.einsum('bhqk,bkhd->bqhd', p.astype(v.dtype), v)

    o = lax.map(one_block, qb)
    return o.transpose(1, 0, 2, 3, 4).reshape(B, L, H * MLA_V)


def attend_ctx(q, k, v):
    B, Lc, H, _ = q.shape
    s = jnp.einsum('bqhd,bkhd->bhqk', q, k, preferred_element_type=jnp.float32) * (MLA_QK ** -0.5)
    p = jax.nn.softmax(s, axis=-1)
    return jnp.einsum('bhqk,bkhd->bqhd', p.astype(v.dtype), v).reshape(B, Lc, H * MLA_V)


def sq_relu_mlp(h, w1, w2):
    return jnp.square(jax.nn.relu(h @ w1)) @ w2


def setup_inputs(seed: int = 0) -> dict:
    key = jax.random.key(seed)
    ks = jax.random.split(key, 32)
    f32 = jnp.float32

    def nrm(k, shape, scale):
        return jax.random.normal(k, shape, dtype=f32) * scale

    def gain(k, shape):
        return 1.0 + 0.01 * jax.random.normal(k, shape, dtype=f32)

    return {
        'x': nrm(ks[0], (BATCH, SEQ, D_MODEL), 1.0),
        'c': nrm(ks[1], (BATCH, D_MODEL), 1.0),
        'ctx': nrm(ks[2], (BATCH, CTX_LEN, D_MODEL), 1.0),
        'c_ctx': nrm(ks[3], (D_MODEL,), 1.0),
        'norm1_g': gain(ks[4], (DEPTH, D_MODEL)),
        'norm2_g': gain(ks[5], (DEPTH, D_MODEL)),
        'w_ada': nrm(ks[6], (DEPTH, D_MODEL, N_MOD * D_MODEL), D_MODEL ** -0.5),
        'b_ada': nrm(ks[7], (DEPTH, N_MOD * D_MODEL), 0.01),
        'w_in': nrm(ks[8], (DEPTH, D_MODEL, IN_COLS), D_MODEL ** -0.5),
        'hy_conv_w': nrm(ks[9], (DEPTH, 3, HY_COLS), 3 ** -0.5),
        'hy_conv_b': nrm(ks[10], (DEPTH, HY_COLS), 0.01),
        'hy_filt_w1': nrm(ks[11], (DEPTH, HY_POS_DIM, HY_FILT_HIDDEN), HY_POS_DIM ** -0.5),
        'hy_filt_b1': nrm(ks[12], (DEPTH, HY_FILT_HIDDEN), 0.1),
        'hy_filt_w2': nrm(ks[13], (DEPTH, HY_FILT_HIDDEN, HY_FILT_HIDDEN), HY_FILT_HIDDEN ** -0.5),
        'hy_filt_b2': nrm(ks[14], (DEPTH, HY_FILT_HIDDEN), 0.1),
        'hy_filt_w3': nrm(ks[15], (DEPTH, HY_FILT_HIDDEN, 2 * HY_ORDER * HY_WIDTH), 0.004),
        'hy_freq': gain(ks[16], (DEPTH, HY_FILT_HIDDEN)),
        'hy_bias': nrm(ks[17], (DEPTH, HY_ORDER, HY_WIDTH), 0.1),
        'mla_g_qa': gain(ks[18], (DEPTH, Q_LORA)),
        'mla_w_qb': nrm(ks[19], (DEPTH, Q_LORA, MLA_HEADS * MLA_QK), Q_LORA ** -0.5),
        'mla_g_kva': gain(ks[20], (DEPTH, KV_LORA)),
        'mla_w_kvb': nrm(ks[21], (DEPTH, KV_LORA, MLA_HEADS * (MLA_NOPE + MLA_V)), KV_LORA ** -0.5),
        'mla_q_norm_g': gain(ks[22], (DEPTH, MLA_QK)),
        'mla_k_norm_g': gain(ks[23], (DEPTH, MLA_QK)),
        'w_out': nrm(ks[24], (DEPTH, D_MIX, D_MODEL), D_MIX ** -0.5),
        'w_mlp1': nrm(ks[25], (DEPTH, D_MODEL, D_FF), D_MODEL ** -0.5),
        'w_mlp2': nrm(ks[26], (DEPTH, D_FF, D_MODEL), D_FF ** -0.5),
    }


def reference(x, c, ctx, c_ctx, norm1_g, norm2_g, w_ada, b_ada, w_in, hy_conv_w, hy_conv_b,
              hy_filt_w1, hy_filt_b1, hy_filt_w2, hy_filt_b2, hy_filt_w3, hy_freq, hy_bias,
              mla_g_qa, mla_w_qb, mla_g_kva, mla_w_kvb, mla_q_norm_g, mla_k_norm_g,
              w_out, w_mlp1, w_mlp2):
    L = x.shape[1]
    Lc = ctx.shape[1]
    rope = axial_rope_tables(L)
    q_end = HY_COLS + Q_LORA
    kv_end = q_end + KV_LORA

    for l in range(DEPTH):
        last = l == DEPTH - 1
        sh1, sc1, g1, sh2, sc2, g2 = [m[:, None, :] for m in adaln_chunks(c, w_ada[l], b_ada[l], N_MOD)]
        n_ctx_mod = 2 if last else N_MOD
        ctx_mod = adaln_chunks(c_ctx, w_ada[l], b_ada[l], n_ctx_mod)

        hc = modulate(ctx, norm1_g[l], ctx_mod[0], ctx_mod[1])
        if last:
            proj_c = hc @ w_in[l][:, HY_COLS:]
            kv_a_c = proj_c[..., Q_LORA:Q_LORA + KV_LORA]
            k_rope_c = proj_c[..., Q_LORA + KV_LORA:]
        else:
            proj_c = hc @ w_in[l]
            kv_a_c = proj_c[..., q_end:kv_end]
            k_rope_c = proj_c[..., kv_end:]
        k_c, v_c = mla_keys_values(kv_a_c, k_rope_c, mla_g_kva[l], mla_w_kvb[l], mla_k_norm_g[l], None)

        h = modulate(x, norm1_g[l], sh1, sc1)
        proj = h @ w_in[l]
        filt = hyena_filters(L, hy_filt_w1[l], hy_filt_b1[l], hy_filt_w2[l], hy_filt_b2[l],
                             hy_filt_w3[l], hy_freq[l])
        y_hy = hyena_mixer(proj[..., :HY_COLS], hy_conv_w[l], hy_conv_b[l], filt, hy_bias[l])
        q = mla_queries(proj[..., HY_COLS:q_end], mla_g_qa[l], mla_w_qb[l], mla_q_norm_g[l], rope)
        k, v = mla_keys_values(proj[..., q_end:kv_end], proj[..., kv_end:], mla_g_kva[l], mla_w_kvb[l],
                               mla_k_norm_g[l], rope)
        y_att = attend_latent(q, k, v, k_c, v_c)
        x_new = x + g1 * (jnp.concatenate([y_hy, y_att], axis=-1) @ w_out[l])
        x_new = x_new + g2 * sq_relu_mlp(modulate(x_new, norm2_g[l], sh2, sc2), w_mlp1[l], w_mlp2[l])

        if not last:
            csh2, csc2, cg1, cg2 = ctx_mod[3], ctx_mod[4], ctx_mod[2], ctx_mod[5]
            filt_c = hyena_filters(Lc, hy_filt_w1[l], hy_filt_b1[l], hy_filt_w2[l], hy_filt_b2[l],
                                   hy_filt_w3[l], hy_freq[l])
            yc_hy = hyena_mixer(proj_c[..., :HY_COLS], hy_conv_w[l], hy_conv_b[l], filt_c, hy_bias[l])
            q_c = mla_queries(proj_c[..., HY_COLS:q_end], mla_g_qa[l], mla_w_qb[l], mla_q_norm_g[l], None)
            yc_att = attend_ctx(q_c, k_c, v_c)
            ctx_new = ctx + cg1 * (jnp.concatenate([yc_hy, yc_att], axis=-1) @ w_out[l])
            ctx = ctx_new + cg2 * sq_relu_mlp(modulate(ctx_new, norm2_g[l], csh2, csc2), w_mlp1[l], w_mlp2[l])
        x = x_new
    return x
```

```cpp
#include <hip/hip_runtime.h>
#include <cstdio>
#include <cstdint>
#ifndef MK_N_LAUNCHES
#define MK_N_LAUNCHES 10
#endif
namespace pg8 {
#define PG8_LAS __attribute__((address_space(3)))
typedef unsigned short bf16_t;
typedef short bf16x8 __attribute__((ext_vector_type(8)));
typedef float f32x4 __attribute__((ext_vector_type(4)));
typedef unsigned u32x4 __attribute__((ext_vector_type(4)));
constexpr int BM = 256, BK = 64, HALF = 128, HTB = HALF * BK * 2  , STAGE_BYTES = 8 * HTB, NXCD = 8, WGM = 8;

__host__ __device__ __forceinline__ int lds_byte(int r, int c) { const int st = (r >> 4) * 2 + (c >> 5), rr = r & 15, cc = c & 31, ob = rr * 64 + cc * 2; return st * 1024 + (ob ^ (((ob >> 9) & 1) << 5)); }
__host__ __device__ __forceinline__ void stage_rc(int b, int& R, int& C) { const int st = b / 1024, sb = b % 1024, swz = sb ^ (((sb >> 9) & 1) << 5); R = (st >> 1) * 16 + swz / 64; C = (st & 1) * 32 + (swz % 64) / 2; }
__host__ __device__ __forceinline__ int perm32(int rho) { const int n = rho >> 4, i = rho & 15; return 8 * (i >> 2) + 4 * n + (i & 3); }

struct Unit { int pm, pn; };
struct Gemm { const bf16_t* A; const bf16_t* Bt; int M, N, K; };

struct StaticOrder {
    int nM, nN, nwg, G, c;
    __host__ __device__ void init(int M, int N, int G_, int c_) { nM = M / BM; nN = N / BM; nwg = nM * nN; G = G_; c = c_; }
    __host__ __device__ bool next(int i, Unit& u) const {
        const long L = (long)i * G + c; if (L >= nwg) return false;
        int wgid = (int)L; { const int q = nwg / NXCD, r = nwg % NXCD, xcd = wgid % NXCD, off = wgid / NXCD; wgid = (xcd < r ? xcd * (q + 1) : r * (q + 1) + (xcd - r) * q) + off; }
        const int nig = WGM * nN, gid = wgid / nig, fm = gid * WGM, gsz = (nM - fm) < WGM ? (nM - fm) : WGM;
        u.pm = fm + ((wgid % nig) % gsz); u.pn = (wgid % nig) / gsz; return true;
    }
    __device__ __forceinline__ void a_ready(const Unit&) const {}
    __device__ __forceinline__ void done(const Unit&) const {}
};

__device__ __forceinline__ unsigned cvt_pk_bf16(float lo, float hi) { unsigned r; asm volatile("v_cvt_pk_bf16_f32 %0, %1, %2" : "=v"(r) : "v"(lo), "v"(hi)); return r; }
typedef float f32x2 __attribute__((ext_vector_type(2)));
template <int ACT> struct EpiBf16A {
    static constexpr bool PERM = true, AFTER_DRAIN = false;
    bf16_t* O; int ldc;
    __device__ __forceinline__ void operator()(const f32x4 (&acc)[2][2][4][2], const Unit& u, int wr, int wc, int fr, int fq) const {
        const int row0 = u.pm * BM + wr * 64 + fr, col0 = u.pn * BM + wc * 32 + 8 * fq;
#pragma unroll
        for (int ai = 0; ai < 2; ++ai)
#pragma unroll
            for (int m = 0; m < 4; ++m) { bf16_t* rowp = O + (size_t)(row0 + ai * HALF + m * 16) * ldc + col0;
#pragma unroll
                for (int bj = 0; bj < 2; ++bj) { f32x4 v0 = acc[ai][bj][m][0], v1 = acc[ai][bj][m][1];
                    if (ACT == 1) {
#pragma unroll
                        for (int j = 0; j < 4; ++j) { const float a = fmaxf(v0[j], 0.f), b = fmaxf(v1[j], 0.f); v0[j] = a * a; v1[j] = b * b; } }
                    u32x4 w; w.x = cvt_pk_bf16(v0[0], v0[1]); w.y = cvt_pk_bf16(v0[2], v0[3]); w.z = cvt_pk_bf16(v1[0], v1[1]); w.w = cvt_pk_bf16(v1[2], v1[3]);
                    *(u32x4*)(rowp + bj * HALF) = w; } }
    }
};
struct EpiAttProj {
    static constexpr bool PERM = true, AFTER_DRAIN = false;
    bf16_t* QA; bf16_t* KVA; float* KR;
    __device__ __forceinline__ void operator()(const f32x4 (&acc)[2][2][4][2], const Unit& u, int wr, int wc, int fr, int fq) const {
        const int row0 = u.pm * BM + wr * 64 + fr;
        if (u.pn < 6) {
            bf16_t* base = u.pn < 4 ? QA : KVA; const int ldc = u.pn < 4 ? 1024 : 512; const int col0 = (u.pn < 4 ? u.pn : u.pn - 4) * BM + wc * 32 + 8 * fq;
#pragma unroll
            for (int ai = 0; ai < 2; ++ai)
#pragma unroll
                for (int m = 0; m < 4; ++m) { bf16_t* rowp = base + (size_t)(row0 + ai * HALF + m * 16) * ldc + col0;
#pragma unroll
                    for (int bj = 0; bj < 2; ++bj) { const f32x4 v0 = acc[ai][bj][m][0], v1 = acc[ai][bj][m][1];
                        u32x4 w; w.x = cvt_pk_bf16(v0[0], v0[1]); w.y = cvt_pk_bf16(v0[2], v0[3]); w.z = cvt_pk_bf16(v1[0], v1[1]); w.w = cvt_pk_bf16(v1[2], v1[3]);
                        *(u32x4*)(rowp + bj * HALF) = w; } }
        } else if (wc < 2) {
            const int col0 = wc * 32 + 8 * fq;
#pragma unroll
            for (int ai = 0; ai < 2; ++ai)
#pragma unroll
                for (int m = 0; m < 4; ++m) { float* rowp = KR + (size_t)(row0 + ai * HALF + m * 16) * 64 + col0;
                    *(f32x4*)(rowp) = acc[ai][0][m][0]; *(f32x4*)(rowp + 4) = acc[ai][0][m][1]; }
        }
    }
};
struct EpiResGate {
    static constexpr bool PERM = false, AFTER_DRAIN = false;
    const float* base; float* out; const float* gate; int ldc;
    __device__ __forceinline__ void operator()(const f32x4 (&acc)[2][2][4][2], const Unit& u, int wr, int wc, int fr, int fq) const {
        const int row0 = u.pm * BM + wr * 64 + fr, col0 = u.pn * BM + wc * 32 + 4 * fq;
        const float* g = gate + (size_t)(u.pm >> 5) * 24576;
        f32x4 gv[2][2];
#pragma unroll
        for (int bj = 0; bj < 2; ++bj)
#pragma unroll
            for (int n = 0; n < 2; ++n) gv[bj][n] = *(const f32x4*)(g + col0 + bj * HALF + n * 16);
#pragma unroll
        for (int ai = 0; ai < 2; ++ai)
#pragma unroll
            for (int m = 0; m < 4; ++m) { const size_t off = (size_t)(row0 + ai * HALF + m * 16) * ldc + col0;
#pragma unroll
                for (int bj = 0; bj < 2; ++bj)
#pragma unroll
                    for (int n = 0; n < 2; ++n) { const f32x4 bs = *(const f32x4*)(base + off + bj * HALF + n * 16); *(f32x4*)(out + off + bj * HALF + n * 16) = bs + gv[bj][n] * acc[ai][bj][m][n]; }
                if (m & 1) asm volatile("" ::: "memory"); }
    }
};
struct AttProjOrder {
    int G, c;
    __device__ __forceinline__ bool next(int i, Unit& u) const {
        const long L = (long)i * G + c; if (L >= 454) return false;
        int wgid = (int)L; { const int q = 454 / NXCD, r = 454 % NXCD, xcd = wgid % NXCD, off = wgid / NXCD; wgid = (xcd < r ? xcd * (q + 1) : r * (q + 1) + (xcd - r) * q) + off; }
        if (wgid < 448) { u.pm = wgid / 7; u.pn = wgid % 7; } else { const int r2 = wgid - 448; u.pm = 64 + r2 / 3; u.pn = 4 + r2 % 3; }
        return true;
    }
    __device__ __forceinline__ void a_ready(const Unit&) const {}
    __device__ __forceinline__ void done(const Unit&) const {}
};
template <class Epi, class Sched, bool ALIGN_EPI = false, bool SP2 = false>
__device__ __forceinline__ void gemm_phase(PG8_LAS unsigned char* lds, const Gemm g, const Sched& S, const Epi& E) {
    int tid_o = threadIdx.x; asm volatile("" : "+v"(tid_o));
    const int tid = tid_o, wid = __builtin_amdgcn_readfirstlane(tid >> 6), lane = tid & 63, wr = wid >> 2, wc = wid & 3, fr = lane & 15, fq = lane >> 4;
    const int K = g.K, nt = K / BK;
    unsigned voffA[2], voffB[2];
#pragma unroll
    for (int i = 0; i < 2; ++i) { int R, C; stage_rc(tid * 16 + i * 8192, R, C); const int Rb = Epi::PERM ? ((R & ~31) + perm32(R & 31)) : R;
        voffA[i] = (unsigned)(R * K + C) * 2u; voffB[i] = (unsigned)(Rb * K + C) * 2u; }
    const size_t kstep = (size_t)(BK * 2);
    const size_t hstep = (size_t)HALF * K * 2;
    const size_t tstep = 2 * hstep;
    const unsigned ldsw = (unsigned)wid * 1024u;
    const int aoff = lds_byte(wr * 64 + fr, fq * 8), boff = lds_byte(wc * 32 + fr, fq * 8);
#define PG8_SA(b, h) (((b) * 2 + (h)) * HTB)
#define PG8_SB(b, h) ((4 + (b) * 2 + (h)) * HTB)
#define PG8_STAGE(bufoff, gbase, voff) do { _Pragma("unroll") for (int _i = 0; _i < 2; ++_i) \
        __builtin_amdgcn_global_load_lds((const unsigned*)((const char*)(gbase) + (voff)[_i]), (PG8_LAS unsigned*)(lds + (bufoff) + ldsw + _i * 8192), 16, 0, 0); } while (0)
#define PG8_LDA(dst, b, h) do { _Pragma("unroll") for (int m = 0; m < 4; ++m) _Pragma("unroll") for (int k = 0; k < 2; ++k) dst[m][k] = *(const PG8_LAS bf16x8*)(lds + PG8_SA(b, h) + aoff + m * 2048 + k * 1024); } while (0)
#define PG8_LDB(dst, b, h) do { _Pragma("unroll") for (int n = 0; n < 2; ++n) _Pragma("unroll") for (int k = 0; k < 2; ++k) dst[n][k] = *(const PG8_LAS bf16x8*)(lds + PG8_SB(b, h) + boff + n * 2048 + k * 1024); } while (0)
#define PG8_MMA(ai, bj, At, Bt) do { __builtin_amdgcn_s_setprio(1); _Pragma("unroll") for (int m = 0; m < 4; ++m) _Pragma("unroll") for (int n = 0; n < 2; ++n) _Pragma("unroll") for (int k = 0; k < 2; ++k) \
        acc[ai][bj][m][n] = __builtin_amdgcn_mfma_f32_16x16x32_bf16(Bt[n][k], At[m][k], acc[ai][bj][m][n], 0, 0, 0); __builtin_amdgcn_s_setprio(0); } while (0)
#define PG8_WAIT_V(n) asm volatile("s_waitcnt vmcnt(" #n ")" ::: "memory")
#define PG8_WAIT_L(n) asm volatile("s_waitcnt lgkmcnt(" #n ")" ::: "memory")
#define PG8_BAR __builtin_amdgcn_s_barrier()
#define PG8_SCHED __builtin_amdgcn_sched_barrier(0)
    Unit cur, nxt; int ui = 0;
    if (!S.next(0, cur)) return;
    f32x4 acc[2][2][4][2];
#pragma unroll
    for (int a = 0; a < 2; ++a)
#pragma unroll
        for (int b = 0; b < 2; ++b)
#pragma unroll
            for (int m = 0; m < 4; ++m)
#pragma unroll
                for (int n = 0; n < 2; ++n) acc[a][b][m][n] = (f32x4){0.f, 0.f, 0.f, 0.f};
    bf16x8 At[4][2], B0[2][2], B1[2][2];
    const char* cA = (const char*)g.A + (size_t)cur.pm * tstep; const char* cB = (const char*)g.Bt + (size_t)cur.pn * tstep;
    S.a_ready(cur);
    if constexpr (SP2) {
        PG8_STAGE(PG8_SB(0, 0), cB, voffB); PG8_STAGE(PG8_SB(0, 1), cB + hstep, voffB); PG8_STAGE(PG8_SA(0, 0), cA, voffA); PG8_STAGE(PG8_SA(0, 1), cA + hstep, voffA);
        if (wr == 1) PG8_BAR;
        PG8_WAIT_V(2); PG8_BAR;
        PG8_STAGE(PG8_SB(1, 0), cB + kstep, voffB); PG8_STAGE(PG8_SA(1, 0), cA + kstep, voffA); PG8_STAGE(PG8_SB(1, 1), cB + hstep + kstep, voffB);
        PG8_WAIT_V(6); PG8_BAR;
    } else {
        PG8_STAGE(PG8_SB(0, 0), cB, voffB); PG8_STAGE(PG8_SA(0, 0), cA, voffA); PG8_STAGE(PG8_SB(0, 1), cB + hstep, voffB); PG8_STAGE(PG8_SA(0, 1), cA + hstep, voffA);
        if (wr == 1) PG8_BAR;
        PG8_WAIT_V(4); PG8_BAR;
        PG8_STAGE(PG8_SB(1, 0), cB + kstep, voffB); PG8_STAGE(PG8_SA(1, 0), cA + kstep, voffA); PG8_STAGE(PG8_SB(1, 1), cB + hstep + kstep, voffB);
        PG8_WAIT_V(6); PG8_BAR;
    }
    for (;;) {
        const bool has_next = S.next(ui + 1, nxt);
        const char* nA = has_next ? (const char*)g.A + (size_t)nxt.pm * tstep : cA; const char* nB = has_next ? (const char*)g.Bt + (size_t)nxt.pn * tstep : cB;
        for (int t = 0; t < nt; t += 2) {
            const bool last = (t == nt - 2);
            const char* a1 = cA + (size_t)(t + 1) * kstep;
            const char* a2 = last ? nA : cA + (size_t)(t + 2) * kstep; const char* b2 = last ? nB : cB + (size_t)(t + 2) * kstep;
            const char* a3 = a2 + kstep; const char* b3 = b2 + kstep;
            if (last && has_next) S.a_ready(nxt);
            if constexpr (SP2) {
            PG8_LDB(B0, 0, 0); PG8_LDB(B1, 0, 1); PG8_SCHED; PG8_LDA(At, 0, 0); PG8_STAGE(PG8_SA(1, 1), a1 + hstep, voffA);
            PG8_WAIT_V(8); PG8_WAIT_L(0); PG8_BAR; PG8_MMA(0, 0, At, B0); PG8_MMA(0, 1, At, B1); PG8_BAR; PG8_SCHED;
            PG8_LDA(At, 0, 1); PG8_STAGE(PG8_SB(0, 0), b2, voffB); PG8_STAGE(PG8_SB(0, 1), b2 + hstep, voffB); PG8_STAGE(PG8_SA(0, 0), a2, voffA);
            PG8_WAIT_V(8); PG8_WAIT_L(0); PG8_BAR; PG8_MMA(1, 0, At, B0); PG8_MMA(1, 1, At, B1); PG8_BAR; PG8_SCHED;
            PG8_LDB(B0, 1, 0); PG8_LDB(B1, 1, 1); PG8_SCHED; PG8_LDA(At, 1, 0); PG8_STAGE(PG8_SA(0, 1), a2 + hstep, voffA);
            PG8_WAIT_V(8); PG8_WAIT_L(0); PG8_BAR; PG8_MMA(0, 0, At, B0); PG8_MMA(0, 1, At, B1); PG8_BAR; PG8_SCHED;
            PG8_LDA(At, 1, 1); PG8_STAGE(PG8_SB(1, 0), b3, voffB); PG8_STAGE(PG8_SB(1, 1), b3 + hstep, voffB); PG8_STAGE(PG8_SA(1, 0), a3, voffA);
            PG8_WAIT_V(8); PG8_WAIT_L(0); PG8_BAR; PG8_MMA(1, 0, At, B0); PG8_MMA(1, 1, At, B1); PG8_BAR; PG8_SCHED;
            } else {
            PG8_LDB(B0, 0, 0); PG8_SCHED; PG8_LDA(At, 0, 0); PG8_STAGE(PG8_SA(1, 1), a1 + hstep, voffA);
            PG8_WAIT_L(8); PG8_BAR; PG8_WAIT_L(0); PG8_MMA(0, 0, At, B0); PG8_BAR; PG8_SCHED;
            PG8_LDB(B1, 0, 1); PG8_STAGE(PG8_SB(0, 0), b2, voffB);
            PG8_BAR; PG8_WAIT_L(0); PG8_MMA(0, 1, At, B1); PG8_BAR;
            PG8_LDA(At, 0, 1); PG8_STAGE(PG8_SA(0, 0), a2, voffA);
            PG8_BAR; PG8_WAIT_L(0); PG8_MMA(1, 0, At, B0); PG8_BAR; PG8_SCHED;
            PG8_STAGE(PG8_SB(0, 1), b2 + hstep, voffB);
            PG8_WAIT_V(6); PG8_BAR; PG8_MMA(1, 1, At, B1); PG8_BAR;
            PG8_LDB(B0, 1, 0); PG8_SCHED; PG8_LDA(At, 1, 0); PG8_STAGE(PG8_SA(0, 1), a2 + hstep, voffA);
            PG8_WAIT_L(8); PG8_BAR; PG8_WAIT_L(0); PG8_MMA(0, 0, At, B0); PG8_BAR; PG8_SCHED;
            PG8_LDB(B1, 1, 1); PG8_STAGE(PG8_SB(1, 0), b3, voffB);
            PG8_BAR; PG8_WAIT_L(0); PG8_MMA(0, 1, At, B1); PG8_BAR;
            PG8_LDA(At, 1, 1); PG8_STAGE(PG8_SA(1, 0), a3, voffA);
            PG8_BAR; PG8_WAIT_L(0); PG8_MMA(1, 0, At, B0); PG8_BAR; PG8_SCHED;
            PG8_STAGE(PG8_SB(1, 1), b3 + hstep, voffB);
            PG8_WAIT_V(6); PG8_BAR; PG8_MMA(1, 1, At, B1); PG8_BAR;
            }
        }
        if constexpr (ALIGN_EPI) { if (wr == 0) PG8_BAR; }
        if constexpr (!Epi::AFTER_DRAIN) { E(acc, cur, wr, wc, fr, fq); S.done(cur); }
        if (!has_next) break;
#pragma unroll
        for (int a = 0; a < 2; ++a)
#pragma unroll
            for (int b = 0; b < 2; ++b)
#pragma unroll
                for (int m = 0; m < 4; ++m)
#pragma unroll
                    for (int n = 0; n < 2; ++n) acc[a][b][m][n] = (f32x4){0.f, 0.f, 0.f, 0.f};
        cur = nxt; cA = nA; cB = nB; ++ui;
        if constexpr (ALIGN_EPI) { if (wr == 1) PG8_BAR; }
    }
    PG8_WAIT_V(0);
    if constexpr (!ALIGN_EPI) { if (wr == 0) PG8_BAR; }
    PG8_BAR;
    if constexpr (Epi::AFTER_DRAIN) { E.fused(acc, cur, wr, wc, fr, fq, lds, wid, lane); S.done(cur); }
#undef PG8_SA
#undef PG8_SB
#undef PG8_STAGE
#undef PG8_LDA
#undef PG8_LDB
#undef PG8_MMA
#undef PG8_WAIT_V
#undef PG8_WAIT_L
#undef PG8_BAR
#undef PG8_SCHED
}
}
#ifndef PG8_SP2
#define PG8_SP2 true
#endif
#ifndef PG8_ALIGN
#define PG8_ALIGN true
#endif
#define GAS __attribute__((address_space(1)))
#define LAS __attribute__((address_space(3)))
typedef unsigned short bf16;
typedef unsigned v4u __attribute__((ext_vector_type(4)));
typedef float f32x4 __attribute__((ext_vector_type(4)));
typedef short bf16x8 __attribute__((ext_vector_type(8)));
typedef GAS unsigned gu32;
typedef GAS unsigned long long gu64;
#define RLX_AGENT __ATOMIC_RELAXED, __HIP_MEMORY_SCOPE_AGENT
#define LDS_WAIT() asm volatile("s_waitcnt lgkmcnt(0)" ::: "memory")
#define VM_WAIT() asm volatile("s_waitcnt vmcnt(0)" ::: "memory")
__device__ __forceinline__ unsigned long long rt() { return __builtin_amdgcn_s_memrealtime(); }
__device__ __forceinline__ unsigned f2bf(float f) { unsigned u = __builtin_bit_cast(unsigned, f); return (u + 0x7fffu + ((u >> 16) & 1u)) >> 16; }
__device__ __forceinline__ unsigned pk2(float lo, float hi) { return f2bf(lo) | (f2bf(hi) << 16); }
#define XB_TMO      128
#define XB_XCNT(j)  (256  + 64 * (j))
#define XB_XSUB(j)  (1280 + 64 * (j))
#define XB_XGEN(j)  (2304 + 64 * (j))
#define XB_TOP      3328
#define XB_TOPGEN   3392
#define XCD_BAR_WORDS 3456
#define XB_SPIN_CAP (1u << 18)

__device__ __forceinline__ unsigned xb_ld(unsigned* p)              { return __hip_atomic_load(p, __ATOMIC_RELAXED, __HIP_MEMORY_SCOPE_AGENT); }
__device__ __forceinline__ unsigned xb_add(unsigned* p, unsigned v) { return __hip_atomic_fetch_add(p, v, __ATOMIC_RELAXED, __HIP_MEMORY_SCOPE_AGENT); }
__device__ __forceinline__ unsigned xb_xcc_id() { return (unsigned)__builtin_amdgcn_s_getreg((3 << 11) | 20) & 0xFu; }
#define XB_SPIN(cond, bar) do { unsigned _sp = 0; while (cond) { __builtin_amdgcn_s_sleep(1); \
    if ((++_sp & 255u) == 0u) { if (xb_ld(&(bar)[XB_TMO])) break; if (_sp > XB_SPIN_CAP) { atomicAdd(&(bar)[XB_TMO], 1u); break; } } } } while (0)

struct XcdBarrier {
    unsigned* bar; unsigned x;
    volatile LAS unsigned* st;
};

__device__ __forceinline__ XcdBarrier xcd_barrier_post(unsigned* bar, volatile LAS unsigned* st) {
    XcdBarrier b; b.bar = bar; b.x = xb_xcc_id(); b.st = st;
    if (threadIdx.x == 0) (void)xb_add(&bar[XB_XCNT(b.x)], 1u);
    return b;
}
__device__ __forceinline__ void xcd_barrier_complete(unsigned* bar, unsigned x, unsigned& nloc, unsigned& nx) {
    const unsigned G = gridDim.x * gridDim.y * gridDim.z;
    unsigned sum, cnt, mine, sp = 0u;
    for (;;) {
        sum = 0u; cnt = 0u; mine = 0u;
#pragma unroll
        for (unsigned j = 0; j < 16; ++j) { const unsigned c = xb_ld(&bar[XB_XCNT(j)]); sum += c; cnt += (c > 0u) ? 1u : 0u; mine = (j == x) ? c : mine; }
        if (sum == G) break;
        __builtin_amdgcn_s_sleep(1);
        if ((++sp & 255u) == 0u) { if (xb_ld(&bar[XB_TMO])) break; if (sp > XB_SPIN_CAP) { atomicAdd(&bar[XB_TMO], 1u); break; } }
    }
    nloc = mine > 0u ? mine : 1u; nx = cnt > 0u ? cnt : 1u;
}

__device__ __forceinline__ void xcd_barrier(const XcdBarrier& b) {
    asm volatile("s_waitcnt vmcnt(0)" ::: "memory");
    __syncthreads();
    if (threadIdx.x == 0) {
        unsigned* bar = b.bar;
        __builtin_amdgcn_s_waitcnt(0);
        unsigned nloc = b.st[0], nx = b.st[1];
        if (nloc == 0u) { xcd_barrier_complete(bar, b.x, nloc, nx); b.st[0] = nloc; b.st[1] = nx; }
        const unsigned old = xb_add(&bar[XB_XSUB(b.x)], 1u);
        const unsigned gen = old / nloc;
        if (old + 1u == (gen + 1u) * nloc) {
            __builtin_amdgcn_fence(__ATOMIC_RELEASE, "agent");
            asm volatile("s_waitcnt vmcnt(0)" ::: "memory");
            const unsigned og = xb_add(&bar[XB_TOP], 1u);
            const unsigned tg = og / nx;
            if (og + 1u == (tg + 1u) * nx) xb_add(&bar[XB_TOPGEN], 1u);
            else XB_SPIN(xb_ld(&bar[XB_TOPGEN]) == tg, bar);
            __builtin_amdgcn_fence(__ATOMIC_ACQUIRE, "agent");
            xb_add(&bar[XB_XGEN(b.x)], 1u);
            asm volatile("s_waitcnt vmcnt(0)" ::: "memory");
        } else {
            XB_SPIN(xb_ld(&bar[XB_XGEN(b.x)]) == gen, bar);
            __builtin_amdgcn_fence(__ATOMIC_ACQUIRE, "agent");
            asm volatile("s_waitcnt vmcnt(0)" ::: "memory");
        }
    }
    __syncthreads();
}
namespace att {
typedef unsigned short bf16;
using bf16x8 = __attribute__((ext_vector_type(8))) short;
using s16x4  = __attribute__((ext_vector_type(4))) short;
using f32x16 = __attribute__((ext_vector_type(16))) float;
using u32x4  = __attribute__((ext_vector_type(4))) unsigned;
constexpr int DQ = 192, DVV = 128, NW = 8, QBLK = 32, KVBLK = 64;
constexpr float SCALE = 0.07216878364870323f;
constexpr float THR = 8.f;
constexpr size_t SHM_V = KVBLK * DVV * 2, SHM_K = KVBLK * DQ * 2, SHM_ATTN = 2 * SHM_V + 2 * SHM_K + NW * 64 * 4;
#define AKSWZ(row, colB) ((row) * 384 + ((colB) ^ ((((row) >> 1) & 7) << 4)))
#define ASBAR() __builtin_amdgcn_sched_barrier(0)
__device__ __forceinline__ int crow(int r, int hi) { return (r & 3) + 8 * (r >> 2) + 4 * hi; }
__device__ __forceinline__ unsigned cvtpk(float lo, float hi) { unsigned r; asm volatile("v_cvt_pk_bf16_f32 %0, %1, %2" : "=v"(r) : "v"(lo), "v"(hi)); return r; }

__device__ __forceinline__ void partialSM(f32x16& p0, f32x16& p1, float& m_reg, float& mn, float& alpha) {
  constexpr float C = SCALE * 1.4426950408889634f;
  float pmax = p0[0];
#pragma unroll
  for (int r = 1; r < 16; ++r) pmax = fmaxf(pmax, p0[r]);
#pragma unroll
  for (int r = 0; r < 16; ++r) pmax = fmaxf(pmax, p1[r]);
  { auto rr = __builtin_amdgcn_permlane32_swap(__float_as_uint(pmax), __float_as_uint(pmax), false, false);
    pmax = fmaxf(__uint_as_float(rr[0]), __uint_as_float(rr[1])); }
  if (__builtin_expect(__all(pmax - m_reg <= THR / SCALE), 1)) { mn = m_reg; alpha = 1.f; }
  else { mn = fmaxf(m_reg, pmax); alpha = __builtin_amdgcn_exp2f((m_reg - mn) * C); m_reg = mn; }
  float mnC = -mn * C;
#pragma unroll
  for (int r = 0; r < 16; ++r) p0[r] = fmaf(p0[r], C, mnC);
#pragma unroll
  for (int r = 0; r < 16; ++r) p1[r] = fmaf(p1[r], C, mnC);
#pragma unroll
  for (int r = 0; r < 16; ++r) p0[r] = __builtin_amdgcn_exp2f(p0[r]);
}
__device__ __forceinline__ void finishSM(f32x16& p0, f32x16& p1, float alpha, float& l_reg, bf16x8& pa0, bf16x8& pa1, bf16x8& pa2, bf16x8& pa3) {
#pragma unroll
  for (int r = 0; r < 16; ++r) p1[r] = __builtin_amdgcn_exp2f(p1[r]);
  float ps = 0;
#pragma unroll
  for (int r = 0; r < 16; ++r) ps += p0[r];
#pragma unroll
  for (int r = 0; r < 16; ++r) ps += p1[r];
  { auto rr = __builtin_amdgcn_permlane32_swap(__float_as_uint(ps), __float_as_uint(ps), false, false);
    ps = __uint_as_float(rr[0]) + __uint_as_float(rr[1]); }
  l_reg = l_reg * alpha + ps;
#define APK4(P, BASE, OUT) do { unsigned a0 = cvtpk(P[BASE + 0], P[BASE + 1]), a1 = cvtpk(P[BASE + 2], P[BASE + 3]);   \
    unsigned b0 = cvtpk(P[BASE + 4], P[BASE + 5]), b1 = cvtpk(P[BASE + 6], P[BASE + 7]);                              \
    auto r0 = __builtin_amdgcn_permlane32_swap(a0, b0, false, false); auto r1 = __builtin_amdgcn_permlane32_swap(a1, b1, false, false); \
    u32x4 w = {r0[0], r1[0], r0[1], r1[1]}; OUT = *reinterpret_cast<bf16x8*>(&w); } while (0)
  APK4(p0, 0, pa0); APK4(p0, 8, pa1); APK4(p1, 0, pa2); APK4(p1, 8, pa3);
#undef APK4
}
__device__ __forceinline__ void qkt(f32x16& p0, f32x16& p1, const bf16* Ks, const bf16x8* qr, int r32, int hi) {
  p0 = f32x16{}; p1 = f32x16{};
#pragma unroll
  for (int d0 = 0; d0 < 12; ++d0) { int cb = (d0 * 16 + hi * 8) * 2;
    bf16x8 b0 = *reinterpret_cast<const bf16x8*>((const char*)Ks + AKSWZ(r32, cb));
    bf16x8 b1 = *reinterpret_cast<const bf16x8*>((const char*)Ks + AKSWZ(32 + r32, cb));
    p0 = __builtin_amdgcn_mfma_f32_32x32x16_bf16(b0, qr[d0], p0, 0, 0, 0);
    p1 = __builtin_amdgcn_mfma_f32_32x32x16_bf16(b1, qr[d0], p1, 0, 0, 0); }
}
__device__ __forceinline__ int v_st(int k, int c) { const int kk = (k & ~0xC) | ((k & 4) << 1) | ((k & 8) >> 1); return ((kk >> 3) * 4 + (c >> 5)) * 512 + ((kk & 7) * 32 + (c & 31)) * 2; }
__device__ __forceinline__ int v_rd_base(int lane) { return ((lane & 3) << 3) | (((lane >> 2) & 3) << 6) | (((lane >> 4) & 1) << 5) | (((lane >> 5) & 1) << 8); }
constexpr int v_rd_off(int d0, int ks, int half) { return d0 * 512 + ks * 4096 + half * 2048; }
template <int OFF> __device__ __forceinline__ s16x4 tr_read(int vb) {
  s16x4 r; asm volatile("ds_read_b64_tr_b16 %0, %1 offset:%2" : "=&v"(r) : "v"(vb), "i"(OFF) : "memory"); return r;
}
template <int D0> __device__ __forceinline__ void pv_one(f32x16& od, int vb, bf16x8 pa0, bf16x8 pa1, bf16x8 pa2, bf16x8 pa3) {
  const s16x4 l0 = tr_read<v_rd_off(D0, 0, 0)>(vb), h0 = tr_read<v_rd_off(D0, 0, 1)>(vb), l1 = tr_read<v_rd_off(D0, 1, 0)>(vb), h1 = tr_read<v_rd_off(D0, 1, 1)>(vb);
  const s16x4 l2 = tr_read<v_rd_off(D0, 2, 0)>(vb), h2 = tr_read<v_rd_off(D0, 2, 1)>(vb), l3 = tr_read<v_rd_off(D0, 3, 0)>(vb), h3 = tr_read<v_rd_off(D0, 3, 1)>(vb);
  asm volatile("s_waitcnt lgkmcnt(0)" ::: "memory"); ASBAR();
#define APK(L, H) (bf16x8){L[0], L[1], L[2], L[3], H[0], H[1], H[2], H[3]}
  od = __builtin_amdgcn_mfma_f32_32x32x16_bf16(pa0, APK(l0, h0), od, 0, 0, 0);
  od = __builtin_amdgcn_mfma_f32_32x32x16_bf16(pa1, APK(l1, h1), od, 0, 0, 0);
  od = __builtin_amdgcn_mfma_f32_32x32x16_bf16(pa2, APK(l2, h2), od, 0, 0, 0);
  od = __builtin_amdgcn_mfma_f32_32x32x16_bf16(pa3, APK(l3, h3), od, 0, 0, 0);
#undef APK
}
__device__ __forceinline__ void pv_d0(f32x16* o, int vb, bf16x8 pa0, bf16x8 pa1, bf16x8 pa2, bf16x8 pa3) {
  pv_one<0>(o[0], vb, pa0, pa1, pa2, pa3); pv_one<1>(o[1], vb, pa0, pa1, pa2, pa3); pv_one<2>(o[2], vb, pa0, pa1, pa2, pa3); pv_one<3>(o[3], vb, pa0, pa1, pa2, pa3);
}
constexpr int LDO = 4096;
__device__ __forceinline__ void attn_unit(const bf16* __restrict__ Qb, const bf16* __restrict__ Kh, const bf16* __restrict__ Vh, bf16* __restrict__ Ob, int seq, char* lds) {
  int tid_o = threadIdx.x; asm volatile("" : "+v"(tid_o));
  const int tid = tid_o, wid = tid >> 6, lane = tid & 63, r32 = lane & 31, hi = lane >> 5;
  bf16* V_lds = (bf16*)lds; bf16* K_lds = (bf16*)(lds + 2 * SHM_V);
  float* ws = (float*)(lds + 2 * SHM_V + 2 * SHM_K) + wid * 64; float* li_l = ws; float* al_l = ws + 32;
  float m_reg = -1e30f, l_reg = 0; f32x16 o[4] = {}; bf16x8 qr[12];
  const bf16* Qw = Qb + (long)(wid * QBLK + r32) * DQ + hi * 8;
#pragma unroll
  for (int d0 = 0; d0 < 12; ++d0) qr[d0] = *reinterpret_cast<const bf16x8*>(Qw + d0 * 16);
  const int vb0 = (int)(uintptr_t)V_lds + v_rd_base(lane);
  bf16x8 sv0, sv1, sk0, sk1, sk2;
#define ASLOAD(k0) do { const bf16* vp = Vh + (long)(k0) * DVV + tid * 8; sv0 = *reinterpret_cast<const bf16x8*>(vp); sv1 = *reinterpret_cast<const bf16x8*>(vp + 4096); \
    const bf16* kp = Kh + (long)(k0) * DQ + tid * 8; sk0 = *reinterpret_cast<const bf16x8*>(kp); sk1 = *reinterpret_cast<const bf16x8*>(kp + 4096); sk2 = *reinterpret_cast<const bf16x8*>(kp + 8192); } while (0)
#define AKST(i) AKSWZ((tidw + 512 * (i)) / 24, ((tidw + 512 * (i)) % 24) * 16)
#define ASWRITE(b) do { int tidw = tid; asm volatile("" : "+v"(tidw)); const int sr = tidw >> 4, sc = (tidw & 15) * 8; \
    *(bf16x8*)((char*)V_lds + (b) * SHM_V + v_st(sr, sc)) = sv0; *(bf16x8*)((char*)V_lds + (b) * SHM_V + v_st(32 + sr, sc)) = sv1; \
    *(bf16x8*)((char*)K_lds + (b) * SHM_K + AKST(0)) = sk0; *(bf16x8*)((char*)K_lds + (b) * SHM_K + AKST(1)) = sk1; *(bf16x8*)((char*)K_lds + (b) * SHM_K + AKST(2)) = sk2; } while (0)
#define ASWAIT() asm volatile("s_waitcnt vmcnt(0)" ::: "memory")
#define ARESC(a) do { if (__any((a) < 1.f)) { if (hi == 0) al_l[r32] = (a); asm volatile("s_waitcnt lgkmcnt(0)" ::: "memory"); \
    _Pragma("unroll") for (int d = 0; d < 4; ++d) _Pragma("unroll") for (int r = 0; r < 16; ++r) o[d][r] *= al_l[crow(r, hi)]; } } while (0)
  f32x16 pA0, pA1, pB0, pB1; float mnA, mnB, alA, alB; bf16x8 pa0, pa1, pa2, pa3; const int NT = seq / KVBLK;
  ASLOAD(0); ASWAIT(); ASWRITE(0); __syncthreads();
  qkt(pA0, pA1, K_lds, qr, r32, hi); partialSM(pA0, pA1, m_reg, mnA, alA);
  ASLOAD(KVBLK);
  ASWAIT(); ASWRITE(1); __syncthreads();
  for (int j = 1; j + 1 < NT; j += 2) {
    ASBAR(); qkt(pB0, pB1, (bf16*)((char*)K_lds + SHM_K), qr, r32, hi);
    finishSM(pA0, pA1, alA, l_reg, pa0, pa1, pa2, pa3); ASBAR();
    ASLOAD((j + 1) * KVBLK); ASBAR();
    pv_d0(o, vb0, pa0, pa1, pa2, pa3); partialSM(pB0, pB1, m_reg, mnB, alB);
    __syncthreads(); ASWAIT(); ASWRITE(0);
    ARESC(alB); __syncthreads();
    ASBAR(); qkt(pA0, pA1, K_lds, qr, r32, hi);
    finishSM(pB0, pB1, alB, l_reg, pa0, pa1, pa2, pa3); ASBAR();
    ASLOAD((j + 2) * KVBLK); ASBAR();
    pv_d0(o, vb0 + (int)SHM_V, pa0, pa1, pa2, pa3); partialSM(pA0, pA1, m_reg, mnA, alA);
    __syncthreads(); ASWAIT(); ASWRITE(1);
    ARESC(alA); __syncthreads();
  }
  ASBAR(); qkt(pB0, pB1, (bf16*)((char*)K_lds + SHM_K), qr, r32, hi);
  finishSM(pA0, pA1, alA, l_reg, pa0, pa1, pa2, pa3); ASBAR();
  pv_d0(o, vb0, pa0, pa1, pa2, pa3); partialSM(pB0, pB1, m_reg, mnB, alB);
  __syncthreads(); ARESC(alB);
  finishSM(pB0, pB1, alB, l_reg, pa0, pa1, pa2, pa3); ASBAR();
  pv_d0(o, vb0 + (int)SHM_V, pa0, pa1, pa2, pa3);
  if (hi == 0) li_l[r32] = l_reg; asm volatile("s_waitcnt lgkmcnt(0)" ::: "memory");
  float rli[16];
#pragma unroll
  for (int r = 0; r < 16; ++r) rli[r] = __builtin_amdgcn_rcpf(li_l[crow(r, hi)]);
  bf16* Ow = Ob + (long)(wid * QBLK) * LDO;
#pragma unroll
  for (int r = 0; r < 16; ++r) { const int orow = crow(r, hi);
#pragma unroll
    for (int d0 = 0; d0 < 4; ++d0) { const float v = o[d0][r] * rli[r]; unsigned u = __float_as_uint(v); u = (u + 0x7fffu + ((u >> 16) & 1u)) >> 16; Ow[(long)orow * LDO + d0 * 32 + r32] = (bf16)u; } }
  __syncthreads();
#undef ASLOAD
#undef ASWRITE
#undef AKST
#undef ASWAIT
#undef ARESC
}
}
namespace hy {
typedef float f2 __attribute__((ext_vector_type(2)));
typedef float f4 __attribute__((ext_vector_type(4)));
constexpr int NF = 16384, LH = 8192;
constexpr int FFT_LDS_F2 = 18944;
__device__ __forceinline__ int PH(int p) { return p + 2 * (p >> 4) + 16 * (p >> 9); }
__device__ constexpr float C32[16] = {1.0f, 0.98078528040323043f, 0.92387953251128674f, 0.83146961230254524f, 0.70710678118654752f, 0.55557023301960218f, 0.38268343236508978f, 0.19509032201612825f,
                                      0.0f, -0.19509032201612825f, -0.38268343236508978f, -0.55557023301960218f, -0.70710678118654752f, -0.83146961230254524f, -0.92387953251128674f, -0.98078528040323043f};
__device__ constexpr float S32[16] = {0.0f, 0.19509032201612825f, 0.38268343236508978f, 0.55557023301960218f, 0.70710678118654752f, 0.83146961230254524f, 0.92387953251128674f, 0.98078528040323043f,
                                      1.0f, 0.98078528040323043f, 0.92387953251128674f, 0.83146961230254524f, 0.70710678118654752f, 0.55557023301960218f, 0.38268343236508978f, 0.19509032201612825f};
__host__ __device__ constexpr int brev(int x, int bits) { int r = 0; for (int i = 0; i < bits; ++i) r |= ((x >> i) & 1) << (bits - 1 - i); return r; }
template <int R> __device__ __forceinline__ void dft_r2(float (&re)[R], float (&im)[R]) {
#pragma unroll
    for (int h = R / 2; h >= 1; h >>= 1) {
#pragma unroll
        for (int s = 0; s < R; s += 2 * h) {
#pragma unroll
            for (int j = 0; j < h; ++j) {
                const int ti = j * (16 / h);
                const float ar = re[s + j], ai = im[s + j], br = re[s + j + h], bi = im[s + j + h];
                re[s + j] = ar + br; im[s + j] = ai + bi;
                const float dr = ar - br, di = ai - bi;
                if (ti == 0) { re[s + j + h] = dr; im[s + j + h] = di; }
                else if (ti == 8) { re[s + j + h] = di; im[s + j + h] = -dr; }
                else { const float c = C32[ti], sn = S32[ti]; re[s + j + h] = dr * c + di * sn; im[s + j + h] = di * c - dr * sn; }
            }
        }
    }
}
__device__ __forceinline__ void cmul(float& xr, float& xi, float wr, float wi) { const float t = xr * wr - xi * wi; xi = xr * wi + xi * wr; xr = t; }
template <int STRIDE, bool INV, int NSTORE> __device__ __forceinline__ void pass32(LAS f2* X, int base, float wr, float wi) {
    float re[32], im[32];
#pragma unroll
    for (int a = 0; a < 32; ++a) { const f2 v = X[base + a * STRIDE]; re[a] = v.x; im[a] = v.y; }
    if (!INV) {
        dft_r2<32>(re, im);
        float cr = wr, ci = -wi;
#pragma unroll
        for (int k = 1; k < 32; ++k) { const int i = brev(k, 5); cmul(re[i], im[i], cr, ci); if (k < 31) cmul(cr, ci, wr, -wi); }
#pragma unroll
        for (int k = 0; k < 32; ++k) { const int i = brev(k, 5); X[base + k * STRIDE] = (f2){re[i], im[i]}; }
    } else {
        float cr = wr, ci = wi;
#pragma unroll
        for (int k = 1; k < 32; ++k) { cmul(re[k], im[k], cr, ci); if (k < 31) cmul(cr, ci, wr, wi); }
        dft_r2<32>(im, re);
#pragma unroll
        for (int k = 0; k < NSTORE; ++k) { const int i = brev(k, 5); X[base + k * STRIDE] = (f2){re[i], im[i]}; }
    }
}
__device__ __forceinline__ int opaque(int v) { asm volatile("" : "+v"(v)); return v; }
__device__ __forceinline__ void fft_pass1(LAS f2* X, int tid, bool inv_) {
    tid = opaque(tid);
    float s, c; sincospif((float)tid * (2.0f / (float)NF), &s, &c);
    asm volatile("" : "+v"(s), "+v"(c));
    const int base = tid + 2 * (tid >> 4);
    if (!inv_) pass32<592, false, 32>(X, base, c, s); else pass32<592, true, 16>(X, base, c, s);
}
__device__ __forceinline__ void fft_pass2(LAS f2* X, int tid, bool inv_) {
    tid = opaque(tid);
    const int r2 = tid & 15, blk = tid >> 4;
    float s, c; sincospif((float)r2 * (1.0f / 256.0f), &s, &c);
    asm volatile("" : "+v"(s), "+v"(c));
    const int base = blk * 592 + r2;
    if (!inv_) pass32<18, false, 32>(X, base, c, s); else pass32<18, true, 32>(X, base, c, s);
}
__device__ __forceinline__ void fft_pass3(LAS f2* X, int tid, const f2* __restrict__ KS) {
    tid = opaque(tid);
#pragma unroll 1
    for (int h = 0; h < 2; ++h) {
        const int q = tid + 512 * h, base = 18 * q + 16 * (q >> 5);
        f4 kv[8];
        if (KS) {
#pragma unroll
            for (int i = 0; i < 8; ++i) kv[i] = *(const f4*)(KS + q * 16 + 2 * i);
        }
        float re[16], im[16];
#pragma unroll
        for (int i = 0; i < 8; ++i) { const f4 v = *(const LAS f4*)(X + base + 2 * i); re[2 * i] = v.x; im[2 * i] = v.y; re[2 * i + 1] = v.z; im[2 * i + 1] = v.w; }
        dft_r2<16>(re, im);
        if (!KS) {
#pragma unroll
            for (int i = 0; i < 8; ++i) { const int a = brev(2 * i, 4), b = brev(2 * i + 1, 4); *(LAS f4*)(X + base + 2 * i) = (f4){re[a], im[a], re[b], im[b]}; }
        } else {
            float r2[16], i2[16];
#pragma unroll
            for (int k = 0; k < 16; ++k) { const int a = brev(k, 4); const float kr = (k & 1) ? kv[k >> 1].z : kv[k >> 1].x, ki = (k & 1) ? kv[k >> 1].w : kv[k >> 1].y;
                r2[k] = re[a] * kr - im[a] * ki; i2[k] = re[a] * ki + im[a] * kr; }
            dft_r2<16>(i2, r2);
#pragma unroll
            for (int i = 0; i < 8; ++i) { const int a = brev(2 * i, 4), b = brev(2 * i + 1, 4); *(LAS f4*)(X + base + 2 * i) = (f4){r2[a], i2[a], r2[b], i2[b]}; }
        }
    }
}
#define HY_SYNC() __syncthreads()
__device__ __forceinline__ void fft_forward_plain(LAS f2* X, int tid) { fft_pass1(X, tid, false); HY_SYNC(); fft_pass2(X, tid, false); HY_SYNC(); fft_pass3(X, tid, nullptr); HY_SYNC(); }
__device__ __forceinline__ void fft_conv(LAS f2* X, int tid, const f2* KS) {
    fft_pass1(X, tid, false); HY_SYNC(); fft_pass2(X, tid, false); HY_SYNC(); fft_pass3(X, tid, KS); HY_SYNC(); fft_pass2(X, tid, true); HY_SYNC(); fft_pass1(X, tid, true); HY_SYNC();
}
__device__ __forceinline__ float bf2f(unsigned short h) { return __uint_as_float(((unsigned)h) << 16); }
__device__ __forceinline__ void conv8(const unsigned short* __restrict__ p, int t0, float w0, float w1, float w2, float cb, float (&o)[8]) {
    const bf16x8 v = *(const bf16x8*)(p + t0);
    float x[10];
    x[0] = t0 > 0 ? bf2f(p[t0 - 1]) : 0.f; x[9] = (t0 + 8 < LH) ? bf2f(p[t0 + 8]) : 0.f;
#pragma unroll
    for (int i = 0; i < 8; ++i) x[i + 1] = bf2f((unsigned short)v[i]);
#pragma unroll
    for (int i = 0; i < 8; ++i) o[i] = w0 * x[i] + w1 * x[i + 1] + w2 * x[i + 2] + cb;
}
__device__ __forceinline__ void zero_upper(LAS f2* X, int tid) {
    LAS f4* z = (LAS f4*)(X + 9472);
    for (int i = tid; i < (FFT_LDS_F2 - 9472) / 2; i += 512) z[i] = (f4){0.f, 0.f, 0.f, 0.f};
}
__device__ __forceinline__ void hyena_channel(LAS f2* X, int tid, int c, const unsigned short* __restrict__ HyT, const float* __restrict__ FiltT, const float* __restrict__ convw, const float* __restrict__ convb,
                                              const float* __restrict__ hbias, f2* KSb, unsigned short* __restrict__ YT) {
    tid = opaque(tid);
    {
        const float* f00 = FiltT + (size_t)(0 * 4096 + 0 * 2048 + c) * LH; const float* f01 = FiltT + (size_t)(0 * 4096 + 1 * 2048 + c) * LH;
        const float* f10 = FiltT + (size_t)(1 * 4096 + 0 * 2048 + c) * LH; const float* f11 = FiltT + (size_t)(1 * 4096 + 1 * 2048 + c) * LH;
#pragma unroll 1
        for (int i = 0; i < 4; ++i) {
            const int t0 = 4 * (tid + 512 * i);
            const f4 a = *(const f4*)(f00 + t0), b = *(const f4*)(f01 + t0), cc = *(const f4*)(f10 + t0), d = *(const f4*)(f11 + t0);
            const int e0 = PH(t0);
            *(LAS f4*)(X + e0) = (f4){a.x, b.x, a.y, b.y}; *(LAS f4*)(X + e0 + 2) = (f4){a.z, b.z, a.w, b.w};
            if (t0 == 0) X[PH(LH)] = (f2){0.f, 0.f}; else X[PH(NF - t0)] = (f2){cc.x, d.x};
            X[PH(NF - t0 - 1)] = (f2){cc.y, d.y}; X[PH(NF - t0 - 2)] = (f2){cc.z, d.z}; X[PH(NF - t0 - 3)] = (f2){cc.w, d.w};
        }
    }
    HY_SYNC();
    fft_forward_plain(X, tid);
    tid = opaque(tid);
    {
        const float b1 = hbias[c], b2 = hbias[2048 + c]; const float sc = 1.0f / (float)NF;
#pragma unroll 4
        for (int i = 0; i < 32; ++i) {
            const int P = tid + 512 * i; const int k = (P >> 9) + 32 * ((P >> 4) & 31) + 1024 * (P & 15); const int kn = (NF - k) & (NF - 1);
            const int Pn = (kn & 31) * 512 + ((kn >> 5) & 31) * 16 + (kn >> 10);
            const f2 z = X[PH(P)], zn = X[PH(Pn)];
            KSb[P] = (f2){(0.5f * (z.x + zn.x) + b1) * sc, 0.5f * (z.y - zn.y) * sc};
            KSb[NF + P] = (f2){(0.5f * (z.y + zn.y) + b2) * sc, -0.5f * (z.x - zn.x) * sc};
        }
    }
    asm volatile("s_waitcnt vmcnt(0)" ::: "memory");
    HY_SYNC();
    tid = opaque(tid);
    const unsigned short* pv = HyT + (size_t)c * NF; const unsigned short* px1 = HyT + (size_t)(2048 + c) * NF; const unsigned short* px2 = HyT + (size_t)(4096 + c) * NF;
    {
        const float w0 = convw[c], w1 = convw[6144 + c], w2 = convw[2 * 6144 + c], cb = convb[c];
#pragma unroll 1
        for (int i = 0; i < 2; ++i) { const int t0 = 8 * (tid + 512 * i); float a[8], b[8]; conv8(pv, t0, w0, w1, w2, cb, a); conv8(pv + LH, t0, w0, w1, w2, cb, b);
            const int e0 = PH(t0);
#pragma unroll
            for (int j = 0; j < 4; ++j) *(LAS f4*)(X + e0 + 2 * j) = (f4){a[2 * j], b[2 * j], a[2 * j + 1], b[2 * j + 1]}; }
        zero_upper(X, tid);
    }
    HY_SYNC();
    fft_conv(X, tid, KSb);
    tid = opaque(tid);
    {
        const float w0 = convw[2048 + c], w1 = convw[6144 + 2048 + c], w2 = convw[2 * 6144 + 2048 + c], cb = convb[2048 + c];
#pragma unroll 1
        for (int i = 0; i < 2; ++i) { const int t0 = 8 * (tid + 512 * i); float a[8], b[8]; conv8(px1, t0, w0, w1, w2, cb, a); conv8(px1 + LH, t0, w0, w1, w2, cb, b);
            const int e0 = PH(t0);
#pragma unroll
            for (int j = 0; j < 4; ++j) { const f4 y = *(const LAS f4*)(X + e0 + 2 * j); *(LAS f4*)(X + e0 + 2 * j) = (f4){a[2 * j] * y.x, b[2 * j] * y.y, a[2 * j + 1] * y.z, b[2 * j + 1] * y.w}; } }
        zero_upper(X, tid);
    }
    HY_SYNC();
    fft_conv(X, tid, KSb + NF);
    tid = opaque(tid);
    {
        const float w0 = convw[4096 + c], w1 = convw[6144 + 4096 + c], w2 = convw[2 * 6144 + 4096 + c], cb = convb[4096 + c];
        unsigned short* yo = YT + (size_t)c * NF;
#pragma unroll 1
        for (int i = 0; i < 2; ++i) { const int t0 = 8 * (tid + 512 * i); float a[8], b[8]; conv8(px2, t0, w0, w1, w2, cb, a); conv8(px2 + LH, t0, w0, w1, w2, cb, b);
            const int e0 = PH(t0); float ya[8], yb[8];
#pragma unroll
            for (int j = 0; j < 4; ++j) { const f4 y = *(const LAS f4*)(X + e0 + 2 * j); ya[2 * j] = a[2 * j] * y.x; yb[2 * j] = b[2 * j] * y.y; ya[2 * j + 1] = a[2 * j + 1] * y.z; yb[2 * j + 1] = b[2 * j + 1] * y.w; }
            v4u wa, wb; wa.x = pg8::cvt_pk_bf16(ya[0], ya[1]); wa.y = pg8::cvt_pk_bf16(ya[2], ya[3]); wa.z = pg8::cvt_pk_bf16(ya[4], ya[5]); wa.w = pg8::cvt_pk_bf16(ya[6], ya[7]);
            wb.x = pg8::cvt_pk_bf16(yb[0], yb[1]); wb.y = pg8::cvt_pk_bf16(yb[2], yb[3]); wb.z = pg8::cvt_pk_bf16(yb[4], yb[5]); wb.w = pg8::cvt_pk_bf16(yb[6], yb[7]);
            *(v4u*)(yo + t0) = wa; *(v4u*)(yo + LH + t0) = wb; }
    }
    HY_SYNC();
}
}
constexpr int NWAVES = 8;
#ifndef MK_N_LAUNCHES
#define MK_N_LAUNCHES 1
#endif
constexpr int N_PHASES = 10;
constexpr int N_LAUNCHES = MK_N_LAUNCHES;
constexpr int DM = 4096, NB = 2, SEQ = 8192, MTOK = NB * SEQ, LCTX = 256, MCTX = NB * LCTX, MALL = MTOK + MCTX;
constexpr int HYW = 2048, HYC = 6144, QLORA = 1024, KVLORA = 512, INC = 7744, INP = 7936, NMODC = 24576;
constexpr int NHEAD = 16, DQK = 192, FF = 16384, SKEYS = LCTX + SEQ;
constexpr float EPS = 1e-6f;
constexpr size_t MiB = 1u << 20;
constexpr size_t WS_CTL = 0, CTL_ZERO_BYTES = 1 * MiB;
constexpr size_t WS_MODP = 1 * MiB;
constexpr size_t WS_MODS = 3 * MiB;
constexpr size_t WS_WOUT = 8 * MiB, WS_W1 = 40 * MiB, WS_W2 = 168 * MiB, WS_WIN = 296 * MiB, WS_WQB = 358 * MiB, WS_WKVB = 364 * MiB, WS_HH = 368 * MiB;
constexpr size_t WS_FILT = 370 * MiB, WS_H = 626 * MiB, WS_HYT = 758 * MiB, WS_QA = 950 * MiB, WS_KVA = 982 * MiB, WS_KR = 999 * MiB, WS_QRAW = 1004 * MiB, WS_KVRAW = 1100 * MiB;
constexpr size_t WS_YT = 1232 * MiB, WS_KS = 1296 * MiB, WS_END0 = 1360 * MiB;
constexpr size_t WS_QB = 370 * MiB, WS_KB = 466 * MiB, WS_VB = 565 * MiB, WS_MIX = 631 * MiB;
constexpr size_t WS_H2 = 760 * MiB;
constexpr size_t WS_HID = 900 * MiB, WS_END = 1412 * MiB;
static_assert(WS_MIX + (size_t)MTOK * DM * 2 <= WS_H2 && WS_H2 + (size_t)MTOK * DM * 2 <= WS_HID && WS_VB + (size_t)NB * NHEAD * SKEYS * 128 * 2 <= WS_MIX && WS_KB + (size_t)NB * NHEAD * SKEYS * 192 * 2 <= WS_VB, "d_ws map");
constexpr int CW_TMO = 0, CW_BAR = 4096;
constexpr int LDS_BYTES = 163840, MISC_OFF = 159744;

struct Args { const float* in[27]; float* out; unsigned char* ws; int ph_lo, ph_hi, li, pad; };
typedef const __attribute__((address_space(4))) Args CArgs;

__device__ __forceinline__ float wave_sum(float v) {
#define WS_SWZ(X) v += __int_as_float(__builtin_amdgcn_ds_swizzle(__float_as_int(v), ((X) << 10) | 0x1f))
    WS_SWZ(1); WS_SWZ(2); WS_SWZ(4); WS_SWZ(8); WS_SWZ(16);
#undef WS_SWZ
    { auto rr = __builtin_amdgcn_permlane32_swap(__float_as_uint(v), __float_as_uint(v), false, false); v = __uint_as_float(rr[0]) + __uint_as_float(rr[1]); }
    return v;
}
__device__ __forceinline__ float bf2f(unsigned short h) { return __uint_as_float(((unsigned)h) << 16); }
__device__ __forceinline__ void p0_transpose_item(const float* W, int K, int N, bf16* WT, int row_off, const float* kscale, LAS float* scr, int item, int lane) {
    const int nblk = N / 32, kb = item / nblk, nb = item % nblk, k0 = 64 * kb, n0 = 32 * nb;
#pragma unroll 8
    for (int i = 0; i < 32; ++i) { const int kk = 2 * i + (lane >> 5); float v = W[(size_t)(k0 + kk) * N + n0 + (lane & 31)]; if (kscale) v *= kscale[k0 + kk]; scr[kk * 33 + (lane & 31)] = v; }
    LDS_WAIT(); asm volatile("" ::: "memory");
    const int c = lane & 7;
#pragma unroll
    for (int j = 0; j < 4; ++j) { const int n = (lane >> 3) + 8 * j; const LAS float* s = scr + (8 * c) * 33 + n;
        v4u o; o.x = pk2(s[0 * 33], s[1 * 33]); o.y = pk2(s[2 * 33], s[3 * 33]); o.z = pk2(s[4 * 33], s[5 * 33]); o.w = pk2(s[6 * 33], s[7 * 33]);
        *(GAS v4u*)(WT + (size_t)(row_off + n0 + n) * K + k0 + 8 * c) = o; }
    LDS_WAIT(); asm volatile("" ::: "memory");
}
__device__ __forceinline__ void modulate_row(const float* xrow, bf16* orow, const LAS float* g, const LAS float* sh, const LAS float* sc, int lane) {
    asm volatile("" : "+v"(lane));
    const GAS f32x4* xr = (const GAS f32x4*)xrow + lane;
    f32x4 v[16]; float s = 0.f;
#pragma unroll
    for (int j = 0; j < 16; ++j) { v[j] = xr[64 * j]; s += (v[j].x * v[j].x + v[j].y * v[j].y) + (v[j].z * v[j].z + v[j].w * v[j].w); }
    const float rstd = 1.0f / sqrtf(wave_sum(s) * (1.f / DM) + EPS);
    GAS unsigned long long* o8 = (GAS unsigned long long*)orow + lane;
#pragma unroll
    for (int j = 0; j < 16; ++j) { const int c0 = 4 * (lane + 64 * j); const f32x4 gg = *(const LAS f32x4*)(g + c0), hh = *(const LAS f32x4*)(sh + c0), cc = *(const LAS f32x4*)(sc + c0);
        const f32x4 y = (v[j] * rstd * gg) * (cc + 1.0f) + hh;
        o8[64 * j] = (unsigned long long)pk2(y.x, y.y) | ((unsigned long long)pk2(y.z, y.w) << 32);
        if (j & 1) asm volatile("" ::: "memory"); }
}

__global__ void __launch_bounds__(NWAVES * 64, 2) mega_fwd(Args args) {
    extern __shared__ __attribute__((aligned(16))) unsigned char lds_raw[];
    LAS unsigned char* lds = (LAS unsigned char*)lds_raw;
    volatile LAS unsigned* MISC = (volatile LAS unsigned*)(lds + MISC_OFF);
#define PHASE_IDS() const CArgs* ap = (const CArgs*)__builtin_amdgcn_kernarg_segment_ptr(); asm volatile("" : "+s"(ap)); unsigned char* ws = ap->ws; const int tid = hy::opaque((int)threadIdx.x), lane = tid & 63, wave = __builtin_amdgcn_readfirstlane(tid >> 6), gw = vcu * NWAVES + wave, NGW = G * NWAVES; (void)lane; (void)gw; (void)NGW
    const int G = gridDim.x; const int bx = blockIdx.x; const int vcu = (G % 8 == 0) ? (bx % 8) * (G / 8) + bx / 8 : bx;
    gu32* ctl = (gu32*)(args.ws + WS_CTL);
#define x_in ((const float*)ap->in[0])
#define cvec ((const float*)ap->in[1])
#define ctx ((const float*)ap->in[2])
#define c_ctx ((const float*)ap->in[3])
#define norm1_g ((const float*)ap->in[4])
#define norm2_g ((const float*)ap->in[5])
#define w_ada ((const float*)ap->in[6])
#define b_ada ((const float*)ap->in[7])
#define w_in ((const float*)ap->in[8])
#define hy_conv_w ((const float*)ap->in[9])
#define hy_conv_b ((const float*)ap->in[10])
#define hy_w1 ((const float*)ap->in[11])
#define hy_b1 ((const float*)ap->in[12])
#define hy_w2 ((const float*)ap->in[13])
#define hy_b2 ((const float*)ap->in[14])
#define hy_w3 ((const float*)ap->in[15])
#define hy_freq ((const float*)ap->in[16])
#define hy_bias ((const float*)ap->in[17])
#define g_qa ((const float*)ap->in[18])
#define w_qb ((const float*)ap->in[19])
#define g_kva ((const float*)ap->in[20])
#define w_kvb ((const float*)ap->in[21])
#define q_norm_g ((const float*)ap->in[22])
#define k_norm_g ((const float*)ap->in[23])
#define w_out ((const float*)ap->in[24])
#define w_mlp1 ((const float*)ap->in[25])
#define w_mlp2 ((const float*)ap->in[26])
#define out_p (ap->out)
#define MODP ((float*)(ws + WS_MODP))
#define MODS ((float*)(ws + WS_MODS))
#define WoutT ((bf16*)(ws + WS_WOUT))
#define W1T ((bf16*)(ws + WS_W1))
#define W2T ((bf16*)(ws + WS_W2))
#define WinT ((bf16*)(ws + WS_WIN))
#define WqbT ((bf16*)(ws + WS_WQB))
#define WkvbT ((bf16*)(ws + WS_WKVB))
#define Hh ((float*)(ws + WS_HH))
#define FiltT ((float*)(ws + WS_FILT))
#define Hb ((bf16*)(ws + WS_H))
#define HyT ((bf16*)(ws + WS_HYT))
#define QA ((bf16*)(ws + WS_QA))
#define KVA ((bf16*)(ws + WS_KVA))
#define KR ((float*)(ws + WS_KR))
#define Qraw ((bf16*)(ws + WS_QRAW))
#define KVraw ((bf16*)(ws + WS_KVRAW))
#define YT ((bf16*)(ws + WS_YT))
#define KSall ((hy::f2*)(ws + WS_KS))
#define Qb ((bf16*)(ws + WS_QB))
#define Kb ((bf16*)(ws + WS_KB))
#define Vb ((bf16*)(ws + WS_VB))
#define MIX ((bf16*)(ws + WS_MIX))
#define H2 ((bf16*)(ws + WS_H2))
#define HID ((bf16*)(ws + WS_HID))
    for (int u = hy::opaque((int)threadIdx.x); u < (LDS_BYTES - MISC_OFF) / 4; u += NWAVES * 64) ((LAS unsigned*)(lds + MISC_OFF))[u] = 0u;
    __syncthreads();
    XcdBarrier bar; bar.bar = (unsigned*)(ctl + CW_BAR); bar.x = 0; bar.st = nullptr;
    if (N_LAUNCHES == 1) bar = xcd_barrier_post((unsigned*)(ctl + CW_BAR), MISC + 8);
#define GRID_BAR() do { if (N_LAUNCHES == 1) xcd_barrier(bar); } while (0)
    const int lo = args.ph_lo, hi = args.ph_hi;
#ifndef PH_MASK
#define PH_MASK 0x3ff
#endif
#define IN(k) (((PH_MASK >> (k)) & 1) && lo <= (k) && (k) < hi)
#define BOTH(k) (IN(k) && IN((k) + 1))

    if (IN(0)) {
        PHASE_IDS();
        {
            LAS float* scr = (LAS float*)(lds + wave * 16384);
            constexpr int I_IN = (DM / 64) * (INC / 32), I_QB = (QLORA / 64) * (3072 / 32), I_KVB = (KVLORA / 64) * (4096 / 32), I_O = (DM / 64) * (DM / 32), I_1 = (DM / 64) * (FF / 32), I_2 = (FF / 64) * (DM / 32);
            constexpr int NITEMS = I_IN + I_QB + I_KVB + I_O + I_1 + I_2;
            for (int it = gw; it < NITEMS; it += NGW) {
                int r = it;
                if (r < I_IN) { p0_transpose_item(w_in, DM, INC, WinT, 0, nullptr, scr, r, lane); continue; } r -= I_IN;
                if (r < I_QB) { p0_transpose_item(w_qb, QLORA, 3072, WqbT, 0, g_qa, scr, r, lane); continue; } r -= I_QB;
                if (r < I_KVB) { p0_transpose_item(w_kvb, KVLORA, 4096, WkvbT, 0, g_kva, scr, r, lane); continue; } r -= I_KVB;
                if (r < I_O) { p0_transpose_item(w_out, DM, DM, WoutT, 0, nullptr, scr, r, lane); continue; } r -= I_O;
                if (r < I_1) { p0_transpose_item(w_mlp1, DM, FF, W1T, 0, nullptr, scr, r, lane); continue; } r -= I_1;
                p0_transpose_item(w_mlp2, FF, DM, W2T, 0, nullptr, scr, r, lane);
            }
            { GAS v4u* z = (GAS v4u*)(WinT + (size_t)INC * DM); const size_t n16 = (size_t)(INP - INC) * DM * 2 / 16;
              for (size_t i = (size_t)vcu * 512 + tid; i < n16; i += (size_t)G * 512) z[i] = (v4u){0u, 0u, 0u, 0u}; }
        }
        __syncthreads();
        {
            LAS float* S = (LAS float*)lds;
            LAS float* RED = (LAS float*)(lds + 49152);
            for (int i = tid; i < 3 * DM; i += 512) { const float v = i < 2 * DM ? cvec[i] : c_ctx[i - 2 * DM]; S[i] = v / (1.0f + __expf(-v)); }
            __syncthreads();
            for (int it = vcu; it < 192 * 4; it += G) {
                const int cb = it % 192, ks = it / 192, col = cb * 128 + 2 * lane, kbeg = ks * 1024;
                float a0 = 0, a1 = 0, b0 = 0, b1 = 0, c0 = 0, c1 = 0;
#pragma unroll 8
                for (int i = 0; i < 128; ++i) { const int k = kbeg + wave + 8 * i; const float2 w = *(const float2*)(w_ada + (size_t)k * NMODC + col);
                    const float s0 = S[k], s1 = S[DM + k], s2 = S[2 * DM + k];
                    a0 += s0 * w.x; a1 += s0 * w.y; b0 += s1 * w.x; b1 += s1 * w.y; c0 += s2 * w.x; c1 += s2 * w.y; }
                LAS float* rw = RED + wave * 384;
                rw[2 * lane] = a0; rw[2 * lane + 1] = a1; rw[128 + 2 * lane] = b0; rw[128 + 2 * lane + 1] = b1; rw[256 + 2 * lane] = c0; rw[256 + 2 * lane + 1] = c1;
                __syncthreads();
                if (tid < 384) { float s = 0.f;
#pragma unroll
                    for (int w = 0; w < 8; ++w) s += RED[w * 384 + tid];
                    const int r = tid >> 7, cc = tid & 127; MODP[(size_t)(ks * 3 + r) * NMODC + cb * 128 + cc] = s; }
                __syncthreads();
            }
        }
        {
            LAS float* FE = (LAS float*)lds;
            LAS float* H1 = (LAS float*)(lds + 2048);
            const int tl = tid >> 6, j = tid & 63;
            for (int it = vcu; it < SEQ / 8; it += G) {
                const int t = it * 8 + tl;
                if (j < 33) { float f;
                    if (j == 0) f = (float)t / (float)(SEQ - 1);
                    else { const int bi = (j - 1) & 15; const float band = 1e-4f + (float)bi * ((15.0f - 1e-4f) / 15.0f); const float ang = ((float)(2.0 * 3.14159265358979323846 / SEQ) * (float)t) * band; f = (j <= 16) ? cosf(ang) : -sinf(ang); }
                    FE[tl * 33 + j] = f; }
                __syncthreads();
                { float a = hy_b1[j];
#pragma unroll 11
                  for (int i = 0; i < 33; ++i) a += FE[tl * 33 + i] * hy_w1[i * 64 + j];
                  H1[tl * 64 + j] = sinf(hy_freq[j] * a); }
                __syncthreads();
                { float a = hy_b2[j];
#pragma unroll 8
                  for (int i = 0; i < 64; ++i) a += H1[tl * 64 + i] * hy_w2[i * 64 + j];
                  Hh[(size_t)t * 64 + j] = sinf(hy_freq[j] * a); }
                __syncthreads();
            }
        }
        if (BOTH(0)) GRID_BAR();
    }

    if (IN(1)) {
        PHASE_IDS();
        {
            LAS float* SH = (LAS float*)lds;
            LAS float* SC = (LAS float*)(lds + 49152);
            LAS float* GN = (LAS float*)(lds + 98304);
            for (int i = tid; i < 3 * 2 * DM; i += 512) { const int r = i / (2 * DM), col = i % (2 * DM);
                float s = b_ada[col];
#pragma unroll
                for (int ks = 0; ks < 4; ++ks) s += MODP[(size_t)(ks * 3 + r) * NMODC + col];
                if (col < DM) SH[r * DM + col] = s; else SC[r * DM + col - DM] = s; }
            for (int i = tid; i < DM; i += 512) GN[i] = norm1_g[i];
            for (int i = vcu * 512 + tid; i < 3 * NMODC; i += G * 512) { const int r = i / NMODC, col = i % NMODC;
                float s = b_ada[col];
#pragma unroll
                for (int ks = 0; ks < 4; ++ks) s += MODP[(size_t)(ks * 3 + r) * NMODC + col];
                MODS[i] = s; }
            __syncthreads();
            for (int m = gw; m < MALL; m += NGW) {
                const int r = m < MTOK ? m / SEQ : 2;
                const float* src = m < MTOK ? x_in + (size_t)m * DM : ctx + (size_t)(m - MTOK) * DM;
                modulate_row(src, Hb + (size_t)m * DM, GN, SH + r * DM, SC + r * DM, lane);
            }
            __syncthreads();
        }
        {
            LAS float* HS = (LAS float*)lds;
            LAS float* W3S = (LAS float*)(lds + 34816);
            const int tb = vcu & 63, t0 = tb * 128, tl = tid & 127, cg = tid >> 7;
            for (int i = tid; i < 128 * 64; i += 512) HS[(i >> 6) * 65 + (i & 63)] = Hh[(size_t)t0 * 64 + i];
            const float tlin = (float)(t0 + tl) / (float)(SEQ - 1);
            for (int cbk = vcu >> 6; cbk < 256; cbk += (G >> 6)) {
                __syncthreads();
                for (int i = tid; i < 64 * 32; i += 512) W3S[i] = hy_w3[(size_t)(i >> 5) * 8192 + cbk * 32 + (i & 31)];
                __syncthreads();
                float acc[8];
#pragma unroll
                for (int q = 0; q < 8; ++q) acc[q] = 0.f;
#pragma unroll 4
                for (int j = 0; j < 64; ++j) { const float hh = HS[tl * 65 + j]; const f32x4 wa = *(const LAS f32x4*)(W3S + j * 32 + cg * 8), wb = *(const LAS f32x4*)(W3S + j * 32 + cg * 8 + 4);
                    acc[0] += hh * wa.x; acc[1] += hh * wa.y; acc[2] += hh * wa.z; acc[3] += hh * wa.w; acc[4] += hh * wb.x; acc[5] += hh * wb.y; acc[6] += hh * wb.z; acc[7] += hh * wb.w; }
#pragma unroll
                for (int q = 0; q < 8; ++q) { const int col = cbk * 32 + cg * 8 + q, c = col & 2047;
                    const float a0 = -3.0701134573253944f, a1 = -15.350567286626972f; const float delta = fabsf(a0 + (float)c * ((a1 - a0) / 2047.0f));
                    FiltT[(size_t)col * SEQ + t0 + tl] = acc[q] * expf(-tlin * delta); }
            }
            __syncthreads();
        }
        if (BOTH(1)) GRID_BAR();
    }

    if (IN(2)) {
        PHASE_IDS();
        { pg8::Gemm g{WinT, Hb, HYC, MTOK, DM}; pg8::StaticOrder S; S.init(HYC, MTOK, G, bx); pg8::EpiBf16A<0> E{HyT, MTOK};
          pg8::gemm_phase<pg8::EpiBf16A<0>, pg8::StaticOrder, PG8_ALIGN, PG8_SP2>(lds, g, S, E); }
        { pg8::Gemm g{Hb, WinT + (size_t)HYC * DM, MALL, INP - HYC, DM}; pg8::AttProjOrder S{G, bx}; pg8::EpiAttProj E{QA, KVA, KR};
          pg8::gemm_phase<pg8::EpiAttProj, pg8::AttProjOrder, PG8_ALIGN, PG8_SP2>(lds, g, S, E); }
        if (BOTH(2)) GRID_BAR();
    }

    if (IN(3)) {
        PHASE_IDS();
        { pg8::Gemm g{QA, WqbT, MTOK, 3072, QLORA}; pg8::StaticOrder S; S.init(MTOK, 3072, G, bx); pg8::EpiBf16A<0> E{Qraw, 3072};
          pg8::gemm_phase<pg8::EpiBf16A<0>, pg8::StaticOrder, PG8_ALIGN, PG8_SP2>(lds, g, S, E); }
        { pg8::Gemm g{KVA, WkvbT, MALL, 4096, KVLORA}; pg8::StaticOrder S; S.init(MALL, 4096, G, bx); pg8::EpiBf16A<0> E{KVraw, 4096};
          pg8::gemm_phase<pg8::EpiBf16A<0>, pg8::StaticOrder, PG8_ALIGN, PG8_SP2>(lds, g, S, E); }
        __syncthreads();
        { hy::f2* KSb = KSall + (size_t)bx * 2 * hy::NF;
          for (int c = vcu; c < HYW; c += G) hy::hyena_channel((LAS hy::f2*)lds, tid, c, HyT, FiltT, hy_conv_w, hy_conv_b, hy_bias, KSb, YT); }
        if (BOTH(3)) GRID_BAR();
    }

    if (IN(4)) {
        PHASE_IDS();
        {
            LAS float* GQ = (LAS float*)lds; LAS float* GK = GQ + 192;
            for (int i = tid; i < 192; i += 512) { GQ[i] = q_norm_g[i]; GK[i] = k_norm_g[i]; }
            __syncthreads();
            const float inv_f = __powf(10000.0f, -(float)(lane & 15) / 16.0f);
            for (int m = gw; m < MALL; m += NGW) {
                const bool lat = m < MTOK; int b, t, key;
                if (lat) { b = m / SEQ; t = m % SEQ; key = LCTX + t; } else { b = (m - MTOK) / LCTX; t = 0; key = (m - MTOK) % LCTX; }
                float rs_kv, rs_q = 0.f;
                { const bf16x8 v = *(const bf16x8*)(KVA + (size_t)m * KVLORA + lane * 8); float s = 0.f;
#pragma unroll
                  for (int i = 0; i < 8; ++i) { const float f = bf2f((unsigned short)v[i]); s += f * f; }
                  rs_kv = 1.0f / sqrtf(wave_sum(s) * (1.f / KVLORA) + EPS); }
                if (lat) { const bf16x8 v0 = *(const bf16x8*)(QA + (size_t)m * QLORA + lane * 8), v1 = *(const bf16x8*)(QA + (size_t)m * QLORA + 512 + lane * 8); float s = 0.f;
#pragma unroll
                  for (int i = 0; i < 8; ++i) { const float f = bf2f((unsigned short)v0[i]), g2 = bf2f((unsigned short)v1[i]); s += f * f + g2 * g2; }
                  rs_q = 1.0f / sqrtf(wave_sum(s) * (1.f / QLORA) + EPS); }
                const float kr = KR[(size_t)m * 64 + lane]; const float ss_r = wave_sum(kr * kr);
                float cs = 1.f, sn = 0.f;
                if (lat) { const float pos = (float)((lane >> 5) ? (t & 63) : (t >> 6)); const float ang = pos * inv_f; cs = cosf(ang); sn = sinf(ang); }
                const float sgn = (lane & 16) ? 1.f : -1.f;
                const bf16* kvr = KVraw + (size_t)m * 4096; const bf16* qr = Qraw + (size_t)m * 3072;
#pragma unroll 2
                for (int h = 0; h < NHEAD; ++h) {
                    const float kn0 = rs_kv * bf2f(kvr[h * 256 + lane]), kn1 = rs_kv * bf2f(kvr[h * 256 + 64 + lane]);
                    const float v0 = rs_kv * bf2f(kvr[h * 256 + 128 + lane]), v1 = rs_kv * bf2f(kvr[h * 256 + 192 + lane]);
                    const float rk = 1.0f / sqrtf((wave_sum(kn0 * kn0 + kn1 * kn1) + ss_r) * (1.f / 192.f) + EPS);
                    float kx = kr * rk * GK[128 + lane]; { const float px = __shfl_xor(kx, 16); kx = kx * cs + sgn * px * sn; }
                    bf16* kd = Kb + ((size_t)(b * NHEAD + h) * SKEYS + key) * 192; bf16* vd = Vb + ((size_t)(b * NHEAD + h) * SKEYS + key) * 128;
                    kd[lane] = (bf16)f2bf(kn0 * rk * GK[lane]); kd[64 + lane] = (bf16)f2bf(kn1 * rk * GK[64 + lane]); kd[128 + lane] = (bf16)f2bf(kx);
                    vd[lane] = (bf16)f2bf(v0); vd[64 + lane] = (bf16)f2bf(v1);
                    if (lat) {
                        const float q0 = rs_q * bf2f(qr[h * 192 + lane]), q1 = rs_q * bf2f(qr[h * 192 + 64 + lane]), q2 = rs_q * bf2f(qr[h * 192 + 128 + lane]);
                        const float rq = 1.0f / sqrtf(wave_sum(q0 * q0 + q1 * q1 + q2 * q2) * (1.f / 192.f) + EPS);
                        float qx = q2 * rq * GQ[128 + lane]; { const float px = __shfl_xor(qx, 16); qx = qx * cs + sgn * px * sn; }
                        bf16* qd = Qb + ((size_t)(b * NHEAD + h) * SEQ + t) * 192;
                        qd[lane] = (bf16)f2bf(q0 * rq * GQ[lane]); qd[64 + lane] = (bf16)f2bf(q1 * rq * GQ[64 + lane]); qd[128 + lane] = (bf16)f2bf(qx);
                    }
                }
            }
            __syncthreads();
        }
        {
            LAS unsigned short* T = (LAS unsigned short*)(lds + 4096 + wave * 8704);
            for (int it = gw; it < 32 * 256; it += NGW) {
                const int c0 = (it & 31) * 64, tk0 = (it >> 5) * 64;
#pragma unroll 8
                for (int i = 0; i < 64; ++i) T[i * 66 + lane] = YT[(size_t)(c0 + i) * MTOK + tk0 + lane];
                LDS_WAIT(); asm volatile("" ::: "memory");
#pragma unroll 8
                for (int j = 0; j < 64; ++j) MIX[(size_t)(tk0 + j) * DM + c0 + lane] = T[lane * 66 + j];
                LDS_WAIT(); asm volatile("" ::: "memory");
            }
        }
        if (BOTH(4)) GRID_BAR();
    }

    if (IN(5)) {
        PHASE_IDS();
        for (int u = vcu; u < NB * NHEAD * (SEQ / 256); u += G) {
            const int bh = u >> 5, qb = u & 31, b = bh >> 4, h = bh & 15;
            att::attn_unit(Qb + ((size_t)bh * SEQ + qb * 256) * 192, Kb + (size_t)bh * SKEYS * 192, Vb + (size_t)bh * SKEYS * 128,
                           MIX + ((size_t)b * SEQ + qb * 256) * DM + HYW + h * 128, SKEYS, (char*)lds_raw);
        }
        if (BOTH(5)) GRID_BAR();
    }

    if (IN(6)) {
        PHASE_IDS();
        pg8::Gemm g{MIX, WoutT, MTOK, DM, DM}; pg8::StaticOrder S; S.init(MTOK, DM, G, bx); pg8::EpiResGate E{x_in, out_p, MODS + 2 * DM, DM};
        pg8::gemm_phase<pg8::EpiResGate, pg8::StaticOrder, PG8_ALIGN, PG8_SP2>(lds, g, S, E);
        if (BOTH(6)) GRID_BAR();
    }

    if (IN(7)) {
        PHASE_IDS();
        LAS float* SH = (LAS float*)lds; LAS float* SC = (LAS float*)(lds + 32768); LAS float* GN = (LAS float*)(lds + 65536);
        for (int i = tid; i < 2 * DM; i += 512) { const int r = i / DM, col = i % DM; SH[i] = MODS[(size_t)r * NMODC + 3 * DM + col]; SC[i] = MODS[(size_t)r * NMODC + 4 * DM + col]; }
        for (int i = tid; i < DM; i += 512) GN[i] = norm2_g[i];
        __syncthreads();
        for (int m = gw; m < MTOK; m += NGW) { const int r = m / SEQ; modulate_row(out_p + (size_t)m * DM, H2 + (size_t)m * DM, GN, SH + r * DM, SC + r * DM, lane); }
        __syncthreads();
        if (BOTH(7)) GRID_BAR();
    }

    if (IN(8)) {
        PHASE_IDS();
        pg8::Gemm g{H2, W1T, MTOK, FF, DM}; pg8::StaticOrder S; S.init(MTOK, FF, G, bx); pg8::EpiBf16A<1> E{HID, FF};
        pg8::gemm_phase<pg8::EpiBf16A<1>, pg8::StaticOrder, PG8_ALIGN, PG8_SP2>(lds, g, S, E);
        if (BOTH(8)) GRID_BAR();
    }

    if (IN(9)) {
        PHASE_IDS();
        pg8::Gemm g{HID, W2T, MTOK, DM, FF}; pg8::StaticOrder S; S.init(MTOK, DM, G, bx); pg8::EpiResGate E{out_p, out_p, MODS + 5 * DM, DM};
        pg8::gemm_phase<pg8::EpiResGate, pg8::StaticOrder, PG8_ALIGN, PG8_SP2>(lds, g, S, E);
    }
#undef PHASE_IDS
#undef IN
#undef BOTH
#undef GRID_BAR
#undef x_in
#undef cvec
#undef ctx
#undef c_ctx
#undef norm1_g
#undef norm2_g
#undef w_ada
#undef b_ada
#undef w_in
#undef hy_conv_w
#undef hy_conv_b
#undef hy_w1
#undef hy_b1
#undef hy_w2
#undef hy_b2
#undef hy_w3
#undef hy_freq
#undef hy_bias
#undef g_qa
#undef w_qb
#undef g_kva
#undef w_kvb
#undef q_norm_g
#undef k_norm_g
#undef w_out
#undef w_mlp1
#undef w_mlp2
#undef out_p
#undef MODP
#undef MODS
#undef WoutT
#undef W1T
#undef W2T
#undef WinT
#undef WqbT
#undef WkvbT
#undef Hh
#undef FiltT
#undef Hb
#undef HyT
#undef QA
#undef KVA
#undef KR
#undef Qraw
#undef KVraw
#undef YT
#undef KSall
#undef Qb
#undef Kb
#undef Vb
#undef MIX
#undef H2
#undef HID
}

extern "C" void kernel_launch(void* const* d_in, const int* in_sizes, int n_in, void* d_out, int out_size, void* d_ws, size_t ws_size, hipStream_t stream) {
    static int grid = 0;
    if (grid == 0) {
        if (n_in != 27 || out_size != MTOK * DM || ws_size < WS_END) { fprintf(stderr, "kernel_launch: unexpected shapes: n_in %d out %d ws %zu (need %zu)\n", n_in, out_size, ws_size, (size_t)WS_END); grid = -1; return; }
        int dev = 0, cus = 0, per_cu = 0;
        if (hipGetDevice(&dev) != hipSuccess || hipDeviceGetAttribute(&cus, hipDeviceAttributeMultiprocessorCount, dev) != hipSuccess) { grid = -1; return; }
        if (hipFuncSetAttribute((const void*)mega_fwd, hipFuncAttributeMaxDynamicSharedMemorySize, LDS_BYTES) != hipSuccess) { fprintf(stderr, "kernel_launch: hipFuncSetAttribute failed\n"); grid = -1; return; }
        if (hipOccupancyMaxActiveBlocksPerMultiprocessor(&per_cu, (const void*)mega_fwd, NWAVES * 64, LDS_BYTES) != hipSuccess || per_cu < 1) { fprintf(stderr, "kernel_launch: occupancy query reports %d\n", per_cu); }
        (void)hipGetLastError();
        grid = cus;
    }
    if (grid < 0) return;
    if (hipMemsetAsync((char*)d_ws + WS_CTL, 0, CTL_ZERO_BYTES, stream) != hipSuccess) return;
    Args a{};
    for (int i = 0; i < 27; ++i) a.in[i] = (const float*)d_in[i];
    a.out = (float*)d_out; a.ws = (unsigned char*)d_ws;
    for (int li = 0; li < N_LAUNCHES; ++li) {
        a.ph_lo = (N_LAUNCHES == 1) ? 0 : li; a.ph_hi = (N_LAUNCHES == 1) ? N_PHASES : li + 1; a.li = li; a.pad = 0;
        hipLaunchKernelGGL(mega_fwd, dim3(grid), dim3(NWAVES * 64), LDS_BYTES, stream, a);
        const hipError_t le = hipPeekAtLastError();
        if (le != hipSuccess) { fprintf(stderr, "kernel_launch: launch %d failed: %s\n", li, hipGetErrorName(le)); break; }
    }
}
```

```cpp
#include <hip/hip_runtime.h>
#include <cstdio>
#include <cstdint>
#define GEXP 0
#ifndef MK_N_LAUNCHES
#define MK_N_LAUNCHES 1
#endif
namespace pg8 {
#define PG8_LAS __attribute__((address_space(3)))
typedef unsigned short bf16_t;
typedef short bf16x8 __attribute__((ext_vector_type(8)));
typedef float f32x4 __attribute__((ext_vector_type(4)));
typedef unsigned u32x4 __attribute__((ext_vector_type(4)));
typedef int i32x4 __attribute__((ext_vector_type(4)));
typedef int i32x8 __attribute__((ext_vector_type(8)));
constexpr int BM = 256, BK = 64, HALF = 128, HTB = HALF * BK * 2  , STAGE_BYTES = 8 * HTB, NXCD = 8, WGM = 4;

__host__ __device__ __forceinline__ int lds_byte(int r, int c) { const int st = (r >> 4) * 2 + (c >> 5), rr = r & 15, cc = c & 31, ob = rr * 64 + cc * 2; return st * 1024 + (ob ^ (((ob >> 9) & 1) << 5)); }
__host__ __device__ __forceinline__ void stage_rc(int b, int& R, int& C) { const int st = b / 1024, sb = b % 1024, swz = sb ^ (((sb >> 9) & 1) << 5); R = (st >> 1) * 16 + swz / 64; C = (st & 1) * 32 + (swz % 64) / 2; }
__host__ __device__ __forceinline__ int perm32(int rho) { const int n = rho >> 4, i = rho & 15; return 8 * (i >> 2) + 4 * n + (i & 3); }

struct Unit { int pm, pn; };
struct Gemm { const bf16_t* A; const bf16_t* Bt; int M, N, K; int tsplit = 0; };

struct StaticOrder {
    int nM, nN, nwg, G, c;
    __host__ __device__ void init(int M, int N, int G_, int c_) { nM = M / BM; nN = N / BM; nwg = nM * nN; G = G_; c = c_; }
    __host__ __device__ bool next(int i, Unit& u) const {
        const long L = (long)i * G + c; if (L >= nwg) return false;
        int wgid = (int)L; { const int q = nwg / NXCD, r = nwg % NXCD, xcd = wgid % NXCD, off = wgid / NXCD; wgid = (xcd < r ? xcd * (q + 1) : r * (q + 1) + (xcd - r) * q) + off; }
        const int nig = WGM * nN, gid = wgid / nig, fm = gid * WGM, gsz = (nM - fm) < WGM ? (nM - fm) : WGM;
        u.pm = fm + ((wgid % nig) % gsz); u.pn = (wgid % nig) / gsz; return true;
    }
    __device__ __forceinline__ void a_ready(const Unit&) const {}
    __device__ __forceinline__ void done(const Unit&) const {}
};

__device__ __forceinline__ unsigned cvt_pk_bf16(float lo, float hi) { unsigned r; asm volatile("v_cvt_pk_bf16_f32 %0, %1, %2" : "=v"(r) : "v"(lo), "v"(hi)); return r; }
typedef float f32x2 __attribute__((ext_vector_type(2)));
template <int ACT> struct EpiBf16A {
    static constexpr bool PERM = true, AFTER_DRAIN = false;
    bf16_t* O; int ldc; float s;
    __device__ __forceinline__ void operator()(const f32x4 (&acc)[2][2][4][2], const Unit& u, int wr, int wc, int fr, int fq) const {
        const int row0 = u.pm * BM + wr * 64 + fr, col0 = u.pn * BM + wc * 32 + 8 * fq;
#pragma unroll
        for (int ai = 0; ai < 2; ++ai)
#pragma unroll
            for (int m = 0; m < 4; ++m) { bf16_t* rowp = O + (size_t)(row0 + ai * HALF + m * 16) * ldc + col0;
#pragma unroll
                for (int bj = 0; bj < 2; ++bj) { f32x4 v0 = acc[ai][bj][m][0] * s, v1 = acc[ai][bj][m][1] * s;
                    if (ACT == 1) {
#pragma unroll
                        for (int j = 0; j < 4; ++j) { const float a = fmaxf(v0[j], 0.f), b = fmaxf(v1[j], 0.f); v0[j] = a * a; v1[j] = b * b; } }
                    u32x4 w; w.x = cvt_pk_bf16(v0[0], v0[1]); w.y = cvt_pk_bf16(v0[2], v0[3]); w.z = cvt_pk_bf16(v1[0], v1[1]); w.w = cvt_pk_bf16(v1[2], v1[3]);
                    *(u32x4*)(rowp + bj * HALF) = w; } }
    }
};
__device__ __forceinline__ unsigned pack4_fp8(float a, float b, float c, float d) {
    a = fminf(a, 448.f); b = fminf(b, 448.f); c = fminf(c, 448.f); d = fminf(d, 448.f);
    int w = 0; w = __builtin_amdgcn_cvt_pk_fp8_f32(a, b, w, false); w = __builtin_amdgcn_cvt_pk_fp8_f32(c, d, w, true); return (unsigned)w; }
struct EpiF8A {
    static constexpr bool PERM = true, AFTER_DRAIN = false;
    unsigned char* O; int ldc; float s;
    __device__ __forceinline__ void operator()(const f32x4 (&acc)[2][2][4][2], const Unit& u, int wr, int wc, int fr, int fq) const {
        const int row0 = u.pm * BM + wr * 64 + fr, col0 = u.pn * BM + wc * 32 + 8 * fq;
#pragma unroll
        for (int ai = 0; ai < 2; ++ai)
#pragma unroll
            for (int m = 0; m < 4; ++m) { unsigned char* rowp = O + (size_t)(row0 + ai * HALF + m * 16) * ldc + col0;
#pragma unroll
                for (int bj = 0; bj < 2; ++bj) { const f32x4 v0 = acc[ai][bj][m][0] * s, v1 = acc[ai][bj][m][1] * s;
                    typedef unsigned u32x2 __attribute__((ext_vector_type(2)));
                    u32x2 w; w.x = pack4_fp8(fmaxf(v0[0], -448.f), fmaxf(v0[1], -448.f), fmaxf(v0[2], -448.f), fmaxf(v0[3], -448.f)); w.y = pack4_fp8(fmaxf(v1[0], -448.f), fmaxf(v1[1], -448.f), fmaxf(v1[2], -448.f), fmaxf(v1[3], -448.f));
                    *(u32x2*)(rowp + bj * HALF) = w; } }
    }
};
struct EpiF8Relu2 {
    static constexpr bool PERM = true, AFTER_DRAIN = false;
    unsigned char* O; int ldc; float s;
    __device__ __forceinline__ void operator()(const f32x4 (&acc)[2][2][4][2], const Unit& u, int wr, int wc, int fr, int fq) const {
        const int row0 = u.pm * BM + wr * 64 + fr, col0 = u.pn * BM + wc * 32 + 8 * fq;
#pragma unroll
        for (int ai = 0; ai < 2; ++ai)
#pragma unroll
            for (int m = 0; m < 4; ++m) { unsigned char* rowp = O + (size_t)(row0 + ai * HALF + m * 16) * ldc + col0;
#pragma unroll
                for (int bj = 0; bj < 2; ++bj) { f32x4 v0 = acc[ai][bj][m][0] * s, v1 = acc[ai][bj][m][1] * s;
#pragma unroll
                    for (int j = 0; j < 4; ++j) { const float a = fmaxf(v0[j], 0.f), b = fmaxf(v1[j], 0.f); v0[j] = a * a; v1[j] = b * b; }
                    typedef unsigned u32x2 __attribute__((ext_vector_type(2)));
                    u32x2 w; w.x = pack4_fp8(v0[0], v0[1], v0[2], v0[3]); w.y = pack4_fp8(v1[0], v1[1], v1[2], v1[3]);
                    *(u32x2*)(rowp + bj * HALF) = w; } }
    }
};
struct EpiAttProj {
    static constexpr bool PERM = true, AFTER_DRAIN = false;
    unsigned char* QA; unsigned char* KVA; float* KR; float s;
    __device__ __forceinline__ void operator()(const f32x4 (&acc)[2][2][4][2], const Unit& u, int wr, int wc, int fr, int fq) const {
        const int row0 = u.pm * BM + wr * 64 + fr;
        if (u.pn < 6) {
            unsigned char* base = u.pn < 4 ? QA : KVA; const int ldc = u.pn < 4 ? 1024 : 512; const int col0 = (u.pn < 4 ? u.pn : u.pn - 4) * BM + wc * 32 + 8 * fq;
#pragma unroll
            for (int ai = 0; ai < 2; ++ai)
#pragma unroll
                for (int m = 0; m < 4; ++m) { unsigned char* rowp = base + (size_t)(row0 + ai * HALF + m * 16) * ldc + col0;
#pragma unroll
                    for (int bj = 0; bj < 2; ++bj) { const f32x4 v0 = acc[ai][bj][m][0] * s, v1 = acc[ai][bj][m][1] * s;
                        typedef unsigned u32x2 __attribute__((ext_vector_type(2)));
                        u32x2 w; w.x = pack4_fp8(fmaxf(v0[0], -448.f), fmaxf(v0[1], -448.f), fmaxf(v0[2], -448.f), fmaxf(v0[3], -448.f)); w.y = pack4_fp8(fmaxf(v1[0], -448.f), fmaxf(v1[1], -448.f), fmaxf(v1[2], -448.f), fmaxf(v1[3], -448.f));
                        *(u32x2*)(rowp + bj * HALF) = w; } }
        } else if (wc < 2) {
            const int col0 = wc * 32 + 8 * fq;
#pragma unroll
            for (int ai = 0; ai < 2; ++ai)
#pragma unroll
                for (int m = 0; m < 4; ++m) { float* rowp = KR + (size_t)(row0 + ai * HALF + m * 16) * 64 + col0;
                    *(f32x4*)(rowp) = acc[ai][0][m][0] * s; *(f32x4*)(rowp + 4) = acc[ai][0][m][1] * s; }
        }
    }
};
struct EpiResGate {
    static constexpr bool PERM = false, AFTER_DRAIN = false;
    const float* base; float* out; const float* gate; int ldc; float scale;
    __device__ __forceinline__ void operator()(const f32x4 (&acc)[2][2][4][2], const Unit& u, int wr, int wc, int fr, int fq) const {
        const int row0 = u.pm * BM + wr * 64 + fr, col0 = u.pn * BM + wc * 32 + 4 * fq;
        const float* g = gate + (size_t)(u.pm >> 5) * 24576;
        f32x4 gv[2][2];
#pragma unroll
        for (int bj = 0; bj < 2; ++bj)
#pragma unroll
            for (int n = 0; n < 2; ++n) gv[bj][n] = *(const f32x4*)(g + col0 + bj * HALF + n * 16) * scale;
#pragma unroll
        for (int ai = 0; ai < 2; ++ai)
#pragma unroll
            for (int m = 0; m < 4; ++m) { const size_t off = (size_t)(row0 + ai * HALF + m * 16) * ldc + col0;
#pragma unroll
                for (int bj = 0; bj < 2; ++bj)
#pragma unroll
                    for (int n = 0; n < 2; ++n) { const f32x4 bs = *(const f32x4*)(base + off + bj * HALF + n * 16); *(f32x4*)(out + off + bj * HALF + n * 16) = bs + gv[bj][n] * acc[ai][bj][m][n]; }
                if (m == 3) asm volatile("" ::: "memory"); }
    }
};
struct AttProjOrder {
    int G, c;
    __device__ __forceinline__ bool next(int i, Unit& u) const {
        const long L = (long)i * G + c; if (L >= 454) return false;
        int wgid = (int)L; { const int q = 454 / NXCD, r = 454 % NXCD, xcd = wgid % NXCD, off = wgid / NXCD; wgid = (xcd < r ? xcd * (q + 1) : r * (q + 1) + (xcd - r) * q) + off; }
        if (wgid < 448) { u.pm = wgid / 7; u.pn = wgid % 7; } else { const int r2 = wgid - 448; u.pm = 64 + r2 / 3; u.pn = 4 + r2 % 3; }
        return true;
    }
    __device__ __forceinline__ void a_ready(const Unit&) const {}
    __device__ __forceinline__ void done(const Unit&) const {}
};
template <class Epi, class Sched, bool ALIGN_EPI = false, bool SP2 = false, int FP8 = 0  , int EXP = 0  >
__device__ __forceinline__ void gemm_phase(PG8_LAS unsigned char* lds, const Gemm g, const Sched& S, const Epi& E) {
    int tid_o = threadIdx.x; asm volatile("" : "+v"(tid_o));
    const int tid = tid_o, wid = __builtin_amdgcn_readfirstlane(tid >> 6), lane = tid & 63, wr = wid >> 2, wc = wid & 3, fr = lane & 15, fq = lane >> 4;
    const int K = g.K, nt = K / BK;
    unsigned voffA[2], voffB[2];
#pragma unroll
    for (int i = 0; i < 2; ++i) { int R, C; stage_rc(tid * 16 + i * 8192, R, C); const int Rb = Epi::PERM ? ((R & ~31) + perm32(R & 31)) : R;
        voffA[i] = (unsigned)(R * K + C) * 2u; voffB[i] = (unsigned)(Rb * K + C) * 2u; }
    const size_t kstep = (size_t)(BK * 2);
    const size_t hstep = (size_t)HALF * K * 2;
    const size_t tstep = 2 * hstep;
    const unsigned ldsw = (unsigned)wid * 1024u;
    const int aoff = lds_byte(wr * 64 + fr, fq * 8), boff = lds_byte(wc * 32 + fr, fq * 8);
#define PG8_SA(b, h) (((b) * 2 + (h)) * HTB)
#define PG8_SB(b, h) ((4 + (b) * 2 + (h)) * HTB)
#define PG8_STAGE(bufoff, gbase, voff) do { _Pragma("unroll") for (int _i = 0; _i < 2; ++_i) \
        __builtin_amdgcn_global_load_lds((const unsigned*)((const char*)(gbase) + (voff)[_i]), (PG8_LAS unsigned*)(lds + (bufoff) + ldsw + _i * 8192), 16, 0, 0); } while (0)
#define PG8_STAGE_L(bufoff, gbase, voff) do { if constexpr (EXP != 3) PG8_STAGE(bufoff, gbase, voff); } while (0)
#define PG8_CAT(v0, v1) __builtin_shufflevector(v0, v1, 0, 1, 2, 3, 4, 5, 6, 7)
#define PG8_LDA(dst, b, h) do { _Pragma("unroll") for (int m = 0; m < 4; ++m) { if constexpr (FP8) dst##8[m] = PG8_CAT(*(const PG8_LAS i32x4*)(lds + PG8_SA(b, h) + aoff + m * 2048), *(const PG8_LAS i32x4*)(lds + PG8_SA(b, h) + aoff + m * 2048 + 1024)); \
        else { _Pragma("unroll") for (int k = 0; k < 2; ++k) dst[m][k] = *(const PG8_LAS bf16x8*)(lds + PG8_SA(b, h) + aoff + m * 2048 + k * 1024); } } } while (0)
#define PG8_LDB(dst, b, h) do { _Pragma("unroll") for (int n = 0; n < 2; ++n) { if constexpr (FP8) dst##8[n] = PG8_CAT(*(const PG8_LAS i32x4*)(lds + PG8_SB(b, h) + boff + n * 2048), *(const PG8_LAS i32x4*)(lds + PG8_SB(b, h) + boff + n * 2048 + 1024)); \
        else { _Pragma("unroll") for (int k = 0; k < 2; ++k) dst[n][k] = *(const PG8_LAS bf16x8*)(lds + PG8_SB(b, h) + boff + n * 2048 + k * 1024); } } } while (0)
#define PG8_MMA(ai, bj, At, Bt) do { __builtin_amdgcn_s_setprio(1); _Pragma("unroll") for (int m = 0; m < 4; ++m) _Pragma("unroll") for (int n = 0; n < 2; ++n) { \
        if constexpr (EXP == 2) { asm volatile("" :: "v"(Bt##8[n]), "v"(At##8[m])); } else if constexpr (PG8_F == 1) asm volatile("s_nop 1\n\tv_mfma_scale_f32_16x16x128_f8f6f4 %0, %1, %2, %0, %3, %3 op_sel_hi:[0,0,0]" : "+v"(acc[ai][bj][m][n]) : "v"(Bt##8[n]), "v"(At##8[m]), "v"(f8scale)); \
        else if constexpr (PG8_F == 2) asm volatile("s_nop 1\n\tv_mfma_scale_f32_16x16x128_f8f6f4 %0, %1, %2, %0, %3, %4 op_sel_hi:[0,0,0] cbsz:2 blgp:2" : "+v"(acc[ai][bj][m][n]) \
            : "v"(__builtin_shufflevector(Bt##8[n], Bt##8[n], 0, 1, 2, 3, 4, 5)), "v"(__builtin_shufflevector(At##8[m], At##8[m], 0, 1, 2, 3, 4, 5)), "v"(Bt##8[n][6]), "v"(At##8[m][6])); \
        else if constexpr (FP8 == 3) { _Pragma("unroll") for (int k = 0; k < 2; ++k) { if (k == 0) asm volatile("s_nop 1\n\tv_mfma_f32_16x16x32_bf16 %0, %1, %2, %0" : "+v"(acc[ai][bj][m][n]) : "v"(__builtin_shufflevector(Bt##8[n], Bt##8[n], 0, 1, 2, 3)), "v"(__builtin_shufflevector(At##8[m], At##8[m], 0, 1, 2, 3))); \
            else asm volatile("s_nop 1\n\tv_mfma_f32_16x16x32_bf16 %0, %1, %2, %0" : "+v"(acc[ai][bj][m][n]) : "v"(__builtin_shufflevector(Bt##8[n], Bt##8[n], 4, 5, 6, 7)), "v"(__builtin_shufflevector(At##8[m], At##8[m], 4, 5, 6, 7))); } }   \
        else { _Pragma("unroll") for (int k = 0; k < 2; ++k) acc[ai][bj][m][n] = __builtin_amdgcn_mfma_f32_16x16x32_bf16(Bt[n][k], At[m][k], acc[ai][bj][m][n], 0, 0, 0); } } __builtin_amdgcn_s_setprio(0); } while (0)
#define PG8_F (FP8 == 3 ? 2 : FP8)
#define PG8_WAIT_V(n) asm volatile("s_waitcnt vmcnt(" #n ")" ::: "memory")
#define PG8_WAIT_L(n) asm volatile("s_waitcnt lgkmcnt(" #n ")" ::: "memory")
#define PG8_BAR __builtin_amdgcn_s_barrier()
#define PG8_SCHED __builtin_amdgcn_sched_barrier(0)
#define PG8_SP2_BODY \
            PG8_LDB(B0, 0, 0); PG8_LDB(B1, 0, 1); PG8_SCHED; PG8_LDA(At, 0, 0); PG8_STAGE_L(PG8_SA(1, 1), a1 + hstep, voffA); \
            PG8_WAIT_V(8); PG8_WAIT_L(0); PG8_BAR; PG8_MMA(0, 0, At, B0); PG8_MMA(0, 1, At, B1); PG8_BAR; PG8_SCHED; \
            PG8_LDA(At, 0, 1); PG8_STAGE_L(PG8_SB(0, 0), b2, voffB); PG8_STAGE_L(PG8_SB(0, 1), b2 + hstep, voffB); PG8_STAGE_L(PG8_SA(0, 0), a2, voffA); \
            PG8_WAIT_V(8); PG8_WAIT_L(0); PG8_BAR; PG8_MMA(1, 0, At, B0); PG8_MMA(1, 1, At, B1); PG8_BAR; PG8_SCHED; \
            PG8_LDB(B0, 1, 0); PG8_LDB(B1, 1, 1); PG8_SCHED; PG8_LDA(At, 1, 0); PG8_STAGE_L(PG8_SA(0, 1), a2 + hstep, voffA); \
            PG8_WAIT_V(8); PG8_WAIT_L(0); PG8_BAR; PG8_MMA(0, 0, At, B0); PG8_MMA(0, 1, At, B1); PG8_BAR; PG8_SCHED; \
            PG8_LDA(At, 1, 1); PG8_STAGE_L(PG8_SB(1, 0), b3, voffB); PG8_STAGE_L(PG8_SB(1, 1), b3 + hstep, voffB); PG8_STAGE_L(PG8_SA(1, 0), a3, voffA); \
            PG8_WAIT_V(8); PG8_WAIT_L(0); PG8_BAR; PG8_MMA(1, 0, At, B0); PG8_MMA(1, 1, At, B1); PG8_BAR; PG8_SCHED;
    Unit cur, nxt; int ui = 0;
    if (!S.next(0, cur)) return;
    f32x4 acc[2][2][4][2];
#pragma unroll
    for (int a = 0; a < 2; ++a)
#pragma unroll
        for (int b = 0; b < 2; ++b)
#pragma unroll
            for (int m = 0; m < 4; ++m)
#pragma unroll
                for (int n = 0; n < 2; ++n) acc[a][b][m][n] = (f32x4){0.f, 0.f, 0.f, 0.f};
    const int f8scale = 0x7f7f7f7f;
    bf16x8 At[4][2], B0[2][2], B1[2][2]; i32x8 At8[4], B08[2], B18[2];
    const char* cA = (const char*)g.A + (size_t)(EXP == 1 ? 0 : cur.pm) * tstep; const char* cB = (const char*)g.Bt + (size_t)(EXP == 1 ? 0 : cur.pn) * tstep;
    S.a_ready(cur);
    if constexpr (SP2) {
        PG8_STAGE(PG8_SB(0, 0), cB, voffB); PG8_STAGE(PG8_SB(0, 1), cB + hstep, voffB); PG8_STAGE(PG8_SA(0, 0), cA, voffA); PG8_STAGE(PG8_SA(0, 1), cA + hstep, voffA);
        if (wr == 1) PG8_BAR;
        PG8_WAIT_V(2); PG8_BAR;
        PG8_STAGE(PG8_SB(1, 0), cB + kstep, voffB); PG8_STAGE(PG8_SA(1, 0), cA + kstep, voffA); PG8_STAGE(PG8_SB(1, 1), cB + hstep + kstep, voffB);
        PG8_WAIT_V(6); PG8_BAR;
    } else {
        PG8_STAGE(PG8_SB(0, 0), cB, voffB); PG8_STAGE(PG8_SA(0, 0), cA, voffA); PG8_STAGE(PG8_SB(0, 1), cB + hstep, voffB); PG8_STAGE(PG8_SA(0, 1), cA + hstep, voffA);
        if (wr == 1) PG8_BAR;
        PG8_WAIT_V(4); PG8_BAR;
        PG8_STAGE(PG8_SB(1, 0), cB + kstep, voffB); PG8_STAGE(PG8_SA(1, 0), cA + kstep, voffA); PG8_STAGE(PG8_SB(1, 1), cB + hstep + kstep, voffB);
        PG8_WAIT_V(6); PG8_BAR;
    }
    for (;;) {
        const bool has_next = S.next(ui + 1, nxt);
        const char* nA = (has_next && EXP != 1) ? (const char*)g.A + (size_t)nxt.pm * tstep : cA; const char* nB = (has_next && EXP != 1) ? (const char*)g.Bt + (size_t)nxt.pn * tstep : cB;
        int t = 0;
        if constexpr (FP8 == 3) {
            for (; t < g.tsplit; t += 2) {
                const char* a1 = cA + (size_t)(t + 1) * kstep; const char* a2 = cA + (size_t)(t + 2) * kstep; const char* b2 = cB + (size_t)(t + 2) * kstep; const char* a3 = a2 + kstep; const char* b3 = b2 + kstep;
#undef PG8_F
#define PG8_F 0
                PG8_SP2_BODY
#undef PG8_F
#define PG8_F (FP8 == 3 ? 2 : FP8)
            }
        }
        for (; t < nt; t += 2) {
            const bool last = (t == nt - 2);
            const char* a1 = cA + (size_t)(t + 1) * kstep;
            const char* a2 = last ? nA : cA + (size_t)(t + 2) * kstep; const char* b2 = last ? nB : cB + (size_t)(t + 2) * kstep;
            const char* a3 = a2 + kstep; const char* b3 = b2 + kstep;
            if (last && has_next) S.a_ready(nxt);
            if constexpr (SP2) {
            PG8_SP2_BODY
            } else {
            PG8_LDB(B0, 0, 0); PG8_SCHED; PG8_LDA(At, 0, 0); PG8_STAGE_L(PG8_SA(1, 1), a1 + hstep, voffA);
            PG8_WAIT_L(8); PG8_BAR; PG8_WAIT_L(0); PG8_MMA(0, 0, At, B0); PG8_BAR; PG8_SCHED;
            PG8_LDB(B1, 0, 1); PG8_STAGE_L(PG8_SB(0, 0), b2, voffB);
            PG8_BAR; PG8_WAIT_L(0); PG8_MMA(0, 1, At, B1); PG8_BAR;
            PG8_LDA(At, 0, 1); PG8_STAGE_L(PG8_SA(0, 0), a2, voffA);
            PG8_BAR; PG8_WAIT_L(0); PG8_MMA(1, 0, At, B0); PG8_BAR; PG8_SCHED;
            PG8_STAGE_L(PG8_SB(0, 1), b2 + hstep, voffB);
            PG8_WAIT_V(6); PG8_BAR; PG8_MMA(1, 1, At, B1); PG8_BAR;
            PG8_LDB(B0, 1, 0); PG8_SCHED; PG8_LDA(At, 1, 0); PG8_STAGE_L(PG8_SA(0, 1), a2 + hstep, voffA);
            PG8_WAIT_L(8); PG8_BAR; PG8_WAIT_L(0); PG8_MMA(0, 0, At, B0); PG8_BAR; PG8_SCHED;
            PG8_LDB(B1, 1, 1); PG8_STAGE_L(PG8_SB(1, 0), b3, voffB);
            PG8_BAR; PG8_WAIT_L(0); PG8_MMA(0, 1, At, B1); PG8_BAR;
            PG8_LDA(At, 1, 1); PG8_STAGE_L(PG8_SA(1, 0), a3, voffA);
            PG8_BAR; PG8_WAIT_L(0); PG8_MMA(1, 0, At, B0); PG8_BAR; PG8_SCHED;
            PG8_STAGE_L(PG8_SB(1, 1), b3 + hstep, voffB);
            PG8_WAIT_V(6); PG8_BAR; PG8_MMA(1, 1, At, B1); PG8_BAR;
            }
        }
        if constexpr (FP8) asm volatile("s_nop 15\n\ts_nop 15" ::: "memory");
        if constexpr (ALIGN_EPI) { if (wr == 0) PG8_BAR; }
        if constexpr (!Epi::AFTER_DRAIN) { E(acc, cur, wr, wc, fr, fq); S.done(cur); }
        if (!has_next) break;
#pragma unroll
        for (int a = 0; a < 2; ++a)
#pragma unroll
            for (int b = 0; b < 2; ++b)
#pragma unroll
                for (int m = 0; m < 4; ++m)
#pragma unroll
                    for (int n = 0; n < 2; ++n) acc[a][b][m][n] = (f32x4){0.f, 0.f, 0.f, 0.f};
        if constexpr (FP8) asm volatile("s_nop 7" ::: "memory");
        cur = nxt; cA = nA; cB = nB; ++ui;
        if constexpr (ALIGN_EPI) { if (wr == 1) PG8_BAR; }
    }
    PG8_WAIT_V(0);
    if constexpr (!ALIGN_EPI) { if (wr == 0) PG8_BAR; }
    PG8_BAR;
    if constexpr (Epi::AFTER_DRAIN) { E.fused(acc, cur, wr, wc, fr, fq, lds, wid, lane); S.done(cur); }
#undef PG8_SA
#undef PG8_SB
#undef PG8_STAGE
#undef PG8_SP2_BODY
#undef PG8_F
#undef PG8_STAGE_L
#undef PG8_LDA
#undef PG8_LDB
#undef PG8_MMA
#undef PG8_CAT
#undef PG8_WAIT_V
#undef PG8_WAIT_L
#undef PG8_BAR
#undef PG8_SCHED
}
}
#ifndef PG8_SP2
#define PG8_SP2 true
#endif
#ifndef PG8_SP2F8
#define PG8_SP2F8 true
#endif
#ifndef PG8_ALIGN
#define PG8_ALIGN true
#endif
#define GAS __attribute__((address_space(1)))
#define LAS __attribute__((address_space(3)))
typedef unsigned short bf16;
typedef unsigned v4u __attribute__((ext_vector_type(4)));
typedef float f32x4 __attribute__((ext_vector_type(4)));
typedef short bf16x8 __attribute__((ext_vector_type(8)));
typedef GAS unsigned gu32;
typedef GAS unsigned long long gu64;
#define RLX_AGENT __ATOMIC_RELAXED, __HIP_MEMORY_SCOPE_AGENT
#define LDS_WAIT() asm volatile("s_waitcnt lgkmcnt(0)" ::: "memory")
#define VM_WAIT() asm volatile("s_waitcnt vmcnt(0)" ::: "memory")
__device__ __forceinline__ unsigned long long rt() { return __builtin_amdgcn_s_memrealtime(); }
__device__ __forceinline__ unsigned f2bf(float f) { unsigned u = __builtin_bit_cast(unsigned, f); return (u + 0x7fffu + ((u >> 16) & 1u)) >> 16; }
__device__ __forceinline__ unsigned pk2(float lo, float hi) { return f2bf(lo) | (f2bf(hi) << 16); }
typedef float f32x16v __attribute__((ext_vector_type(16)));
typedef int i32x6v __attribute__((ext_vector_type(6)));
__device__ __forceinline__ void mx6_pack(f32x16v a, f32x16v b, v4u& lo, v4u& hi) {
    float mx = 0.f;
#pragma unroll
    for (int i = 0; i < 16; ++i) mx = fmaxf(mx, fmaxf(fabsf(a[i]), fabsf(b[i])));
    int sb = (int)((__float_as_uint(mx) >> 23) & 0xffu) - 2; sb = sb < 1 ? 1 : sb;
    const float mult = __uint_as_float((unsigned)(254 - sb) << 23);
#pragma unroll
    for (int i = 0; i < 16; ++i) { a[i] = fminf(fmaxf(a[i] * mult, -7.5f), 7.5f); b[i] = fminf(fmaxf(b[i] * mult, -7.5f), 7.5f); }
    const i32x6v p = __builtin_amdgcn_cvt_scalef32_2xpk16_fp6_f32(a, b, 1.0f);
    lo = (v4u){(unsigned)p[0], (unsigned)p[1], (unsigned)p[2], (unsigned)p[3]}; hi = (v4u){(unsigned)p[4], (unsigned)p[5], (unsigned)sb, 0u};
}
__device__ __forceinline__ size_t mx6_off(int blk) { return (size_t)(blk >> 2) * 128 + 16 * (blk & 3); }
#define XB_TMO      128
#define XB_XCNT(j)  (256  + 64 * (j))
#define XB_XSUB(j)  (1280 + 64 * (j))
#define XB_XGEN(j)  (2304 + 64 * (j))
#define XB_TOP      3328
#define XB_TOPGEN   3392
#define XCD_BAR_WORDS 3456
#define XB_SPIN_CAP (1u << 18)

__device__ __forceinline__ unsigned xb_ld(unsigned* p)              { return __hip_atomic_load(p, __ATOMIC_RELAXED, __HIP_MEMORY_SCOPE_AGENT); }
__device__ __forceinline__ unsigned xb_add(unsigned* p, unsigned v) { return __hip_atomic_fetch_add(p, v, __ATOMIC_RELAXED, __HIP_MEMORY_SCOPE_AGENT); }
__device__ __forceinline__ unsigned xb_xcc_id() { return (unsigned)__builtin_amdgcn_s_getreg((3 << 11) | 20) & 0xFu; }
#define XB_SPIN(cond, bar) do { unsigned _sp = 0; while (cond) { __builtin_amdgcn_s_sleep(1); \
    if ((++_sp & 255u) == 0u) { if (xb_ld(&(bar)[XB_TMO])) break; if (_sp > XB_SPIN_CAP) { atomicAdd(&(bar)[XB_TMO], 1u); break; } } } } while (0)

struct XcdBarrier {
    unsigned* bar; unsigned x;
    volatile LAS unsigned* st;
};

__device__ __forceinline__ XcdBarrier xcd_barrier_post(unsigned* bar, volatile LAS unsigned* st) {
    XcdBarrier b; b.bar = bar; b.x = xb_xcc_id(); b.st = st;
    if (threadIdx.x == 0) (void)xb_add(&bar[XB_XCNT(b.x)], 1u);
    return b;
}
__device__ __forceinline__ void xcd_barrier_complete(unsigned* bar, unsigned x, unsigned& nloc, unsigned& nx) {
    const unsigned G = gridDim.x * gridDim.y * gridDim.z;
    unsigned sum, cnt, mine, sp = 0u;
    for (;;) {
        sum = 0u; cnt = 0u; mine = 0u;
#pragma unroll
        for (unsigned j = 0; j < 16; ++j) { const unsigned c = xb_ld(&bar[XB_XCNT(j)]); sum += c; cnt += (c > 0u) ? 1u : 0u; mine = (j == x) ? c : mine; }
        if (sum == G) break;
        __builtin_amdgcn_s_sleep(1);
        if ((++sp & 255u) == 0u) { if (xb_ld(&bar[XB_TMO])) break; if (sp > XB_SPIN_CAP) { atomicAdd(&bar[XB_TMO], 1u); break; } }
    }
    nloc = mine > 0u ? mine : 1u; nx = cnt > 0u ? cnt : 1u;
}

__device__ __forceinline__ void xcd_barrier(const XcdBarrier& b) {
    asm volatile("s_waitcnt vmcnt(0)" ::: "memory");
    __syncthreads();
    if (threadIdx.x == 0) {
        unsigned* bar = b.bar;
        __builtin_amdgcn_s_waitcnt(0);
        unsigned nloc = b.st[0], nx = b.st[1];
        if (nloc == 0u) { xcd_barrier_complete(bar, b.x, nloc, nx); b.st[0] = nloc; b.st[1] = nx; }
        const unsigned old = xb_add(&bar[XB_XSUB(b.x)], 1u);
        const unsigned gen = old / nloc;
        if (old + 1u == (gen + 1u) * nloc) {
            __builtin_amdgcn_fence(__ATOMIC_RELEASE, "agent");
            asm volatile("s_waitcnt vmcnt(0)" ::: "memory");
            const unsigned og = xb_add(&bar[XB_TOP], 1u);
            const unsigned tg = og / nx;
            if (og + 1u == (tg + 1u) * nx) xb_add(&bar[XB_TOPGEN], 1u);
            else XB_SPIN(xb_ld(&bar[XB_TOPGEN]) == tg, bar);
            __builtin_amdgcn_fence(__ATOMIC_ACQUIRE, "agent");
            xb_add(&bar[XB_XGEN(b.x)], 1u);
            asm volatile("s_waitcnt vmcnt(0)" ::: "memory");
        } else {
            XB_SPIN(xb_ld(&bar[XB_XGEN(b.x)]) == gen, bar);
            __builtin_amdgcn_fence(__ATOMIC_ACQUIRE, "agent");
            asm volatile("s_waitcnt vmcnt(0)" ::: "memory");
        }
    }
    __syncthreads();
}
namespace att8 {
typedef unsigned short bf16;
using i32x4 = __attribute__((ext_vector_type(4))) int;
using i32x8 = __attribute__((ext_vector_type(8))) int;
using i32x2 = __attribute__((ext_vector_type(2))) int;
using f32x16 = __attribute__((ext_vector_type(16))) float;
constexpr int DQ = 192, DVV = 128, NW = 8, QBLK = 32, KVBLK = 64;
constexpr float SCALE = 0.07216878364870323f;
constexpr float THR = 3.f, POFF = 4.f;
constexpr int SHM_V = DVV * KVBLK, SHM_K = KVBLK * DQ, SHM_ATTN = 2 * SHM_V + 2 * SHM_K + NW * 64 * 4;
#define A8BAR() __builtin_amdgcn_sched_barrier(0)
__device__ __forceinline__ int crow(int r, int hi) { return (r & 3) + 8 * (r >> 2) + 4 * hi; }
__device__ __forceinline__ int k_off(int r, int s) { return r * 192 + (((s & ~3) | ((s & 3) ^ ((r >> 2) & 3))) << 4); }
__device__ __forceinline__ int v_off(int c, int s) { return c * 64 + ((s ^ ((c >> 2) & 3)) << 4); }
__device__ __forceinline__ f32x16 mfma8(i32x8 a, i32x8 b, f32x16 c) { return __builtin_amdgcn_mfma_scale_f32_32x32x64_f8f6f4(a, b, c, 0, 0, 0, 0x7f7f7f7f, 0, 0x7f7f7f7f); }
#define A8CAT(v0, v1) __builtin_shufflevector(v0, v1, 0, 1, 2, 3, 4, 5, 6, 7)

__device__ __forceinline__ void partialSM(f32x16& p0, f32x16& p1, float& m_reg, float& mn, float& alpha) {
  constexpr float C = SCALE * 1.4426950408889634f;
  float pmax = p0[0];
#pragma unroll
  for (int r = 1; r < 16; ++r) pmax = fmaxf(pmax, p0[r]);
#pragma unroll
  for (int r = 0; r < 16; ++r) pmax = fmaxf(pmax, p1[r]);
  { auto rr = __builtin_amdgcn_permlane32_swap(__float_as_uint(pmax), __float_as_uint(pmax), false, false);
    pmax = fmaxf(__uint_as_float(rr[0]), __uint_as_float(rr[1])); }
  if (__builtin_expect(__all(pmax - m_reg <= THR / SCALE), 1)) { mn = m_reg; alpha = 1.f; }
  else { mn = fmaxf(m_reg, pmax); alpha = __builtin_amdgcn_exp2f((m_reg - mn) * C); m_reg = mn; }
  const float mnC = POFF - mn * C;
#pragma unroll
  for (int r = 0; r < 16; ++r) p0[r] = fmaf(p0[r], C, mnC);
#pragma unroll
  for (int r = 0; r < 16; ++r) p1[r] = fmaf(p1[r], C, mnC);
#pragma unroll
  for (int r = 0; r < 16; ++r) p0[r] = __builtin_amdgcn_exp2f(p0[r]);
}
__device__ __forceinline__ unsigned pk4(float a, float b, float c, float d) { int w = 0; w = __builtin_amdgcn_cvt_pk_fp8_f32(a, b, w, false); w = __builtin_amdgcn_cvt_pk_fp8_f32(c, d, w, true); return (unsigned)w; }
__device__ __forceinline__ void finishSM(f32x16& p0, f32x16& p1, float alpha, float& l_reg, i32x8& pa) {
#pragma unroll
  for (int r = 0; r < 16; ++r) p1[r] = __builtin_amdgcn_exp2f(p1[r]);
  float ps = 0;
#pragma unroll
  for (int r = 0; r < 16; ++r) ps += p0[r];
#pragma unroll
  for (int r = 0; r < 16; ++r) ps += p1[r];
  { auto rr = __builtin_amdgcn_permlane32_swap(__float_as_uint(ps), __float_as_uint(ps), false, false);
    ps = __uint_as_float(rr[0]) + __uint_as_float(rr[1]); }
  l_reg = l_reg * alpha + ps;
#pragma unroll
  for (int g = 0; g < 4; ++g) { pa[g] = (int)pk4(p0[4 * g], p0[4 * g + 1], p0[4 * g + 2], p0[4 * g + 3]); pa[4 + g] = (int)pk4(p1[4 * g], p1[4 * g + 1], p1[4 * g + 2], p1[4 * g + 3]); }
}
__device__ __forceinline__ void qkt(f32x16& p0, f32x16& p1, const char* Ks, const i32x8* qr, int r32, int hi) {
  p0 = f32x16{}; p1 = f32x16{};
#pragma unroll
  for (int c = 0; c < 3; ++c) {
    const i32x8 a0 = A8CAT(*(const i32x4*)(Ks + k_off(r32, 4 * c + 2 * hi)), *(const i32x4*)(Ks + k_off(r32, 4 * c + 2 * hi + 1)));
    const i32x8 a1 = A8CAT(*(const i32x4*)(Ks + k_off(32 + r32, 4 * c + 2 * hi)), *(const i32x4*)(Ks + k_off(32 + r32, 4 * c + 2 * hi + 1)));
    p0 = mfma8(a0, qr[c], p0); p1 = mfma8(a1, qr[c], p1); }
}
__device__ __forceinline__ void pv(f32x16* o, const char* Vs, i32x8 pa, int r32, int hi) {
#pragma unroll
  for (int d0 = 0; d0 < 4; ++d0) { const int c = 32 * d0 + r32;
    const i32x8 b = A8CAT(*(const i32x4*)(Vs + v_off(c, 2 * hi)), *(const i32x4*)(Vs + v_off(c, 2 * hi + 1)));
    o[d0] = mfma8(pa, b, o[d0]); }
}
constexpr int LDO = 6144;
constexpr int OT_OFF = 45056, OT_LD = 136;
__device__ __forceinline__ void attn_unit(const unsigned char* __restrict__ Qb, const unsigned char* __restrict__ Kh, const unsigned char* __restrict__ Vt, unsigned char* __restrict__ Ob, int seq, char* lds) {
  int tid_o = threadIdx.x; asm volatile("" : "+v"(tid_o));
  const int tid = tid_o, wid = tid >> 6, lane = tid & 63, r32 = lane & 31, hi = lane >> 5;
  char* V_lds = lds; char* K_lds = lds + 2 * SHM_V;
  float* ws = (float*)(lds + 2 * SHM_V + 2 * SHM_K) + wid * 64; float* li_l = ws; float* al_l = ws + 32;
  float m_reg = -1e30f, l_reg = 0; f32x16 o[4] = {}; i32x8 qr[3];
  { const unsigned char* Qw = Qb + (long)(wid * QBLK + r32) * DQ + hi * 32;
#pragma unroll
    for (int c = 0; c < 3; ++c) qr[c] = A8CAT(*(const i32x4*)(Qw + 64 * c), *(const i32x4*)(Qw + 64 * c + 16)); }
  i32x4 sv[2], sk0[2]; i32x2 sk1[2];
  const __amdgpu_buffer_rsrc_t rK = __builtin_amdgcn_make_buffer_rsrc((void*)Kh, 0, seq * DQ, 0x00020000), rV = __builtin_amdgcn_make_buffer_rsrc((void*)Vt, 0, seq * DVV, 0x00020000);
  const int lo16 = tid * 16, lo8 = 8192 + tid * 8;
  const int wv = v_off(tid >> 2, tid & 3), wk0 = k_off(tid / 12, tid % 12), wk1 = k_off((512 + (tid >> 1)) / 12, (512 + (tid >> 1)) % 12) + 8 * (tid & 1);
#define A8LOAD(i, k0) do { sv[i] = __builtin_amdgcn_raw_buffer_load_b128(rV, lo16, (k0) * DVV, 0); sk0[i] = __builtin_amdgcn_raw_buffer_load_b128(rK, lo16, (k0) * DQ, 0); sk1[i] = __builtin_amdgcn_raw_buffer_load_b64(rK, lo8, (k0) * DQ, 0); } while (0)
#define A8WRITE(b, i) do { *(i32x4*)(V_lds + (b) * SHM_V + wv) = sv[i]; *(i32x4*)(K_lds + (b) * SHM_K + wk0) = sk0[i]; *(i32x2*)(K_lds + (b) * SHM_K + wk1) = sk1[i]; } while (0)
#define A8WAIT() asm volatile("s_waitcnt vmcnt(3)" ::: "memory")
#define A8RESC(a) do { if (__any((a) < 1.f)) { if (hi == 0) al_l[r32] = (a); asm volatile("s_waitcnt lgkmcnt(0)" ::: "memory"); \
    _Pragma("unroll") for (int d = 0; d < 4; ++d) _Pragma("unroll") for (int r = 0; r < 16; ++r) o[d][r] *= al_l[crow(r, hi)]; } } while (0)
  f32x16 pA0, pA1, pB0, pB1; float mnA, mnB, alA, alB; i32x8 pa; const int NT = seq / KVBLK;
  A8LOAD(0, 0); asm volatile("s_waitcnt vmcnt(0)" ::: "memory"); A8WRITE(0, 0); __syncthreads();
  qkt(pA0, pA1, K_lds, qr, r32, hi); partialSM(pA0, pA1, m_reg, mnA, alA);
  A8LOAD(1, KVBLK); if (2 < NT) A8LOAD(0, 2 * KVBLK);
  A8WAIT(); A8WRITE(1, 1); __syncthreads();
  for (int j = 1; j + 1 < NT; j += 2) {
    A8BAR(); qkt(pB0, pB1, K_lds + SHM_K, qr, r32, hi);
    finishSM(pA0, pA1, alA, l_reg, pa); A8BAR();
    A8LOAD(1, (j + 2) * KVBLK); A8BAR();
    pv(o, V_lds, pa, r32, hi); partialSM(pB0, pB1, m_reg, mnB, alB);
    __syncthreads(); A8WAIT(); A8WRITE(0, 0);
    A8RESC(alB); __syncthreads();
    A8BAR(); qkt(pA0, pA1, K_lds, qr, r32, hi);
    finishSM(pB0, pB1, alB, l_reg, pa); A8BAR();
    if (j + 3 < NT) A8LOAD(0, (j + 3) * KVBLK); A8BAR();
    pv(o, V_lds + SHM_V, pa, r32, hi); partialSM(pA0, pA1, m_reg, mnA, alA);
    __syncthreads(); A8WAIT(); A8WRITE(1, 1);
    A8RESC(alA); __syncthreads();
  }
  A8BAR(); qkt(pB0, pB1, K_lds + SHM_K, qr, r32, hi);
  finishSM(pA0, pA1, alA, l_reg, pa); A8BAR();
  pv(o, V_lds, pa, r32, hi); partialSM(pB0, pB1, m_reg, mnB, alB);
  __syncthreads(); A8RESC(alB);
  finishSM(pB0, pB1, alB, l_reg, pa); A8BAR();
  pv(o, V_lds + SHM_V, pa, r32, hi);
  if (hi == 0) li_l[r32] = l_reg; asm volatile("s_waitcnt lgkmcnt(0)" ::: "memory");
  float rli[16];
#pragma unroll
  for (int r = 0; r < 16; ++r) rli[r] = __builtin_amdgcn_rcpf(li_l[crow(r, hi)]);
  LAS unsigned short* OT = (LAS unsigned short*)(lds + OT_OFF) + wid * (32 * OT_LD);
#pragma unroll
  for (int r = 0; r < 16; ++r) { const int orow = crow(r, hi);
#pragma unroll
    for (int d0 = 0; d0 < 4; ++d0) OT[orow * OT_LD + d0 * 32 + r32] = (unsigned short)f2bf(o[d0][r] * rli[r]); }
  asm volatile("s_waitcnt lgkmcnt(0)" ::: "memory");
  { const int row = lane >> 1, half = lane & 1; unsigned char* Ow = Ob + (long)(wid * QBLK + row) * LDO;
#pragma unroll
    for (int g2 = 0; g2 < 2; ++g2) { const int g = 2 * half + g2; f32x16v a, b; const LAS bf16x8* src = (const LAS bf16x8*)(OT + row * OT_LD + 32 * g);
#pragma unroll
      for (int q = 0; q < 2; ++q) { const bf16x8 va = src[q], vb = src[2 + q];
#pragma unroll
        for (int e = 0; e < 8; ++e) { a[8 * q + e] = __uint_as_float(((unsigned)(unsigned short)va[e]) << 16); b[8 * q + e] = __uint_as_float(((unsigned)(unsigned short)vb[e]) << 16); } }
      v4u lo, hi; mx6_pack(a, b, lo, hi);
      *(GAS v4u*)(Ow + 16 * g) = lo; *(GAS v4u*)(Ow + 64 + 16 * g) = hi; } }
  __syncthreads();
#undef A8LOAD
#undef A8WRITE
#undef A8WAIT
#undef A8RESC
}
}
namespace hy {
typedef float f2 __attribute__((ext_vector_type(2)));
typedef float f4 __attribute__((ext_vector_type(4)));
constexpr int NF = 16384, LH = 8192;
constexpr int FFT_LDS_F2 = 18944;
__device__ __forceinline__ int PH(int p) { return p + 2 * (p >> 4) + 16 * (p >> 9); }
__device__ constexpr float C32[16] = {1.0f, 0.98078528040323043f, 0.92387953251128674f, 0.83146961230254524f, 0.70710678118654752f, 0.55557023301960218f, 0.38268343236508978f, 0.19509032201612825f,
                                      0.0f, -0.19509032201612825f, -0.38268343236508978f, -0.55557023301960218f, -0.70710678118654752f, -0.83146961230254524f, -0.92387953251128674f, -0.98078528040323043f};
__device__ constexpr float S32[16] = {0.0f, 0.19509032201612825f, 0.38268343236508978f, 0.55557023301960218f, 0.70710678118654752f, 0.83146961230254524f, 0.92387953251128674f, 0.98078528040323043f,
                                      1.0f, 0.98078528040323043f, 0.92387953251128674f, 0.83146961230254524f, 0.70710678118654752f, 0.55557023301960218f, 0.38268343236508978f, 0.19509032201612825f};
__host__ __device__ constexpr int brev(int x, int bits) { int r = 0; for (int i = 0; i < bits; ++i) r |= ((x >> i) & 1) << (bits - 1 - i); return r; }
__device__ __forceinline__ f2 cmulf(f2 x, f2 w) { return x * (f2){w.x, w.x} + (f2){x.y, x.x} * (f2){-w.y, w.y}; }
__device__ __forceinline__ f2 cmulc(f2 x, f2 w) { return x * (f2){w.x, w.x} + (f2){x.y, x.x} * (f2){w.y, -w.y}; }
__device__ __forceinline__ f2 cmulf_rt(f2 x, f2 w) { f2 t, r;
    asm("v_pk_mul_f32 %0, %1, %2 op_sel:[0,1] op_sel_hi:[1,1] neg_hi:[0,1]" : "=v"(t) : "v"(x), "v"(w));
    asm("v_pk_fma_f32 %0, %1, %2, %3 op_sel:[0,0,1] op_sel_hi:[1,0,0]" : "=v"(r) : "v"(x), "v"(w), "v"(t)); return r; }
__device__ __forceinline__ f2 cmulc_rt(f2 x, f2 w) { f2 t, r;
    asm("v_pk_mul_f32 %0, %1, %2 op_sel:[0,1] op_sel_hi:[1,1] neg_hi:[0,1]" : "=v"(t) : "v"(x), "v"(w));
    asm("v_pk_fma_f32 %0, %1, %2, %3 op_sel:[0,0,1] op_sel_hi:[1,0,0] neg_lo:[0,0,1] neg_hi:[0,0,1]" : "=v"(r) : "v"(x), "v"(w), "v"(t)); return r; }
template <int R, bool INV, bool ZH = false> __device__ __forceinline__ void dft_r2(f2 (&x)[R]) {
    if (ZH) {
#pragma unroll
        for (int j = 0; j < R / 2; ++j) { const int ti = j * (32 / R); const f2 d = x[j];
            if (ti == 0) x[j + R / 2] = d;
            else if (ti == 8) x[j + R / 2] = INV ? (f2){-d.y, d.x} : (f2){d.y, -d.x};
            else { const f2 w = {C32[ti], S32[ti]}; x[j + R / 2] = INV ? cmulf(d, w) : cmulc(d, w); } }
    }
#pragma unroll
    for (int h = ZH ? R / 4 : R / 2; h >= 1; h >>= 1) {
#pragma unroll
        for (int s = 0; s < R; s += 2 * h) {
#pragma unroll
            for (int j = 0; j < h; ++j) {
                const int ti = j * (16 / h);
                const f2 a = x[s + j], b = x[s + j + h];
                x[s + j] = a + b;
                const f2 d = a - b;
                if (ti == 0) x[s + j + h] = d;
                else if (ti == 8) x[s + j + h] = INV ? (f2){-d.y, d.x} : (f2){d.y, -d.x};
                else { const f2 w = {C32[ti], S32[ti]}; x[s + j + h] = INV ? cmulf(d, w) : cmulc(d, w); }
            }
        }
    }
}
template <int STRIDE, bool INV, int NSTORE, bool ZH> __device__ __forceinline__ void pass32(LAS f2* X, int base, f2 w1) {
    f2 x[32];
#pragma unroll
    for (int a = 0; a < (ZH ? 16 : 32); ++a) x[a] = X[base + a * STRIDE];
    f2 pw = w1;
    if (!INV) {
        dft_r2<32, false, ZH>(x);
#pragma unroll
        for (int k = 1; k < 32; ++k) { const int i = brev(k, 5); x[i] = cmulc_rt(x[i], pw); if (k < 31) pw = cmulf_rt(pw, w1); }
#pragma unroll
        for (int k = 0; k < 32; ++k) X[base + k * STRIDE] = x[brev(k, 5)];
    } else {
#pragma unroll
        for (int k = 1; k < 32; ++k) { x[k] = cmulf_rt(x[k], pw); if (k < 31) pw = cmulf_rt(pw, w1); }
        dft_r2<32, true>(x);
#pragma unroll
        for (int k = 0; k < NSTORE; ++k) X[base + k * STRIDE] = x[brev(k, 5)];
    }
}
__device__ __forceinline__ int opaque(int v) { asm volatile("" : "+v"(v)); return v; }
struct Tw { f2 wa, wb; };
__device__ __forceinline__ Tw make_tw(int tid) { Tw t; float sn, cs; sincospif((float)tid * (2.0f / 16384.0f), &sn, &cs); t.wa = (f2){cs, sn}; sincospif((float)(tid & 15) * (2.0f / 512.0f), &sn, &cs); t.wb = (f2){cs, sn}; return t; }
template <bool ZH> __device__ __forceinline__ void fft_pass1(LAS f2* X, int tid, bool inv_, f2 wa) {
    tid = opaque(tid); asm volatile("" : "+v"(wa));
    const int base = tid + 2 * (tid >> 4);
    if (!inv_) pass32<592, false, 32, ZH>(X, base, wa); else pass32<592, true, 16, false>(X, base, wa);
}
__device__ __forceinline__ void fft_pass2(LAS f2* X, int tid, bool inv_, f2 wb) {
    tid = opaque(tid); asm volatile("" : "+v"(wb));
    const int r2 = tid & 15, blk = tid >> 4;
    const int base = blk * 592 + r2;
    if (!inv_) pass32<18, false, 32, false>(X, base, wb); else pass32<18, true, 32, false>(X, base, wb);
}
__device__ __forceinline__ void fft_pass3(LAS f2* X, int tid, const f2* __restrict__ KS) {
    tid = opaque(tid);
#pragma unroll 1
    for (int h = 0; h < 2; ++h) {
        const int q = tid + 512 * h, base = 18 * q + 16 * (q >> 5);
        f4 kv[8];
        if (KS) {
#pragma unroll
            for (int i = 0; i < 8; ++i) kv[i] = *(const f4*)(KS + q * 16 + 2 * i);
        }
        f2 x[16];
#pragma unroll
        for (int i = 0; i < 8; ++i) { const f4 v = *(const LAS f4*)(X + base + 2 * i); x[2 * i] = (f2){v.x, v.y}; x[2 * i + 1] = (f2){v.z, v.w}; }
        dft_r2<16, false>(x);
        if (!KS) {
#pragma unroll
            for (int i = 0; i < 8; ++i) { const f2 p = x[brev(2 * i, 4)], q2 = x[brev(2 * i + 1, 4)]; *(LAS f4*)(X + base + 2 * i) = (f4){p.x, p.y, q2.x, q2.y}; }
        } else {
            f2 y[16];
#pragma unroll
            for (int k = 0; k < 16; ++k) { const f2 kk = (k & 1) ? (f2){kv[k >> 1].z, kv[k >> 1].w} : (f2){kv[k >> 1].x, kv[k >> 1].y}; y[k] = cmulf_rt(x[brev(k, 4)], kk); }
            dft_r2<16, true>(y);
#pragma unroll
            for (int i = 0; i < 8; ++i) { const f2 p = y[brev(2 * i, 4)], q2 = y[brev(2 * i + 1, 4)]; *(LAS f4*)(X + base + 2 * i) = (f4){p.x, p.y, q2.x, q2.y}; }
        }
    }
}
#define HY_SYNC() __syncthreads()
__device__ __forceinline__ void fft_forward_plain(LAS f2* X, int tid, Tw tw) { fft_pass1<false>(X, tid, false, tw.wa); HY_SYNC(); fft_pass2(X, tid, false, tw.wb); HY_SYNC(); fft_pass3(X, tid, nullptr); HY_SYNC(); }
__device__ __forceinline__ void fft_conv(LAS f2* X, int tid, const f2* KS, Tw tw) {
    fft_pass1<true>(X, tid, false, tw.wa); HY_SYNC(); fft_pass2(X, tid, false, tw.wb); HY_SYNC(); fft_pass3(X, tid, KS); HY_SYNC(); fft_pass2(X, tid, true, tw.wb); HY_SYNC(); fft_pass1<false>(X, tid, true, tw.wa); HY_SYNC();
}
__device__ __forceinline__ float bf2f(unsigned short h) { return __uint_as_float(((unsigned)h) << 16); }
__device__ __forceinline__ void conv8(const unsigned short* __restrict__ p, int t0, float w0, float w1, float w2, float cb, float (&o)[8]) {
    const bf16x8 v = *(const bf16x8*)(p + t0);
    float x[10];
    x[0] = t0 > 0 ? bf2f(p[t0 - 1]) : 0.f; x[9] = (t0 + 8 < LH) ? bf2f(p[t0 + 8]) : 0.f;
#pragma unroll
    for (int i = 0; i < 8; ++i) x[i + 1] = bf2f((unsigned short)v[i]);
#pragma unroll
    for (int i = 0; i < 8; ++i) o[i] = w0 * x[i] + w1 * x[i + 1] + w2 * x[i + 2] + cb;
}
__device__ __forceinline__ void zero_upper(LAS f2* X, int tid) {
    LAS f4* z = (LAS f4*)(X + 9472);
    for (int i = tid; i < (FFT_LDS_F2 - 9472) / 2; i += 512) z[i] = (f4){0.f, 0.f, 0.f, 0.f};
}
__device__ __forceinline__ void hyena_channel(LAS f2* X, int tid, int c, const unsigned short* __restrict__ HyT, const unsigned short* __restrict__ FiltT, const float* __restrict__ convw, const float* __restrict__ convb,
                                              const float* __restrict__ hbias, f2* KSb, unsigned short* __restrict__ YT, Tw tw) {
    tid = opaque(tid);
    {
        const unsigned short* f00 = FiltT + (size_t)(0 * 4096 + 0 * 2048 + c) * LH; const unsigned short* f01 = FiltT + (size_t)(0 * 4096 + 1 * 2048 + c) * LH;
        const unsigned short* f10 = FiltT + (size_t)(1 * 4096 + 0 * 2048 + c) * LH; const unsigned short* f11 = FiltT + (size_t)(1 * 4096 + 1 * 2048 + c) * LH;
#pragma unroll 1
        for (int i = 0; i < 4; ++i) {
            const int t0 = 4 * (tid + 512 * i);
            typedef unsigned short u16x4 __attribute__((ext_vector_type(4)));
            const u16x4 ra = *(const u16x4*)(f00 + t0), rb = *(const u16x4*)(f01 + t0), rc = *(const u16x4*)(f10 + t0), rd = *(const u16x4*)(f11 + t0);
            const f4 a = {bf2f(ra.x), bf2f(ra.y), bf2f(ra.z), bf2f(ra.w)}, b = {bf2f(rb.x), bf2f(rb.y), bf2f(rb.z), bf2f(rb.w)}, cc = {bf2f(rc.x), bf2f(rc.y), bf2f(rc.z), bf2f(rc.w)}, d = {bf2f(rd.x), bf2f(rd.y), bf2f(rd.z), bf2f(rd.w)};
            const int e0 = PH(t0);
            *(LAS f4*)(X + e0) = (f4){a.x, b.x, a.y, b.y}; *(LAS f4*)(X + e0 + 2) = (f4){a.z, b.z, a.w, b.w};
            if (t0 == 0) X[PH(LH)] = (f2){0.f, 0.f}; else X[PH(NF - t0)] = (f2){cc.x, d.x};
            X[PH(NF - t0 - 1)] = (f2){cc.y, d.y}; X[PH(NF - t0 - 2)] = (f2){cc.z, d.z}; X[PH(NF - t0 - 3)] = (f2){cc.w, d.w};
        }
    }
    HY_SYNC();
    fft_forward_plain(X, tid, tw);
    tid = opaque(tid);
    {
        const float b1 = hbias[c], b2 = hbias[2048 + c]; const float sc = 1.0f / (float)NF;
#pragma unroll 4
        for (int i = 0; i < 32; ++i) {
            const int P = tid + 512 * i; const int k = (P >> 9) + 32 * ((P >> 4) & 31) + 1024 * (P & 15); const int kn = (NF - k) & (NF - 1);
            const int Pn = (kn & 31) * 512 + ((kn >> 5) & 31) * 16 + (kn >> 10);
            const f2 z = X[PH(P)], zn = X[PH(Pn)];
            KSb[P] = (f2){(0.5f * (z.x + zn.x) + b1) * sc, 0.5f * (z.y - zn.y) * sc};
            KSb[NF + P] = (f2){(0.5f * (z.y + zn.y) + b2) * sc, -0.5f * (z.x - zn.x) * sc};
        }
    }
    asm volatile("s_waitcnt vmcnt(0)" ::: "memory");
    HY_SYNC();
    tid = opaque(tid);
    const unsigned short* pv = HyT + (size_t)c * NF; const unsigned short* px1 = HyT + (size_t)(2048 + c) * NF; const unsigned short* px2 = HyT + (size_t)(4096 + c) * NF;
    {
        const float w0 = convw[c], w1 = convw[6144 + c], w2 = convw[2 * 6144 + c], cb = convb[c];
#pragma unroll 1
        for (int i = 0; i < 2; ++i) { const int t0 = 8 * (tid + 512 * i); float a[8], b[8]; conv8(pv, t0, w0, w1, w2, cb, a); conv8(pv + LH, t0, w0, w1, w2, cb, b);
            const int e0 = PH(t0);
#pragma unroll
            for (int j = 0; j < 4; ++j) *(LAS f4*)(X + e0 + 2 * j) = (f4){a[2 * j], b[2 * j], a[2 * j + 1], b[2 * j + 1]}; }
    }
    HY_SYNC();
    fft_conv(X, tid, KSb, tw);
    tid = opaque(tid);
    {
        const float w0 = convw[2048 + c], w1 = convw[6144 + 2048 + c], w2 = convw[2 * 6144 + 2048 + c], cb = convb[2048 + c];
#pragma unroll 1
        for (int i = 0; i < 2; ++i) { const int t0 = 8 * (tid + 512 * i); float a[8], b[8]; conv8(px1, t0, w0, w1, w2, cb, a); conv8(px1 + LH, t0, w0, w1, w2, cb, b);
            const int e0 = PH(t0);
#pragma unroll
            for (int j = 0; j < 4; ++j) { const f4 y = *(const LAS f4*)(X + e0 + 2 * j); *(LAS f4*)(X + e0 + 2 * j) = (f4){a[2 * j] * y.x, b[2 * j] * y.y, a[2 * j + 1] * y.z, b[2 * j + 1] * y.w}; } }
    }
    HY_SYNC();
    fft_conv(X, tid, KSb + NF, tw);
    tid = opaque(tid);
    {
        const float w0 = convw[4096 + c], w1 = convw[6144 + 4096 + c], w2 = convw[2 * 6144 + 4096 + c], cb = convb[4096 + c];
        unsigned short* yo = YT + (size_t)c * NF;
#pragma unroll 1
        for (int i = 0; i < 2; ++i) { const int t0 = 8 * (tid + 512 * i); float a[8], b[8]; conv8(px2, t0, w0, w1, w2, cb, a); conv8(px2 + LH, t0, w0, w1, w2, cb, b);
            const int e0 = PH(t0); float ya[8], yb[8];
#pragma unroll
            for (int j = 0; j < 4; ++j) { const f4 y = *(const LAS f4*)(X + e0 + 2 * j); ya[2 * j] = a[2 * j] * y.x; yb[2 * j] = b[2 * j] * y.y; ya[2 * j + 1] = a[2 * j + 1] * y.z; yb[2 * j + 1] = b[2 * j + 1] * y.w; }
            v4u wa, wb; wa.x = pg8::cvt_pk_bf16(ya[0], ya[1]); wa.y = pg8::cvt_pk_bf16(ya[2], ya[3]); wa.z = pg8::cvt_pk_bf16(ya[4], ya[5]); wa.w = pg8::cvt_pk_bf16(ya[6], ya[7]);
            wb.x = pg8::cvt_pk_bf16(yb[0], yb[1]); wb.y = pg8::cvt_pk_bf16(yb[2], yb[3]); wb.z = pg8::cvt_pk_bf16(yb[4], yb[5]); wb.w = pg8::cvt_pk_bf16(yb[6], yb[7]);
            *(v4u*)(yo + t0) = wa; *(v4u*)(yo + LH + t0) = wb; }
    }
    HY_SYNC();
}
}
constexpr int NWAVES = 8;
#ifndef MK_N_LAUNCHES
#define MK_N_LAUNCHES 1
#endif
constexpr int N_PHASES = 10;
#ifndef DUP_ID
#define DUP_ID -1
#endif
#define REP(id) _Pragma("unroll 1") for (int rep_ = 0; rep_ < ((DUP_ID == (id) || DUP_ID == 200 + (id)) ? 2 : 1); ++rep_) if ((rep_ == 1 && DUP_ID >= 200) ? (xcd_barrier(bar), true) : true)
constexpr int N_LAUNCHES = MK_N_LAUNCHES;
constexpr int DM = 4096, NB = 2, SEQ = 8192, MTOK = NB * SEQ, LCTX = 256, MCTX = NB * LCTX, MALL = MTOK + MCTX;
constexpr int HYW = 2048, HYC = 6144, QLORA = 1024, KVLORA = 512, INC = 7744, INP = 7936, NMODC = 24576;
constexpr int NHEAD = 16, DQK = 192, FF = 16384, SKEYS = LCTX + SEQ;
constexpr float EPS = 1e-6f;
constexpr int MIXLD = 3072;
constexpr float WQBSCALE = 32.f, WKVBSCALE = 16.f, W1SCALE = 64.f, W2SCALE = 128.f, WINSCALE = 64.f, WOSCALE = 64.f;
constexpr size_t MiB = 1u << 20;
constexpr size_t WS_CTL = 0, CTL_ZERO_BYTES = 1 * MiB;
constexpr size_t WS_MODP = 1 * MiB;
constexpr size_t WS_MODS = 3 * MiB;
constexpr size_t WS_TW1 = 4 * MiB, WS_TW2 = 5 * MiB;
constexpr size_t WS_WOUT = 8 * MiB, WS_W1 = 40 * MiB, WS_W2 = 168 * MiB, WS_WIN = 296 * MiB, WS_WQB = 358 * MiB, WS_WKVB = 364 * MiB, WS_HH = 368 * MiB;
constexpr size_t WS_FILT = 370 * MiB, WS_H = 626 * MiB, WS_HYT = 758 * MiB, WS_QA = 950 * MiB, WS_KVA = 982 * MiB, WS_KR = 999 * MiB, WS_QRAW = 1004 * MiB, WS_KVRAW = 1100 * MiB;
constexpr size_t WS_H8 = WS_QRAW, WS_WIN8 = WS_KVRAW;
constexpr size_t WS_YT = 1232 * MiB, WS_KS = 1296 * MiB, WS_END0 = 1360 * MiB;
constexpr size_t WS_QB = 370 * MiB, WS_KB = 466 * MiB, WS_VB = 565 * MiB, WS_MIX = 631 * MiB;
constexpr size_t WS_H2 = 760 * MiB;
constexpr size_t WS_HID = 900 * MiB, WS_END = 1412 * MiB;
static_assert(WS_MIX + (size_t)MTOK * DM * 2 <= WS_H2 && WS_H2 + (size_t)MTOK * DM * 2 <= WS_HID && WS_VB + (size_t)NB * NHEAD * SKEYS * 128 * 2 <= WS_MIX && WS_KB + (size_t)NB * NHEAD * SKEYS * 192 * 2 <= WS_VB, "d_ws map");
constexpr int CW_TMO = 0, CW_BAR = 4096;
constexpr int LDS_BYTES = 163840, MISC_OFF = 159744;

struct Args { const float* in[27]; float* out; unsigned char* ws; int ph_lo, ph_hi, li, pad; };
typedef const __attribute__((address_space(4))) Args CArgs;

__device__ __forceinline__ float wave_sum(float v) {
#define WS_SWZ(X) v += __int_as_float(__builtin_amdgcn_ds_swizzle(__float_as_int(v), ((X) << 10) | 0x1f))
    WS_SWZ(1); WS_SWZ(2); WS_SWZ(4); WS_SWZ(8); WS_SWZ(16);
#undef WS_SWZ
    { auto rr = __builtin_amdgcn_permlane32_swap(__float_as_uint(v), __float_as_uint(v), false, false); v = __uint_as_float(rr[0]) + __uint_as_float(rr[1]); }
    return v;
}
__device__ __forceinline__ float bf2f(unsigned short h) { return __uint_as_float(((unsigned)h) << 16); }
__device__ __forceinline__ void p0_transpose_item(const float* W, int K, int N, bf16* WT, int row_off, const float* kscale, LAS float* scr, int item, int lane, int ldw = 0, int kofs = 0) {
    const int nblk = N / 32, kb = item / nblk, nb = item % nblk, k0 = 64 * kb, n0 = 32 * nb;
#pragma unroll 8
    for (int i = 0; i < 32; ++i) { const int kk = 2 * i + (lane >> 5); float v = W[(size_t)(k0 + kk) * N + n0 + (lane & 31)]; if (kscale) v *= kscale[k0 + kk]; scr[kk * 33 + (lane & 31)] = v; }
    LDS_WAIT(); asm volatile("" ::: "memory");
    const int c = lane & 7;
#pragma unroll
    for (int j = 0; j < 4; ++j) { const int n = (lane >> 3) + 8 * j; const LAS float* s = scr + (8 * c) * 33 + n;
        v4u o; o.x = pk2(s[0 * 33], s[1 * 33]); o.y = pk2(s[2 * 33], s[3 * 33]); o.z = pk2(s[4 * 33], s[5 * 33]); o.w = pk2(s[6 * 33], s[7 * 33]);
        *(GAS v4u*)(WT + (size_t)(row_off + n0 + n) * (ldw ? ldw : K) + (k0 - kofs) + 8 * c) = o; }
    LDS_WAIT(); asm volatile("" ::: "memory");
}
__device__ __forceinline__ void p0_transpose_item_f8(const float* W, int K, int N, unsigned char* WT, float wscale, LAS float* scr, int item, int lane, int ldw = 0, int kofs = 0, const float* kscale = nullptr) {
    const int nblk = N / 32, kb = item / nblk, nb = item % nblk, k0 = 64 * kb, n0 = 32 * nb;
#pragma unroll 8
    for (int i = 0; i < 32; ++i) { const int kk = 2 * i + (lane >> 5); float v = W[(size_t)(k0 + kk) * N + n0 + (lane & 31)] * wscale; if (kscale) v *= kscale[k0 + kk]; scr[kk * 33 + (lane & 31)] = v; }
    LDS_WAIT(); asm volatile("" ::: "memory");
    const int c = lane & 3;
#pragma unroll
    for (int j = 0; j < 2; ++j) { const int n = (lane >> 2) + 16 * j; const LAS float* s = scr + (16 * c) * 33 + n;
        v4u o;
        o.x = pg8::pack4_fp8(fmaxf(s[0 * 33], -448.f), fmaxf(s[1 * 33], -448.f), fmaxf(s[2 * 33], -448.f), fmaxf(s[3 * 33], -448.f));
        o.y = pg8::pack4_fp8(fmaxf(s[4 * 33], -448.f), fmaxf(s[5 * 33], -448.f), fmaxf(s[6 * 33], -448.f), fmaxf(s[7 * 33], -448.f));
        o.z = pg8::pack4_fp8(fmaxf(s[8 * 33], -448.f), fmaxf(s[9 * 33], -448.f), fmaxf(s[10 * 33], -448.f), fmaxf(s[11 * 33], -448.f));
        o.w = pg8::pack4_fp8(fmaxf(s[12 * 33], -448.f), fmaxf(s[13 * 33], -448.f), fmaxf(s[14 * 33], -448.f), fmaxf(s[15 * 33], -448.f));
        *(GAS v4u*)(WT + (size_t)(n0 + n) * (ldw ? ldw : K) + (k0 - kofs) + 16 * c) = o; }
    LDS_WAIT(); asm volatile("" ::: "memory");
}
__device__ __forceinline__ unsigned f8pack(float a, float b, float c, float d) { return pg8::pack4_fp8(fmaxf(a, -448.f), fmaxf(b, -448.f), fmaxf(c, -448.f), fmaxf(d, -448.f)); }
__device__ __forceinline__ void p0_transpose_item_mx6(const float* W, int K, int N, unsigned char* WT, LAS float* scr, int item, int lane, int ldw = 0  , int kofs = 0) {
    const int nblk = N / 32, kb = item / nblk, nb = item % nblk, k0 = 64 * kb, n0 = 32 * nb;
#pragma unroll 8
    for (int i = 0; i < 32; ++i) { const int kk = 2 * i + (lane >> 5); scr[kk * 33 + (lane & 31)] = W[(size_t)(k0 + kk) * N + n0 + (lane & 31)]; }
    LDS_WAIT(); asm volatile("" ::: "memory");
    const int n = lane & 31, bl = lane >> 5; const LAS float* sp = scr + (32 * bl) * 33 + n;
    f32x16v a, b;
#pragma unroll
    for (int i = 0; i < 16; ++i) { a[i] = sp[i * 33]; b[i] = sp[(16 + i) * 33]; }
    v4u lo, hi; mx6_pack(a, b, lo, hi);
    unsigned char* d = WT + (size_t)(n0 + n) * (ldw ? ldw : K) + mx6_off(((k0 - kofs) >> 5) + bl);
    *(GAS v4u*)d = lo; *(GAS v4u*)(d + 64) = hi;
    LDS_WAIT(); asm volatile("" ::: "memory");
}
__device__ __forceinline__ void modulate_row_mx6(const float* xrow, unsigned char* orow, const LAS float* g, const LAS float* sh, const LAS float* sc, int lane) {
    asm volatile("" : "+v"(lane));
    f32x4 v[2][8]; float s = 0.f;
#pragma unroll
    for (int j = 0; j < 2; ++j)
#pragma unroll
        for (int q = 0; q < 8; ++q) { v[j][q] = *(const GAS f32x4*)(xrow + 32 * (lane + 64 * j) + 4 * q); s += (v[j][q].x * v[j][q].x + v[j][q].y * v[j][q].y) + (v[j][q].z * v[j][q].z + v[j][q].w * v[j][q].w); }
    const float rstd = 1.0f / sqrtf(wave_sum(s) * (1.f / DM) + EPS);
#pragma unroll
    for (int j = 0; j < 2; ++j) { const int blk = lane + 64 * j, c0 = 32 * blk; f32x16v a, b;
#pragma unroll
        for (int q = 0; q < 8; ++q) { const f32x4 gg = *(const LAS f32x4*)(g + c0 + 4 * q), hh = *(const LAS f32x4*)(sh + c0 + 4 * q), cc = *(const LAS f32x4*)(sc + c0 + 4 * q);
            const f32x4 y = (v[j][q] * rstd * gg) * (cc + 1.0f) + hh;
            if (q < 4) { a[4 * q] = y.x; a[4 * q + 1] = y.y; a[4 * q + 2] = y.z; a[4 * q + 3] = y.w; } else { b[4 * q - 16] = y.x; b[4 * q - 15] = y.y; b[4 * q - 14] = y.z; b[4 * q - 13] = y.w; } }
        v4u lo, hi; mx6_pack(a, b, lo, hi);
        unsigned char* d = orow + mx6_off(blk); *(GAS v4u*)d = lo; *(GAS v4u*)(d + 64) = hi;
        asm volatile("" ::: "memory"); }
}
template <int F8  > __device__ __forceinline__ void modulate_row(const float* xrow, void* orow, void* orow8, const LAS float* g, const LAS float* sh, const LAS float* sc, int lane) {
    asm volatile("" : "+v"(lane));
    const GAS f32x4* xr = (const GAS f32x4*)xrow + lane;
    f32x4 v[16]; float s = 0.f;
#pragma unroll
    for (int j = 0; j < 16; ++j) { v[j] = xr[64 * j]; s += (v[j].x * v[j].x + v[j].y * v[j].y) + (v[j].z * v[j].z + v[j].w * v[j].w); }
    const float rstd = 1.0f / sqrtf(wave_sum(s) * (1.f / DM) + EPS);
    GAS unsigned long long* o8 = (GAS unsigned long long*)orow + lane; GAS unsigned* o4 = (GAS unsigned*)(F8 == 2 ? orow8 : orow) + lane;
#pragma unroll
    for (int j = 0; j < 16; ++j) { const int c0 = 4 * (lane + 64 * j); const f32x4 gg = *(const LAS f32x4*)(g + c0), hh = *(const LAS f32x4*)(sh + c0), cc = *(const LAS f32x4*)(sc + c0);
        const f32x4 y = (v[j] * rstd * gg) * (cc + 1.0f) + hh;
        if (F8 != 0) o4[64 * j] = pg8::pack4_fp8(fmaxf(y.x, -448.f), fmaxf(y.y, -448.f), fmaxf(y.z, -448.f), fmaxf(y.w, -448.f));
        if (F8 != 1) o8[64 * j] = (unsigned long long)pk2(y.x, y.y) | ((unsigned long long)pk2(y.z, y.w) << 32);
        if (j & 1) asm volatile("" ::: "memory"); }
}

__global__ void __launch_bounds__(NWAVES * 64, 2) mega_fwd(Args args) {
    extern __shared__ __attribute__((aligned(16))) unsigned char lds_raw[];
    LAS unsigned char* lds = (LAS unsigned char*)lds_raw;
    volatile LAS unsigned* MISC = (volatile LAS unsigned*)(lds + MISC_OFF);
#define PHASE_IDS() const CArgs* ap = (const CArgs*)__builtin_amdgcn_kernarg_segment_ptr(); asm volatile("" : "+s"(ap)); unsigned char* ws = ap->ws; const int tid = hy::opaque((int)threadIdx.x), lane = tid & 63, wave = __builtin_amdgcn_readfirstlane(tid >> 6), gw = vcu * NWAVES + wave, NGW = G * NWAVES; (void)lane; (void)gw; (void)NGW
    const int G = gridDim.x; const int bx = blockIdx.x; const int vcu = (G % 8 == 0) ? (bx % 8) * (G / 8) + bx / 8 : bx;
    gu32* ctl = (gu32*)(args.ws + WS_CTL);
#define x_in ((const float*)ap->in[0])
#define cvec ((const float*)ap->in[1])
#define ctx ((const float*)ap->in[2])
#define c_ctx ((const float*)ap->in[3])
#define norm1_g ((const float*)ap->in[4])
#define norm2_g ((const float*)ap->in[5])
#define w_ada ((const float*)ap->in[6])
#define b_ada ((const float*)ap->in[7])
#define w_in ((const float*)ap->in[8])
#define hy_conv_w ((const float*)ap->in[9])
#define hy_conv_b ((const float*)ap->in[10])
#define hy_w1 ((const float*)ap->in[11])
#define hy_b1 ((const float*)ap->in[12])
#define hy_w2 ((const float*)ap->in[13])
#define hy_b2 ((const float*)ap->in[14])
#define hy_w3 ((const float*)ap->in[15])
#define hy_freq ((const float*)ap->in[16])
#define hy_bias ((const float*)ap->in[17])
#define g_qa ((const float*)ap->in[18])
#define w_qb ((const float*)ap->in[19])
#define g_kva ((const float*)ap->in[20])
#define w_kvb ((const float*)ap->in[21])
#define q_norm_g ((const float*)ap->in[22])
#define k_norm_g ((const float*)ap->in[23])
#define w_out ((const float*)ap->in[24])
#define w_mlp1 ((const float*)ap->in[25])
#define w_mlp2 ((const float*)ap->in[26])
#define out_p (ap->out)
#define MODP ((float*)(ws + WS_MODP))
#define MODS ((float*)(ws + WS_MODS))
#define TW1 ((hy::f2*)(ws + WS_TW1))
#define TW2 ((hy::f2*)(ws + WS_TW2))
#define W1T ((bf16*)(ws + WS_W1))
#define W2T ((bf16*)(ws + WS_W2))
#define WinT ((bf16*)(ws + WS_WIN))
#define WinT8 ((unsigned char*)(ws + WS_WIN8))
#define H8 ((unsigned char*)(ws + WS_H8))
#define WqbT ((bf16*)(ws + WS_WQB))
#define WkvbT ((bf16*)(ws + WS_WKVB))
#define Hh ((float*)(ws + WS_HH))
#define FiltT ((float*)(ws + WS_FILT))
#define Hb ((bf16*)(ws + WS_H))
#define HyT ((bf16*)(ws + WS_HYT))
#define QA ((bf16*)(ws + WS_QA))
#define KVA ((bf16*)(ws + WS_KVA))
#define KR ((float*)(ws + WS_KR))
#define Qraw ((bf16*)(ws + WS_QRAW))
#define KVraw ((bf16*)(ws + WS_KVRAW))
#define YT ((bf16*)(ws + WS_YT))
#define KSall ((hy::f2*)(ws + WS_KS))
#define Qb ((bf16*)(ws + WS_QB))
#define Kb ((bf16*)(ws + WS_KB))
#define Vb ((bf16*)(ws + WS_VB))
#define MIX ((bf16*)(ws + WS_MIX))
#define WoutT ((bf16*)(ws + WS_WOUT))
#define H2 ((bf16*)(ws + WS_H2))
#define HID ((bf16*)(ws + WS_HID))
    for (int u = hy::opaque((int)threadIdx.x); u < (LDS_BYTES - MISC_OFF) / 4; u += NWAVES * 64) ((LAS unsigned*)(lds + MISC_OFF))[u] = 0u;
    __syncthreads();
    XcdBarrier bar; bar.bar = (unsigned*)(ctl + CW_BAR); bar.x = 0; bar.st = nullptr;
    if (N_LAUNCHES == 1) bar = xcd_barrier_post((unsigned*)(ctl + CW_BAR), MISC + 8);
#define GRID_BAR() do { if (N_LAUNCHES == 1) xcd_barrier(bar); } while (0)
    const int lo = args.ph_lo, hi = args.ph_hi;
#ifndef PH_MASK
#define PH_MASK 0x3ff
#endif
#define IN(k) (((PH_MASK >> (k)) & 1) && lo <= (k) && (k) < hi)
#define BOTH(k) (IN(k) && IN((k) + 1))

    if (IN(0)) {
        PHASE_IDS();
        REP(0) {
            LAS float* scr = (LAS float*)(lds + wave * 16384);
            constexpr int I_IN = (DM / 64) * (INC / 32), I_QB = (QLORA / 64) * (3072 / 32), I_KVB = (KVLORA / 64) * (4096 / 32), I_O = (DM / 64) * (DM / 32), I_1 = (DM / 64) * (FF / 32), I_2 = (FF / 64) * (DM / 32);
            constexpr int NITEMS = I_IN + I_QB + I_KVB + I_O + I_1 + I_2;
            for (int it = gw; it < NITEMS; it += NGW) {
                int r = it;
                if (r < I_IN) { const int n0 = 32 * (r % (INC / 32));
                    if (n0 < HYC) p0_transpose_item(w_in, DM, INC, WinT, 0, nullptr, scr, r, lane); else p0_transpose_item_f8(w_in, DM, INC, WinT8, WINSCALE, scr, r, lane); continue; } r -= I_IN;
                if (r < I_QB) { p0_transpose_item_f8(w_qb, QLORA, 3072, (unsigned char*)WqbT, WQBSCALE, scr, r, lane, 0, 0, g_qa); continue; } r -= I_QB;
                if (r < I_KVB) { p0_transpose_item_f8(w_kvb, KVLORA, 4096, (unsigned char*)WkvbT, WKVBSCALE, scr, r, lane, 0, 0, g_kva); continue; } r -= I_KVB;
                if (r < I_O) { if (64 * (r / (DM / 32)) < HYW) p0_transpose_item(w_out, DM, DM, WoutT, 0, nullptr, scr, r, lane, MIXLD, 0);
                                else p0_transpose_item_mx6(w_out, DM, DM, (unsigned char*)WoutT + 2 * HYW, scr, r, lane, 2 * MIXLD, HYW); continue; } r -= I_O;
                if (r < I_1) { p0_transpose_item_mx6(w_mlp1, DM, FF, (unsigned char*)W1T, scr, r, lane); continue; } r -= I_1;
                p0_transpose_item_f8(w_mlp2, FF, DM, (unsigned char*)W2T, W2SCALE, scr, r, lane);
            }
            { GAS v4u* z = (GAS v4u*)(WinT8 + (size_t)INC * DM); const size_t n16 = (size_t)(INP - INC) * DM / 16;
              for (size_t i = (size_t)vcu * 512 + tid; i < n16; i += (size_t)G * 512) z[i] = (v4u){0u, 0u, 0u, 0u}; }
        }
        __syncthreads();
        REP(1) {
            LAS float* S = (LAS float*)lds;
            LAS float* RED = (LAS float*)(lds + 49152);
            for (int i = tid; i < 3 * DM; i += 512) { const float v = i < 2 * DM ? cvec[i] : c_ctx[i - 2 * DM]; S[i] = v / (1.0f + __expf(-v)); }
            __syncthreads();
            for (int it = vcu; it < 192 * 4; it += G) {
                const int cb = it % 192, ks = it / 192, col = cb * 128 + 2 * lane, kbeg = ks * 1024;
                float a0 = 0, a1 = 0, b0 = 0, b1 = 0, c0 = 0, c1 = 0;
#pragma unroll 8
                for (int i = 0; i < 128; ++i) { const int k = kbeg + wave + 8 * i; const float2 w = *(const float2*)(w_ada + (size_t)k * NMODC + col);
                    const float s0 = S[k], s1 = S[DM + k], s2 = S[2 * DM + k];
                    a0 += s0 * w.x; a1 += s0 * w.y; b0 += s1 * w.x; b1 += s1 * w.y; c0 += s2 * w.x; c1 += s2 * w.y; }
                LAS float* rw = RED + wave * 384;
                rw[2 * lane] = a0; rw[2 * lane + 1] = a1; rw[128 + 2 * lane] = b0; rw[128 + 2 * lane + 1] = b1; rw[256 + 2 * lane] = c0; rw[256 + 2 * lane + 1] = c1;
                __syncthreads();
                if (tid < 384) { float s = 0.f;
#pragma unroll
                    for (int w = 0; w < 8; ++w) s += RED[w * 384 + tid];
                    const int r = tid >> 7, cc = tid & 127; MODP[(size_t)(ks * 3 + r) * NMODC + cb * 128 + cc] = s; }
                __syncthreads();
            }
        }
        REP(2) {
            LAS float* FE = (LAS float*)lds;
            LAS float* H1 = (LAS float*)(lds + 2048);
            const int tl = tid >> 6, j = tid & 63;
            for (int it = vcu; it < SEQ / 8; it += G) {
                const int t = it * 8 + tl;
                if (j < 33) { float f;
                    if (j == 0) f = (float)t / (float)(SEQ - 1);
                    else { const int bi = (j - 1) & 15; const float band = 1e-4f + (float)bi * ((15.0f - 1e-4f) / 15.0f); const float ang = ((float)(2.0 * 3.14159265358979323846 / SEQ) * (float)t) * band; f = (j <= 16) ? cosf(ang) : -sinf(ang); }
                    FE[tl * 33 + j] = f; }
                __syncthreads();
                { float a = hy_b1[j];
#pragma unroll 11
                  for (int i = 0; i < 33; ++i) a += FE[tl * 33 + i] * hy_w1[i * 64 + j];
                  H1[tl * 64 + j] = sinf(hy_freq[j] * a); }
                __syncthreads();
                { float a = hy_b2[j];
#pragma unroll 8
                  for (int i = 0; i < 64; ++i) a += H1[tl * 64 + i] * hy_w2[i * 64 + j];
                  ((unsigned short*)Hh)[(size_t)t * 64 + j] = (unsigned short)f2bf(sinf(hy_freq[j] * a)); }
                __syncthreads();
            }
        }
        if (BOTH(0)) GRID_BAR();
    }

    if (IN(1)) {
        PHASE_IDS();
        REP(10) {
            LAS float* SH = (LAS float*)lds;
            LAS float* SC = (LAS float*)(lds + 49152);
            LAS float* GN = (LAS float*)(lds + 98304);
            for (int i = tid; i < 3 * 2 * DM; i += 512) { const int r = i / (2 * DM), col = i % (2 * DM);
                float s = b_ada[col];
#pragma unroll
                for (int ks = 0; ks < 4; ++ks) s += MODP[(size_t)(ks * 3 + r) * NMODC + col];
                if (col < DM) SH[r * DM + col] = s; else SC[r * DM + col - DM] = s; }
            for (int i = tid; i < DM; i += 512) GN[i] = norm1_g[i];
            for (int i = vcu * 512 + tid; i < 3 * NMODC; i += G * 512) { const int r = i / NMODC, col = i % NMODC;
                float s = b_ada[col];
#pragma unroll
                for (int ks = 0; ks < 4; ++ks) s += MODP[(size_t)(ks * 3 + r) * NMODC + col];
                MODS[i] = s; }
            __syncthreads();
            for (int m = gw; m < MALL; m += NGW) {
                const int r = m < MTOK ? m / SEQ : 2;
                const float* src = m < MTOK ? x_in + (size_t)m * DM : ctx + (size_t)(m - MTOK) * DM;
                modulate_row<2>(src, Hb + (size_t)m * DM, H8 + (size_t)m * DM, GN, SH + r * DM, SC + r * DM, lane);
            }
            __syncthreads();
        }
        REP(11) {
            typedef float f32x16 __attribute__((ext_vector_type(16)));
            typedef short s16x8 __attribute__((ext_vector_type(8)));
            const int cb = vcu & 127, col0 = cb * 64, l31 = lane & 31, kh = lane >> 5;
            s16x8 af[2][4];
#pragma unroll
            for (int tl = 0; tl < 2; ++tl)
#pragma unroll
                for (int kk = 0; kk < 4; ++kk)
#pragma unroll
                    for (int e = 0; e < 8; ++e) af[tl][kk][e] = (short)f2bf(hy_w3[(size_t)(16 * kk + 8 * kh + e) * 8192 + col0 + 32 * tl + l31]);
            const unsigned short* HhB = (const unsigned short*)Hh;
            for (int tb = vcu >> 7; tb < 8; tb += (G >> 7)) {
                const int t0w = tb * 1024 + wave * 128 + 4 * l31;
                s16x8 bfr[4][4];
#pragma unroll
                for (int i = 0; i < 4; ++i)
#pragma unroll
                    for (int kk = 0; kk < 4; ++kk) bfr[i][kk] = *(const s16x8*)(HhB + (size_t)(t0w + i) * 64 + 16 * kk + 8 * kh);
#pragma unroll
                for (int tl = 0; tl < 2; ++tl) {
                    f32x16 acc[4];
#pragma unroll
                    for (int i = 0; i < 4; ++i) { acc[i] = (f32x16){};
#pragma unroll
                        for (int kk = 0; kk < 4; ++kk) acc[i] = __builtin_amdgcn_mfma_f32_32x32x16_bf16(af[tl][kk], bfr[i][kk], acc[i], 0, 0, 0); }
#pragma unroll
                    for (int r = 0; r < 16; ++r) { const int col = hy::opaque(col0 + 32 * tl + 4 * kh) + (r & 3) + 8 * (r >> 2), c = col & 2047;
                        const float a0 = -3.0701134573253944f, a1 = -15.350567286626972f; const float delta = fabsf(a0 + (float)c * ((a1 - a0) / 2047.0f));
                        const float dl = delta * (1.4426950408889634f / (float)(SEQ - 1));
                        const float e1 = __builtin_amdgcn_exp2f(-dl), E0 = __builtin_amdgcn_exp2f(-(float)t0w * dl), E1 = E0 * e1, E2 = E1 * e1, E3 = E2 * e1;
                        uint2 w; w.x = pg8::cvt_pk_bf16(acc[0][r] * E0, acc[1][r] * E1); w.y = pg8::cvt_pk_bf16(acc[2][r] * E2, acc[3][r] * E3);
                        *(uint2*)((bf16*)FiltT + (size_t)col * SEQ + t0w) = w; if ((r & 3) == 3) __builtin_amdgcn_sched_barrier(0); }
                    __builtin_amdgcn_sched_barrier(0);
                }
            }
        }
        if (BOTH(1)) GRID_BAR();
        if (DUP_ID == 103) { for (int i = 0; i < 20; ++i) GRID_BAR(); }
    }

    if (IN(2)) {
        PHASE_IDS();
        REP(20) { pg8::Gemm g{WinT, Hb, HYC, MTOK, DM}; pg8::StaticOrder S; S.init(HYC, MTOK, G, bx); pg8::EpiBf16A<0> E{HyT, MTOK, 1.0f};
          pg8::gemm_phase<pg8::EpiBf16A<0>, pg8::StaticOrder, PG8_ALIGN, PG8_SP2>(lds, g, S, E); }
        REP(21) { pg8::Gemm g{(const bf16*)H8, (const bf16*)(WinT8 + (size_t)HYC * DM), MALL, INP - HYC, DM / 2}; pg8::AttProjOrder S{G, bx}; pg8::EpiAttProj E{(unsigned char*)QA, (unsigned char*)KVA, KR, 1.0f / WINSCALE};
          pg8::gemm_phase<pg8::EpiAttProj, pg8::AttProjOrder, PG8_ALIGN, PG8_SP2F8, 1>(lds, g, S, E); }
        if (BOTH(2)) GRID_BAR();
    }

    if (IN(3)) {
        PHASE_IDS();
        REP(30) { pg8::Gemm g{QA, WqbT, MTOK, 3072, QLORA / 2}; pg8::StaticOrder S; S.init(MTOK, 3072, G, bx); pg8::EpiF8A E{(unsigned char*)Qraw, 3072, 1.0f / WQBSCALE};
          pg8::gemm_phase<pg8::EpiF8A, pg8::StaticOrder, PG8_ALIGN, PG8_SP2F8, 1>(lds, g, S, E); }
        REP(31) { pg8::Gemm g{KVA, WkvbT, MALL, 4096, KVLORA / 2}; pg8::StaticOrder S; S.init(MALL, 4096, G, bx); pg8::EpiF8A E{(unsigned char*)KVraw, 4096, 1.0f / WKVBSCALE};
          pg8::gemm_phase<pg8::EpiF8A, pg8::StaticOrder, PG8_ALIGN, PG8_SP2F8, 1>(lds, g, S, E); }
        __syncthreads();
        REP(32) { hy::f2* KSb = KSall + (size_t)bx * 2 * hy::NF; const hy::Tw tw = hy::make_tw(tid);
          for (int c = vcu; c < HYW; c += G) hy::hyena_channel((LAS hy::f2*)lds, tid, c, HyT, (const bf16*)FiltT, hy_conv_w, hy_conv_b, hy_bias, KSb, YT, tw); }
        if (BOTH(3)) GRID_BAR();
    }

    if (IN(4)) {
        PHASE_IDS();
        REP(40) {
            LAS float* GQ = (LAS float*)lds; LAS float* GK = GQ + 192;
            LAS hy::f2* ROPE = (LAS hy::f2*)(lds + 2048);
            LAS unsigned char* VT = lds + 20480;
            for (int i = tid; i < 192; i += 512) { GQ[i] = q_norm_g[i]; GK[i] = k_norm_g[i]; }
            for (int i = tid; i < 2048; i += 512) { const float ang = (float)(i >> 4) * powf(10000.0f, -(float)(i & 15) / 16.0f); ROPE[i] = (hy::f2){cosf(ang), sinf(ang)}; }
            __syncthreads();
#define SUM16(v) do { v += __int_as_float(__builtin_amdgcn_update_dpp(0, __float_as_int(v), 0xB1, 0xf, 0xf, true)); v += __int_as_float(__builtin_amdgcn_update_dpp(0, __float_as_int(v), 0x4E, 0xf, 0xf, true)); \
                      v += __int_as_float(__builtin_amdgcn_update_dpp(0, __float_as_int(v), 0x124, 0xf, 0xf, true)); v += __int_as_float(__builtin_amdgcn_update_dpp(0, __float_as_int(v), 0x128, 0xf, 0xf, true)); } while (0)
            const int hl = lane >> 4, sub = lane & 15;
            float gk8[8], gk4[4], gq8[8], gq4[4];
#pragma unroll
            for (int i = 0; i < 8; ++i) { gk8[i] = GK[8 * sub + i]; gq8[i] = GQ[8 * sub + i]; }
#pragma unroll
            for (int j = 0; j < 4; ++j) { gk4[j] = GK[128 + 4 * sub + j]; gq4[j] = GQ[128 + 4 * sub + j]; }
            LAS float* STAT = (LAS float*)(lds + 57344) + wave * 16;
            int stat_tile = -1;
            for (int it = (vcu * 33) >> 3; it < ((vcu + 1) * 33) >> 3; ++it) {
                const int hq = it & 3, tile = it >> 2, b = tile / 132, kt = tile % 132, h = hq * 4 + hl;
                const bool lat = kt >= 4;
                if (tile != stat_tile) { stat_tile = tile;
#pragma unroll 1
                    for (int e = 0; e < 8; ++e) {
                        const int key = kt * 64 + wave * 8 + e, t = key - LCTX; const int m = lat ? b * SEQ + t : MTOK + b * LCTX + key;
                        float rs_kv, rs_q = 0.f;
                        { typedef unsigned u32x2 __attribute__((ext_vector_type(2))); typedef float f32x2 __attribute__((ext_vector_type(2)));
                          const u32x2 v = *(const u32x2*)((const unsigned char*)KVA + (size_t)m * KVLORA + lane * 8); float s = 0.f;
#pragma unroll
                          for (int i = 0; i < 2; ++i) { const f32x2 a = __builtin_amdgcn_cvt_pk_f32_fp8((int)v[i], false), c = __builtin_amdgcn_cvt_pk_f32_fp8((int)v[i], true); s += (a.x * a.x + a.y * a.y) + (c.x * c.x + c.y * c.y); }
                          rs_kv = 1.0f / sqrtf(wave_sum(s) * (1.f / KVLORA) + EPS);
                          if (lat) { const v4u q = *(const v4u*)((const unsigned char*)QA + (size_t)m * QLORA + lane * 16); float s2 = 0.f;
#pragma unroll
                            for (int i = 0; i < 4; ++i) { const f32x2 a = __builtin_amdgcn_cvt_pk_f32_fp8((int)q[i], false), c = __builtin_amdgcn_cvt_pk_f32_fp8((int)q[i], true); s2 += (a.x * a.x + a.y * a.y) + (c.x * c.x + c.y * c.y); }
                            rs_q = 1.0f / sqrtf(wave_sum(s2) * (1.f / QLORA) + EPS); } }
                        if (lane == 0) { STAT[2 * e] = rs_kv; STAT[2 * e + 1] = rs_q; }
                    }
                    LDS_WAIT(); asm volatile("" ::: "memory");
                }
#pragma unroll 2
                for (int e = 0; e < 8; ++e) {
                    const int ki = wave * 8 + e, key = kt * 64 + ki, t = key - LCTX;
                    const int m = lat ? b * SEQ + t : MTOK + b * LCTX + key;
                    const float rs_kv = STAT[2 * e], rs_q = STAT[2 * e + 1];
                    float cs[4], sn[4];
#pragma unroll
                    for (int j = 0; j < 4; ++j) { cs[j] = 1.f; sn[j] = 0.f; }
                    if (lat) { const int pos = (sub >> 3) ? (t & 63) : (t >> 6);
#pragma unroll
                        for (int j = 0; j < 4; ++j) { const hy::f2 r = ROPE[pos * 16 + 4 * (sub & 3) + j]; cs[j] = r.x; sn[j] = (sub & 4) ? r.y : -r.y; } }
                    const f32x4 kr = *(const f32x4*)(KR + (size_t)m * 64 + 4 * sub);
                    float ss_r = (kr.x * kr.x + kr.y * kr.y) + (kr.z * kr.z + kr.w * kr.w); SUM16(ss_r);
                    typedef unsigned u32x2 __attribute__((ext_vector_type(2))); typedef float f32x2 __attribute__((ext_vector_type(2)));
                    const unsigned char* kvr = (const unsigned char*)KVraw + (size_t)m * 4096 + h * 256 + 8 * sub;
                    const u32x2 kn8 = *(const u32x2*)kvr, v8 = *(const u32x2*)(kvr + 128);
                    float kn[8], vv[8], ssk = 0.f;
#pragma unroll
                    for (int i = 0; i < 2; ++i) { const f32x2 a = __builtin_amdgcn_cvt_pk_f32_fp8((int)kn8[i], false), c = __builtin_amdgcn_cvt_pk_f32_fp8((int)kn8[i], true), d = __builtin_amdgcn_cvt_pk_f32_fp8((int)v8[i], false), f = __builtin_amdgcn_cvt_pk_f32_fp8((int)v8[i], true);
                        kn[4 * i] = a.x; kn[4 * i + 1] = a.y; kn[4 * i + 2] = c.x; kn[4 * i + 3] = c.y; vv[4 * i] = d.x; vv[4 * i + 1] = d.y; vv[4 * i + 2] = f.x; vv[4 * i + 3] = f.y; }
#pragma unroll
                    for (int i = 0; i < 8; ++i) { kn[i] *= rs_kv; vv[i] *= rs_kv; ssk += kn[i] * kn[i]; }
                    SUM16(ssk);
                    const float rk = 1.0f / sqrtf((ssk + ss_r) * (1.f / 192.f) + EPS);
                    float kx[4] = {kr.x, kr.y, kr.z, kr.w};
#pragma unroll
                    for (int j = 0; j < 4; ++j) { kx[j] = kx[j] * rk * gk4[j]; const float px = __int_as_float(__builtin_amdgcn_ds_swizzle(__float_as_int(kx[j]), (4 << 10) | 0x1f)); kx[j] = kx[j] * cs[j] + px * sn[j]; }
#pragma unroll
                    for (int i = 0; i < 8; ++i) kn[i] = kn[i] * rk * gk8[i];
                    unsigned char* kd = (unsigned char*)Kb + ((size_t)(b * NHEAD + h) * SKEYS + key) * 192;
                    { typedef unsigned u32x2 __attribute__((ext_vector_type(2))); u32x2 w; w.x = f8pack(kn[0], kn[1], kn[2], kn[3]); w.y = f8pack(kn[4], kn[5], kn[6], kn[7]);
                      *(u32x2*)(kd + 8 * sub) = w; *(unsigned*)(kd + 128 + 4 * sub) = f8pack(kx[0], kx[1], kx[2], kx[3]); }
                    { const int k5 = ki & 31, slot = 32 * ((k5 >> 2) & 1) + 16 * (ki >> 5) + (k5 & 3) + 4 * (k5 >> 3);
                      const unsigned w0 = f8pack(vv[0], vv[1], vv[2], vv[3]), w1 = f8pack(vv[4], vv[5], vv[6], vv[7]);
                      LAS unsigned char* vd = VT + hl * 8704 + sub * 68 + slot;
#pragma unroll
                      for (int i = 0; i < 4; ++i) { vd[i * 1088] = (unsigned char)(w0 >> (8 * i)); vd[(4 + i) * 1088] = (unsigned char)(w1 >> (8 * i)); } }
                    if (lat) {
                        const unsigned char* qrp = (const unsigned char*)Qraw + (size_t)m * 3072 + h * 192;
                        const u32x2 q8 = *(const u32x2*)(qrp + 8 * sub); const unsigned q4 = *(const unsigned*)(qrp + 128 + 4 * sub);
                        float qn[8], qx[4], ssq = 0.f;
#pragma unroll
                        for (int i = 0; i < 2; ++i) { const f32x2 a = __builtin_amdgcn_cvt_pk_f32_fp8((int)q8[i], false), c = __builtin_amdgcn_cvt_pk_f32_fp8((int)q8[i], true); qn[4 * i] = a.x; qn[4 * i + 1] = a.y; qn[4 * i + 2] = c.x; qn[4 * i + 3] = c.y; }
                        { const f32x2 a = __builtin_amdgcn_cvt_pk_f32_fp8((int)q4, false), c = __builtin_amdgcn_cvt_pk_f32_fp8((int)q4, true); qx[0] = a.x; qx[1] = a.y; qx[2] = c.x; qx[3] = c.y; }
#pragma unroll
                        for (int i = 0; i < 8; ++i) { qn[i] *= rs_q; ssq += qn[i] * qn[i]; }
#pragma unroll
                        for (int j = 0; j < 4; ++j) { qx[j] *= rs_q; ssq += qx[j] * qx[j]; }
                        SUM16(ssq);
                        const float rq = 1.0f / sqrtf(ssq * (1.f / 192.f) + EPS);
#pragma unroll
                        for (int j = 0; j < 4; ++j) { qx[j] = qx[j] * rq * gq4[j]; const float px = __int_as_float(__builtin_amdgcn_ds_swizzle(__float_as_int(qx[j]), (4 << 10) | 0x1f)); qx[j] = qx[j] * cs[j] + px * sn[j]; }
#pragma unroll
                        for (int i = 0; i < 8; ++i) qn[i] = qn[i] * rq * gq8[i];
                        unsigned char* qd = (unsigned char*)Qb + ((size_t)(b * NHEAD + h) * SEQ + t) * 192;
                        typedef unsigned u32x2 __attribute__((ext_vector_type(2))); u32x2 w; w.x = f8pack(qn[0], qn[1], qn[2], qn[3]); w.y = f8pack(qn[4], qn[5], qn[6], qn[7]);
                        *(u32x2*)(qd + 8 * sub) = w; *(unsigned*)(qd + 128 + 4 * sub) = f8pack(qx[0], qx[1], qx[2], qx[3]);
                    }
                }
                __syncthreads();
#pragma unroll
                for (int j = 0; j < 4; ++j) { const int id = tid + 512 * j, hh = id >> 9, within = id & 511;
                    const int col = within >> 2; const LAS unsigned* src = (const LAS unsigned*)(VT + hh * 8704 + ((col & 7) * 16 + (col >> 3)) * 68 + (within & 3) * 16);
                    *(v4u*)((unsigned char*)Vb + ((size_t)((b * NHEAD + hq * 4 + hh) * 132 + kt)) * 8192 + within * 16) = (v4u){src[0], src[1], src[2], src[3]}; }
                __syncthreads();
            }
#undef SUM16
        }
        REP(41) {
            LAS unsigned short* T = (LAS unsigned short*)(lds + 4096 + wave * 8704);
            for (int it = gw; it < 32 * 256; it += NGW) {
                const int c0 = (it & 31) * 64, tk0 = (it >> 5) * 64;
#pragma unroll 8
                for (int i = 0; i < 64; ++i) T[i * 66 + lane] = YT[(size_t)(c0 + i) * MTOK + tk0 + lane];
                LDS_WAIT(); asm volatile("" ::: "memory");
#pragma unroll 8
                for (int j = 0; j < 64; ++j) MIX[(size_t)(tk0 + j) * MIXLD + c0 + lane] = T[lane * 66 + j];
                LDS_WAIT(); asm volatile("" ::: "memory");
            }
        }
        if (BOTH(4)) GRID_BAR();
    }

    if (IN(5)) {
        PHASE_IDS();
        REP(5) for (int u = vcu; u < NB * NHEAD * (SEQ / 256); u += G) {
            const int bh = u >> 5, qb = u & 31, b = bh >> 4, h = bh & 15;
            att8::attn_unit((const unsigned char*)Qb + ((size_t)bh * SEQ + qb * 256) * 192, (const unsigned char*)Kb + (size_t)bh * SKEYS * 192, (const unsigned char*)Vb + (size_t)bh * SKEYS * 128,
                            (unsigned char*)MIX + ((size_t)b * SEQ + qb * 256) * (2 * MIXLD) + 2 * HYW + h * 128, SKEYS, (char*)lds_raw);
        }
        if (BOTH(5)) GRID_BAR();
    }

    if (IN(6)) {
        PHASE_IDS();
        REP(6) { pg8::Gemm g{MIX, WoutT, MTOK, DM, MIXLD, HYW / 64}; pg8::StaticOrder S; S.init(MTOK, DM, G, bx); pg8::EpiResGate E{x_in, out_p, MODS + 2 * DM, DM, 1.0f};
        pg8::gemm_phase<pg8::EpiResGate, pg8::StaticOrder, PG8_ALIGN, PG8_SP2F8, 3>(lds, g, S, E); }
        if (BOTH(6)) GRID_BAR();
    }

    if (IN(7) && DUP_ID != 100) {
        PHASE_IDS();
        REP(7) {
        LAS float* SH = (LAS float*)lds; LAS float* SC = (LAS float*)(lds + 32768); LAS float* GN = (LAS float*)(lds + 65536);
        for (int i = tid; i < 2 * DM; i += 512) { const int r = i / DM, col = i % DM; SH[i] = MODS[(size_t)r * NMODC + 3 * DM + col]; SC[i] = MODS[(size_t)r * NMODC + 4 * DM + col]; }
        for (int i = tid; i < DM; i += 512) GN[i] = norm2_g[i];
        __syncthreads();
        for (int m = gw; m < MTOK; m += NGW) { const int r = m / SEQ; modulate_row_mx6(out_p + (size_t)m * DM, (unsigned char*)H2 + (size_t)m * DM, GN, SH + r * DM, SC + r * DM, lane); }
        __syncthreads();
        }
        if (BOTH(7)) GRID_BAR();
    }

    if (IN(8) && DUP_ID != 100) {
        PHASE_IDS();
        REP(8) { pg8::Gemm g{H2, W1T, MTOK, FF, DM / 2}; pg8::StaticOrder S; S.init(MTOK, FF, G, bx); pg8::EpiF8Relu2 E{(unsigned char*)HID, FF, 1.0f};
        if (DUP_ID == 8 && GEXP != 0 && rep_ == 0) pg8::gemm_phase<pg8::EpiF8Relu2, pg8::StaticOrder, PG8_ALIGN, PG8_SP2F8, 2, GEXP>(lds, g, S, E); else
        pg8::gemm_phase<pg8::EpiF8Relu2, pg8::StaticOrder, PG8_ALIGN, PG8_SP2F8, 2>(lds, g, S, E); }
        if (BOTH(8)) GRID_BAR();
    }

    if (IN(9) && DUP_ID != 100) {
        PHASE_IDS();
        REP(9) { float* o9 = (DUP_ID == 9 && rep_ == 0) ? (float*)(ws + WS_WIN) : out_p;
        pg8::Gemm g{HID, W2T, MTOK, DM, FF / 2}; pg8::StaticOrder S; S.init(MTOK, DM, G, bx); pg8::EpiResGate E{out_p, o9, MODS + 5 * DM, DM, 1.0f / W2SCALE};
        if (DUP_ID == 9 && GEXP != 0 && rep_ == 0) pg8::gemm_phase<pg8::EpiResGate, pg8::StaticOrder, PG8_ALIGN, PG8_SP2F8, 1, GEXP>(lds, g, S, E); else
        pg8::gemm_phase<pg8::EpiResGate, pg8::StaticOrder, PG8_ALIGN, PG8_SP2F8, 1>(lds, g, S, E); }
    }
#undef PHASE_IDS
#undef IN
#undef BOTH
#undef GRID_BAR
#undef x_in
#undef cvec
#undef ctx
#undef c_ctx
#undef norm1_g
#undef norm2_g
#undef w_ada
#undef b_ada
#undef w_in
#undef hy_conv_w
#undef hy_conv_b
#undef hy_w1
#undef hy_b1
#undef hy_w2
#undef hy_b2
#undef hy_w3
#undef hy_freq
#undef hy_bias
#undef g_qa
#undef w_qb
#undef g_kva
#undef w_kvb
#undef q_norm_g
#undef k_norm_g
#undef w_out
#undef w_mlp1
#undef w_mlp2
#undef out_p
#undef MODP
#undef MODS
#undef TW1
#undef TW2
#undef W1T
#undef W2T
#undef WinT
#undef WinT8
#undef H8
#undef WqbT
#undef WkvbT
#undef Hh
#undef FiltT
#undef Hb
#undef HyT
#undef QA
#undef KVA
#undef KR
#undef Qraw
#undef KVraw
#undef YT
#undef KSall
#undef Qb
#undef Kb
#undef Vb
#undef MIX
#undef WoutT
#undef H2
#undef HID
}

extern "C" void kernel_launch(void* const* d_in, const int* in_sizes, int n_in, void* d_out, int out_size, void* d_ws, size_t ws_size, hipStream_t stream) {
    static int grid = 0;
    if (grid == 0) {
        if (n_in != 27 || out_size != MTOK * DM || ws_size < WS_END) { fprintf(stderr, "kernel_launch: unexpected shapes: n_in %d out %d ws %zu (need %zu)\n", n_in, out_size, ws_size, (size_t)WS_END); grid = -1; return; }
        int dev = 0, cus = 0, per_cu = 0;
        if (hipGetDevice(&dev) != hipSuccess || hipDeviceGetAttribute(&cus, hipDeviceAttributeMultiprocessorCount, dev) != hipSuccess) { grid = -1; return; }
        if (hipFuncSetAttribute((const void*)mega_fwd, hipFuncAttributeMaxDynamicSharedMemorySize, LDS_BYTES) != hipSuccess) { fprintf(stderr, "kernel_launch: hipFuncSetAttribute failed\n"); grid = -1; return; }
        if (hipOccupancyMaxActiveBlocksPerMultiprocessor(&per_cu, (const void*)mega_fwd, NWAVES * 64, LDS_BYTES) != hipSuccess || per_cu < 1) { fprintf(stderr, "kernel_launch: occupancy query reports %d\n", per_cu); }
        (void)hipGetLastError();
        if (cus != 256) { fprintf(stderr, "kernel_launch: built for 256 CUs (several phases deal their work in fixed per-workgroup shares of a 256-workgroup grid); this device has %d; nothing launched\n", cus); grid = -1; return; }
        grid = cus;
    }
    if (grid < 0) return;
    if (hipMemsetAsync((char*)d_ws + WS_CTL, 0, CTL_ZERO_BYTES, stream) != hipSuccess) return;
    Args a{};
    for (int i = 0; i < 27; ++i) a.in[i] = (const float*)d_in[i];
    a.out = (float*)d_out; a.ws = (unsigned char*)d_ws;
    for (int li = 0; li < N_LAUNCHES; ++li) {
        a.ph_lo = (N_LAUNCHES == 1) ? 0 : li; a.ph_hi = (N_LAUNCHES == 1) ? N_PHASES : li + 1; a.li = li; a.pad = 0;
        hipLaunchKernelGGL(mega_fwd, dim3(grid), dim3(NWAVES * 64), LDS_BYTES, stream, a);
        const hipError_t le = hipPeekAtLastError();
        if (le != hipSuccess) { fprintf(stderr, "kernel_launch: launch %d failed: %s\n", li, hipGetErrorName(le)); break; }
    }
}
```

```cpp
#include <hip/hip_runtime.h>
#include <cstdio>
#include <cstdint>
#define GEXP 0
#ifndef MK_N_LAUNCHES
#define MK_N_LAUNCHES 1
#endif
namespace pg8 {
#define PG8_LAS __attribute__((address_space(3)))
typedef unsigned short bf16_t;
typedef short bf16x8 __attribute__((ext_vector_type(8)));
typedef float f32x4 __attribute__((ext_vector_type(4)));
typedef unsigned u32x4 __attribute__((ext_vector_type(4)));
typedef int i32x4 __attribute__((ext_vector_type(4)));
typedef int i32x8 __attribute__((ext_vector_type(8)));
constexpr int BM = 256, BK = 64, HALF = 128, HTB = HALF * BK * 2  , STAGE_BYTES = 8 * HTB, NXCD = 8, WGM = 4;

__host__ __device__ __forceinline__ int lds_byte(int r, int c) { const int st = (r >> 4) * 2 + (c >> 5), rr = r & 15, cc = c & 31, ob = rr * 64 + cc * 2; return st * 1024 + (ob ^ (((ob >> 9) & 1) << 5)); }
__host__ __device__ __forceinline__ void stage_rc(int b, int& R, int& C) { const int st = b / 1024, sb = b % 1024, swz = sb ^ (((sb >> 9) & 1) << 5); R = (st >> 1) * 16 + swz / 64; C = (st & 1) * 32 + (swz % 64) / 2; }
__host__ __device__ __forceinline__ int perm32(int rho) { const int n = rho >> 4, i = rho & 15; return 8 * (i >> 2) + 4 * n + (i & 3); }

struct Unit { int pm, pn; };
struct Gemm { const bf16_t* A; const bf16_t* Bt; int M, N, K; int tsplit = 0; };

struct StaticOrder {
    int nM, nN, nwg, G, c;
    __host__ __device__ void init(int M, int N, int G_, int c_) { nM = M / BM; nN = N / BM; nwg = nM * nN; G = G_; c = c_; }
    __host__ __device__ bool next(int i, Unit& u) const {
        const long L = (long)i * G + c; if (L >= nwg) return false;
        int wgid = (int)L; { const int q = nwg / NXCD, r = nwg % NXCD, xcd = wgid % NXCD, off = wgid / NXCD; wgid = (xcd < r ? xcd * (q + 1) : r * (q + 1) + (xcd - r) * q) + off; }
        const int nig = WGM * nN, gid = wgid / nig, fm = gid * WGM, gsz = (nM - fm) < WGM ? (nM - fm) : WGM;
        u.pm = fm + ((wgid % nig) % gsz); u.pn = (wgid % nig) / gsz; return true;
    }
    __device__ __forceinline__ void a_ready(const Unit&) const {}
    __device__ __forceinline__ void done(const Unit&) const {}
};

__device__ __forceinline__ unsigned cvt_pk_bf16(float lo, float hi) { unsigned r; asm volatile("v_cvt_pk_bf16_f32 %0, %1, %2" : "=v"(r) : "v"(lo), "v"(hi)); return r; }
typedef float f32x2 __attribute__((ext_vector_type(2)));
template <int ACT> struct EpiBf16A {
    static constexpr bool PERM = true, AFTER_DRAIN = false;
    bf16_t* O; int ldc; float s;
    __device__ __forceinline__ void operator()(const f32x4 (&acc)[2][2][4][2], const Unit& u, int wr, int wc, int fr, int fq) const {
        const int row0 = u.pm * BM + wr * 64 + fr, col0 = u.pn * BM + wc * 32 + 8 * fq;
#pragma unroll
        for (int ai = 0; ai < 2; ++ai)
#pragma unroll
            for (int m = 0; m < 4; ++m) { bf16_t* rowp = O + (size_t)(row0 + ai * HALF + m * 16) * ldc + col0;
#pragma unroll
                for (int bj = 0; bj < 2; ++bj) { f32x4 v0 = acc[ai][bj][m][0] * s, v1 = acc[ai][bj][m][1] * s;
                    if (ACT == 1) {
#pragma unroll
                        for (int j = 0; j < 4; ++j) { const float a = fmaxf(v0[j], 0.f), b = fmaxf(v1[j], 0.f); v0[j] = a * a; v1[j] = b * b; } }
                    u32x4 w; w.x = cvt_pk_bf16(v0[0], v0[1]); w.y = cvt_pk_bf16(v0[2], v0[3]); w.z = cvt_pk_bf16(v1[0], v1[1]); w.w = cvt_pk_bf16(v1[2], v1[3]);
                    *(u32x4*)(rowp + bj * HALF) = w; } }
    }
};
__device__ __forceinline__ unsigned pack4_fp8(float a, float b, float c, float d) {
    a = fminf(a, 448.f); b = fminf(b, 448.f); c = fminf(c, 448.f); d = fminf(d, 448.f);
    int w = 0; w = __builtin_amdgcn_cvt_pk_fp8_f32(a, b, w, false); w = __builtin_amdgcn_cvt_pk_fp8_f32(c, d, w, true); return (unsigned)w; }
struct EpiF8A {
    static constexpr bool PERM = true, AFTER_DRAIN = false;
    unsigned char* O; int ldc; float s;
    __device__ __forceinline__ void operator()(const f32x4 (&acc)[2][2][4][2], const Unit& u, int wr, int wc, int fr, int fq) const {
        const int row0 = u.pm * BM + wr * 64 + fr, col0 = u.pn * BM + wc * 32 + 8 * fq;
#pragma unroll
        for (int ai = 0; ai < 2; ++ai)
#pragma unroll
            for (int m = 0; m < 4; ++m) { unsigned char* rowp = O + (size_t)(row0 + ai * HALF + m * 16) * ldc + col0;
#pragma unroll
                for (int bj = 0; bj < 2; ++bj) { const f32x4 v0 = acc[ai][bj][m][0] * s, v1 = acc[ai][bj][m][1] * s;
                    typedef unsigned u32x2 __attribute__((ext_vector_type(2)));
                    u32x2 w; w.x = pack4_fp8(fmaxf(v0[0], -448.f), fmaxf(v0[1], -448.f), fmaxf(v0[2], -448.f), fmaxf(v0[3], -448.f)); w.y = pack4_fp8(fmaxf(v1[0], -448.f), fmaxf(v1[1], -448.f), fmaxf(v1[2], -448.f), fmaxf(v1[3], -448.f));
                    *(u32x2*)(rowp + bj * HALF) = w; } }
    }
};
struct EpiF8Relu2 {
    static constexpr bool PERM = true, AFTER_DRAIN = false;
    unsigned char* O; int ldc; float s;
    __device__ __forceinline__ void operator()(const f32x4 (&acc)[2][2][4][2], const Unit& u, int wr, int wc, int fr, int fq) const {
        const int row0 = u.pm * BM + wr * 64 + fr, col0 = u.pn * BM + wc * 32 + 8 * fq;
#pragma unroll
        for (int ai = 0; ai < 2; ++ai)
#pragma unroll
            for (int m = 0; m < 4; ++m) { unsigned char* rowp = O + (size_t)(row0 + ai * HALF + m * 16) * ldc + col0;
#pragma unroll
                for (int bj = 0; bj < 2; ++bj) { f32x4 v0 = acc[ai][bj][m][0] * s, v1 = acc[ai][bj][m][1] * s;
#pragma unroll
                    for (int j = 0; j < 4; ++j) { const float a = fmaxf(v0[j], 0.f), b = fmaxf(v1[j], 0.f); v0[j] = a * a; v1[j] = b * b; }
                    typedef unsigned u32x2 __attribute__((ext_vector_type(2)));
                    u32x2 w; w.x = pack4_fp8(v0[0], v0[1], v0[2], v0[3]); w.y = pack4_fp8(v1[0], v1[1], v1[2], v1[3]);
                    *(u32x2*)(rowp + bj * HALF) = w; } }
    }
};
struct EpiAttProj {
    static constexpr bool PERM = true, AFTER_DRAIN = false;
    unsigned char* QA; unsigned char* KVA; float* KR; float s;
    __device__ __forceinline__ void operator()(const f32x4 (&acc)[2][2][4][2], const Unit& u, int wr, int wc, int fr, int fq) const {
        const int row0 = u.pm * BM + wr * 64 + fr;
        if (u.pn < 6) {
            unsigned char* base = u.pn < 4 ? QA : KVA; const int ldc = u.pn < 4 ? 1024 : 512; const int col0 = (u.pn < 4 ? u.pn : u.pn - 4) * BM + wc * 32 + 8 * fq;
#pragma unroll
            for (int ai = 0; ai < 2; ++ai)
#pragma unroll
                for (int m = 0; m < 4; ++m) { unsigned char* rowp = base + (size_t)(row0 + ai * HALF + m * 16) * ldc + col0;
#pragma unroll
                    for (int bj = 0; bj < 2; ++bj) { const f32x4 v0 = acc[ai][bj][m][0] * s, v1 = acc[ai][bj][m][1] * s;
                        typedef unsigned u32x2 __attribute__((ext_vector_type(2)));
                        u32x2 w; w.x = pack4_fp8(fmaxf(v0[0], -448.f), fmaxf(v0[1], -448.f), fmaxf(v0[2], -448.f), fmaxf(v0[3], -448.f)); w.y = pack4_fp8(fmaxf(v1[0], -448.f), fmaxf(v1[1], -448.f), fmaxf(v1[2], -448.f), fmaxf(v1[3], -448.f));
                        *(u32x2*)(rowp + bj * HALF) = w; } }
        } else if (wc < 2) {
            const int col0 = wc * 32 + 8 * fq;
#pragma unroll
            for (int ai = 0; ai < 2; ++ai)
#pragma unroll
                for (int m = 0; m < 4; ++m) { float* rowp = KR + (size_t)(row0 + ai * HALF + m * 16) * 64 + col0;
                    *(f32x4*)(rowp) = acc[ai][0][m][0] * s; *(f32x4*)(rowp + 4) = acc[ai][0][m][1] * s; }
        }
    }
};
struct EpiResGate {
    static constexpr bool PERM = false, AFTER_DRAIN = false;
    const float* base; float* out; const float* gate; int ldc; float scale;
    __device__ __forceinline__ void operator()(const f32x4 (&acc)[2][2][4][2], const Unit& u, int wr, int wc, int fr, int fq) const {
        const int row0 = u.pm * BM + wr * 64 + fr, col0 = u.pn * BM + wc * 32 + 4 * fq;
        const float* g = gate + (size_t)(u.pm >> 5) * 24576;
        f32x4 gv[2][2];
#pragma unroll
        for (int bj = 0; bj < 2; ++bj)
#pragma unroll
            for (int n = 0; n < 2; ++n) gv[bj][n] = *(const f32x4*)(g + col0 + bj * HALF + n * 16) * scale;
#pragma unroll
        for (int ai = 0; ai < 2; ++ai) { f32x4 bs[4][2][2];
#pragma unroll
            for (int m = 0; m < 4; ++m) { const size_t off = (size_t)(row0 + ai * HALF + m * 16) * ldc + col0;
#pragma unroll
                for (int bj = 0; bj < 2; ++bj)
#pragma unroll
                    for (int n = 0; n < 2; ++n) bs[m][bj][n] = *(const f32x4*)(base + off + bj * HALF + n * 16); }
#pragma unroll
            for (int m = 0; m < 4; ++m) { const size_t off = (size_t)(row0 + ai * HALF + m * 16) * ldc + col0;
#pragma unroll
                for (int bj = 0; bj < 2; ++bj)
#pragma unroll
                    for (int n = 0; n < 2; ++n) *(f32x4*)(out + off + bj * HALF + n * 16) = bs[m][bj][n] + gv[bj][n] * acc[ai][bj][m][n]; }
            asm volatile("" ::: "memory"); }
    }
};
struct AttProjOrder {
    int G, c;
    __device__ __forceinline__ bool next(int i, Unit& u) const {
        const long L = (long)i * G + c; if (L >= 454) return false;
        int wgid = (int)L; { const int q = 454 / NXCD, r = 454 % NXCD, xcd = wgid % NXCD, off = wgid / NXCD; wgid = (xcd < r ? xcd * (q + 1) : r * (q + 1) + (xcd - r) * q) + off; }
        if (wgid < 448) { u.pm = wgid / 7; u.pn = wgid % 7; } else { const int r2 = wgid - 448; u.pm = 64 + r2 / 3; u.pn = 4 + r2 % 3; }
        return true;
    }
    __device__ __forceinline__ void a_ready(const Unit&) const {}
    __device__ __forceinline__ void done(const Unit&) const {}
};
template <class Epi, class Sched, bool ALIGN_EPI = false, bool SP2 = false, int FP8 = 0  , int EXP = 0  >
__device__ __forceinline__ void gemm_phase(PG8_LAS unsigned char* lds, const Gemm g, const Sched& S, const Epi& E) {
    int tid_o = threadIdx.x; asm volatile("" : "+v"(tid_o));
    const int tid = tid_o, wid = __builtin_amdgcn_readfirstlane(tid >> 6), lane = tid & 63, wr = wid >> 2, wc = wid & 3, fr = lane & 15, fq = lane >> 4;
    const int K = g.K, nt = K / BK;
    unsigned voffA[2], voffB[2];
#pragma unroll
    for (int i = 0; i < 2; ++i) { int R, C; stage_rc(tid * 16 + i * 8192, R, C); const int Rb = Epi::PERM ? ((R & ~31) + perm32(R & 31)) : R;
        voffA[i] = (unsigned)(R * K + C) * 2u; voffB[i] = (unsigned)(Rb * K + C) * 2u; }
    const size_t kstep = (size_t)(BK * 2);
    const size_t hstep = (size_t)HALF * K * 2;
    const size_t tstep = 2 * hstep;
    const unsigned ldsw = (unsigned)wid * 1024u;
    const int aoff = lds_byte(wr * 64 + fr, fq * 8), boff = lds_byte(wc * 32 + fr, fq * 8);
#define PG8_SA(b, h) (((b) * 2 + (h)) * HTB)
#define PG8_SB(b, h) ((4 + (b) * 2 + (h)) * HTB)
#define PG8_STAGE(bufoff, gbase, voff) do { _Pragma("unroll") for (int _i = 0; _i < 2; ++_i) \
        __builtin_amdgcn_global_load_lds((const unsigned*)((const char*)(gbase) + (voff)[_i]), (PG8_LAS unsigned*)(lds + (bufoff) + ldsw + _i * 8192), 16, 0, 0); } while (0)
#define PG8_STAGE_L(bufoff, gbase, voff) do { if constexpr (EXP != 3) PG8_STAGE(bufoff, gbase, voff); } while (0)
#define PG8_CAT(v0, v1) __builtin_shufflevector(v0, v1, 0, 1, 2, 3, 4, 5, 6, 7)
#define PG8_LDA(dst, b, h) do { _Pragma("unroll") for (int m = 0; m < 4; ++m) { if constexpr (FP8) dst##8[m] = PG8_CAT(*(const PG8_LAS i32x4*)(lds + PG8_SA(b, h) + aoff + m * 2048), *(const PG8_LAS i32x4*)(lds + PG8_SA(b, h) + aoff + m * 2048 + 1024)); \
        else { _Pragma("unroll") for (int k = 0; k < 2; ++k) dst[m][k] = *(const PG8_LAS bf16x8*)(lds + PG8_SA(b, h) + aoff + m * 2048 + k * 1024); } } } while (0)
#define PG8_LDB(dst, b, h) do { _Pragma("unroll") for (int n = 0; n < 2; ++n) { if constexpr (FP8) dst##8[n] = PG8_CAT(*(const PG8_LAS i32x4*)(lds + PG8_SB(b, h) + boff + n * 2048), *(const PG8_LAS i32x4*)(lds + PG8_SB(b, h) + boff + n * 2048 + 1024)); \
        else { _Pragma("unroll") for (int k = 0; k < 2; ++k) dst[n][k] = *(const PG8_LAS bf16x8*)(lds + PG8_SB(b, h) + boff + n * 2048 + k * 1024); } } } while (0)
#define PG8_MMA(ai, bj, At, Bt) do { __builtin_amdgcn_s_setprio(1); _Pragma("unroll") for (int m = 0; m < 4; ++m) _Pragma("unroll") for (int n = 0; n < 2; ++n) { \
        if constexpr (EXP == 2) { asm volatile("" :: "v"(Bt##8[n]), "v"(At##8[m])); } else if constexpr (PG8_F == 1) asm volatile("s_nop 1\n\tv_mfma_scale_f32_16x16x128_f8f6f4 %0, %1, %2, %0, %3, %3 op_sel_hi:[0,0,0]" : "+v"(acc[ai][bj][m][n]) : "v"(Bt##8[n]), "v"(At##8[m]), "v"(f8scale)); \
        else if constexpr (PG8_F == 2) asm volatile("s_nop 1\n\tv_mfma_scale_f32_16x16x128_f8f6f4 %0, %1, %2, %0, %3, %4 op_sel_hi:[0,0,0] cbsz:2 blgp:2" : "+v"(acc[ai][bj][m][n]) \
            : "v"(__builtin_shufflevector(Bt##8[n], Bt##8[n], 0, 1, 2, 3, 4, 5)), "v"(__builtin_shufflevector(At##8[m], At##8[m], 0, 1, 2, 3, 4, 5)), "v"(Bt##8[n][6]), "v"(At##8[m][6])); \
        else if constexpr (FP8 == 3) { _Pragma("unroll") for (int k = 0; k < 2; ++k) { if (k == 0) asm volatile("s_nop 1\n\tv_mfma_f32_16x16x32_bf16 %0, %1, %2, %0" : "+v"(acc[ai][bj][m][n]) : "v"(__builtin_shufflevector(Bt##8[n], Bt##8[n], 0, 1, 2, 3)), "v"(__builtin_shufflevector(At##8[m], At##8[m], 0, 1, 2, 3))); \
            else asm volatile("s_nop 1\n\tv_mfma_f32_16x16x32_bf16 %0, %1, %2, %0" : "+v"(acc[ai][bj][m][n]) : "v"(__builtin_shufflevector(Bt##8[n], Bt##8[n], 4, 5, 6, 7)), "v"(__builtin_shufflevector(At##8[m], At##8[m], 4, 5, 6, 7))); } }   \
        else { _Pragma("unroll") for (int k = 0; k < 2; ++k) acc[ai][bj][m][n] = __builtin_amdgcn_mfma_f32_16x16x32_bf16(Bt[n][k], At[m][k], acc[ai][bj][m][n], 0, 0, 0); } } __builtin_amdgcn_s_setprio(0); } while (0)
#define PG8_F (FP8 == 3 ? 2 : FP8)
#define PG8_WAIT_V(n) asm volatile("s_waitcnt vmcnt(" #n ")" ::: "memory")
#define PG8_WAIT_L(n) asm volatile("s_waitcnt lgkmcnt(" #n ")" ::: "memory")
#define PG8_BAR __builtin_amdgcn_s_barrier()
#define PG8_SCHED __builtin_amdgcn_sched_barrier(0)
#define PG8_SP2_BODY \
            PG8_LDB(B0, 0, 0); PG8_LDB(B1, 0, 1); PG8_SCHED; PG8_LDA(At, 0, 0); PG8_STAGE_L(PG8_SA(1, 1), a1 + hstep, voffA); \
            PG8_WAIT_V(8); PG8_WAIT_L(0); PG8_BAR; PG8_MMA(0, 0, At, B0); PG8_MMA(0, 1, At, B1); PG8_BAR; PG8_SCHED; \
            PG8_LDA(At, 0, 1); PG8_STAGE_L(PG8_SB(0, 0), b2, voffB); PG8_STAGE_L(PG8_SB(0, 1), b2 + hstep, voffB); PG8_STAGE_L(PG8_SA(0, 0), a2, voffA); \
            PG8_WAIT_V(8); PG8_WAIT_L(0); PG8_BAR; PG8_MMA(1, 0, At, B0); PG8_MMA(1, 1, At, B1); PG8_BAR; PG8_SCHED; \
            PG8_LDB(B0, 1, 0); PG8_LDB(B1, 1, 1); PG8_SCHED; PG8_LDA(At, 1, 0); PG8_STAGE_L(PG8_SA(0, 1), a2 + hstep, voffA); \
            PG8_WAIT_V(8); PG8_WAIT_L(0); PG8_BAR; PG8_MMA(0, 0, At, B0); PG8_MMA(0, 1, At, B1); PG8_BAR; PG8_SCHED; \
            PG8_LDA(At, 1, 1); PG8_STAGE_L(PG8_SB(1, 0), b3, voffB); PG8_STAGE_L(PG8_SB(1, 1), b3 + hstep, voffB); PG8_STAGE_L(PG8_SA(1, 0), a3, voffA); \
            PG8_WAIT_V(8); PG8_WAIT_L(0); PG8_BAR; PG8_MMA(1, 0, At, B0); PG8_MMA(1, 1, At, B1); PG8_BAR; PG8_SCHED;
    Unit cur, nxt; int ui = 0;
    if (!S.next(0, cur)) return;
    f32x4 acc[2][2][4][2];
#pragma unroll
    for (int a = 0; a < 2; ++a)
#pragma unroll
        for (int b = 0; b < 2; ++b)
#pragma unroll
            for (int m = 0; m < 4; ++m)
#pragma unroll
                for (int n = 0; n < 2; ++n) acc[a][b][m][n] = (f32x4){0.f, 0.f, 0.f, 0.f};
    const int f8scale = 0x7f7f7f7f;
    bf16x8 At[4][2], B0[2][2], B1[2][2]; i32x8 At8[4], B08[2], B18[2];
    const char* cA = (const char*)g.A + (size_t)(EXP == 1 ? 0 : cur.pm) * tstep; const char* cB = (const char*)g.Bt + (size_t)(EXP == 1 ? 0 : cur.pn) * tstep;
    S.a_ready(cur);
    if constexpr (SP2) {
        PG8_STAGE(PG8_SB(0, 0), cB, voffB); PG8_STAGE(PG8_SB(0, 1), cB + hstep, voffB); PG8_STAGE(PG8_SA(0, 0), cA, voffA); PG8_STAGE(PG8_SA(0, 1), cA + hstep, voffA);
        if (wr == 1) PG8_BAR;
        PG8_WAIT_V(2); PG8_BAR;
        PG8_STAGE(PG8_SB(1, 0), cB + kstep, voffB); PG8_STAGE(PG8_SA(1, 0), cA + kstep, voffA); PG8_STAGE(PG8_SB(1, 1), cB + hstep + kstep, voffB);
        PG8_WAIT_V(6); PG8_BAR;
    } else {
        PG8_STAGE(PG8_SB(0, 0), cB, voffB); PG8_STAGE(PG8_SA(0, 0), cA, voffA); PG8_STAGE(PG8_SB(0, 1), cB + hstep, voffB); PG8_STAGE(PG8_SA(0, 1), cA + hstep, voffA);
        if (wr == 1) PG8_BAR;
        PG8_WAIT_V(4); PG8_BAR;
        PG8_STAGE(PG8_SB(1, 0), cB + kstep, voffB); PG8_STAGE(PG8_SA(1, 0), cA + kstep, voffA); PG8_STAGE(PG8_SB(1, 1), cB + hstep + kstep, voffB);
        PG8_WAIT_V(6); PG8_BAR;
    }
    for (;;) {
        const bool has_next = S.next(ui + 1, nxt);
        const char* nA = (has_next && EXP != 1) ? (const char*)g.A + (size_t)nxt.pm * tstep : cA; const char* nB = (has_next && EXP != 1) ? (const char*)g.Bt + (size_t)nxt.pn * tstep : cB;
        int t = 0;
        if constexpr (FP8 == 3) {
            for (; t < g.tsplit; t += 2) {
                const char* a1 = cA + (size_t)(t + 1) * kstep; const char* a2 = cA + (size_t)(t + 2) * kstep; const char* b2 = cB + (size_t)(t + 2) * kstep; const char* a3 = a2 + kstep; const char* b3 = b2 + kstep;
#undef PG8_F
#define PG8_F 0
                PG8_SP2_BODY
#undef PG8_F
#define PG8_F (FP8 == 3 ? 2 : FP8)
            }
        }
        for (; t < nt; t += 2) {
            const bool last = (t == nt - 2);
            const char* a1 = cA + (size_t)(t + 1) * kstep;
            const char* a2 = last ? nA : cA + (size_t)(t + 2) * kstep; const char* b2 = last ? nB : cB + (size_t)(t + 2) * kstep;
            const char* a3 = a2 + kstep; const char* b3 = b2 + kstep;
            if (last && has_next) S.a_ready(nxt);
            if constexpr (SP2) {
            PG8_SP2_BODY
            } else {
            PG8_LDB(B0, 0, 0); PG8_SCHED; PG8_LDA(At, 0, 0); PG8_STAGE_L(PG8_SA(1, 1), a1 + hstep, voffA);
            PG8_WAIT_L(8); PG8_BAR; PG8_WAIT_L(0); PG8_MMA(0, 0, At, B0); PG8_BAR; PG8_SCHED;
            PG8_LDB(B1, 0, 1); PG8_STAGE_L(PG8_SB(0, 0), b2, voffB);
            PG8_BAR; PG8_WAIT_L(0); PG8_MMA(0, 1, At, B1); PG8_BAR;
            PG8_LDA(At, 0, 1); PG8_STAGE_L(PG8_SA(0, 0), a2, voffA);
            PG8_BAR; PG8_WAIT_L(0); PG8_MMA(1, 0, At, B0); PG8_BAR; PG8_SCHED;
            PG8_STAGE_L(PG8_SB(0, 1), b2 + hstep, voffB);
            PG8_WAIT_V(6); PG8_BAR; PG8_MMA(1, 1, At, B1); PG8_BAR;
            PG8_LDB(B0, 1, 0); PG8_SCHED; PG8_LDA(At, 1, 0); PG8_STAGE_L(PG8_SA(0, 1), a2 + hstep, voffA);
            PG8_WAIT_L(8); PG8_BAR; PG8_WAIT_L(0); PG8_MMA(0, 0, At, B0); PG8_BAR; PG8_SCHED;
            PG8_LDB(B1, 1, 1); PG8_STAGE_L(PG8_SB(1, 0), b3, voffB);
            PG8_BAR; PG8_WAIT_L(0); PG8_MMA(0, 1, At, B1); PG8_BAR;
            PG8_LDA(At, 1, 1); PG8_STAGE_L(PG8_SA(1, 0), a3, voffA);
            PG8_BAR; PG8_WAIT_L(0); PG8_MMA(1, 0, At, B0); PG8_BAR; PG8_SCHED;
            PG8_STAGE_L(PG8_SB(1, 1), b3 + hstep, voffB);
            PG8_WAIT_V(6); PG8_BAR; PG8_MMA(1, 1, At, B1); PG8_BAR;
            }
        }
        if constexpr (FP8) asm volatile("s_nop 15\n\ts_nop 15" ::: "memory");
        if constexpr (ALIGN_EPI) { if (wr == 0) PG8_BAR; }
        if constexpr (!Epi::AFTER_DRAIN) { E(acc, cur, wr, wc, fr, fq); S.done(cur); }
        if (!has_next) break;
#pragma unroll
        for (int a = 0; a < 2; ++a)
#pragma unroll
            for (int b = 0; b < 2; ++b)
#pragma unroll
                for (int m = 0; m < 4; ++m)
#pragma unroll
                    for (int n = 0; n < 2; ++n) acc[a][b][m][n] = (f32x4){0.f, 0.f, 0.f, 0.f};
        if constexpr (FP8) asm volatile("s_nop 7" ::: "memory");
        cur = nxt; cA = nA; cB = nB; ++ui;
        if constexpr (ALIGN_EPI) { if (wr == 1) PG8_BAR; }
    }
    PG8_WAIT_V(0);
    if constexpr (!ALIGN_EPI) { if (wr == 0) PG8_BAR; }
    PG8_BAR;
    if constexpr (Epi::AFTER_DRAIN) { E.fused(acc, cur, wr, wc, fr, fq, lds, wid, lane); S.done(cur); }
#undef PG8_SA
#undef PG8_SB
#undef PG8_STAGE
#undef PG8_SP2_BODY
#undef PG8_F
#undef PG8_STAGE_L
#undef PG8_LDA
#undef PG8_LDB
#undef PG8_MMA
#undef PG8_CAT
#undef PG8_WAIT_V
#undef PG8_WAIT_L
#undef PG8_BAR
#undef PG8_SCHED
}
}
#ifndef PG8_SP2
#define PG8_SP2 true
#endif
#ifndef PG8_SP2F8
#define PG8_SP2F8 true
#endif
#ifndef PG8_ALIGN
#define PG8_ALIGN true
#endif
#define GAS __attribute__((address_space(1)))
#define LAS __attribute__((address_space(3)))
typedef unsigned short bf16;
typedef unsigned v4u __attribute__((ext_vector_type(4)));
typedef float f32x4 __attribute__((ext_vector_type(4)));
typedef short bf16x8 __attribute__((ext_vector_type(8)));
typedef GAS unsigned gu32;
typedef GAS unsigned long long gu64;
#define RLX_AGENT __ATOMIC_RELAXED, __HIP_MEMORY_SCOPE_AGENT
#define LDS_WAIT() asm volatile("s_waitcnt lgkmcnt(0)" ::: "memory")
#define VM_WAIT() asm volatile("s_waitcnt vmcnt(0)" ::: "memory")
__device__ __forceinline__ unsigned long long rt() { return __builtin_amdgcn_s_memrealtime(); }
__device__ __forceinline__ unsigned f2bf(float f) { unsigned u = __builtin_bit_cast(unsigned, f); return (u + 0x7fffu + ((u >> 16) & 1u)) >> 16; }
__device__ __forceinline__ unsigned pk2(float lo, float hi) { return f2bf(lo) | (f2bf(hi) << 16); }
typedef float f32x16v __attribute__((ext_vector_type(16)));
typedef int i32x6v __attribute__((ext_vector_type(6)));
__device__ __forceinline__ void mx6_pack(f32x16v a, f32x16v b, v4u& lo, v4u& hi) {
    float mx = 0.f;
#pragma unroll
    for (int i = 0; i < 16; ++i) mx = fmaxf(mx, fmaxf(fabsf(a[i]), fabsf(b[i])));
    int sb = (int)((__float_as_uint(mx) >> 23) & 0xffu) - 2; sb = sb < 1 ? 1 : sb;
    const float mult = __uint_as_float((unsigned)(254 - sb) << 23);
#pragma unroll
    for (int i = 0; i < 16; ++i) { a[i] = fminf(fmaxf(a[i] * mult, -7.5f), 7.5f); b[i] = fminf(fmaxf(b[i] * mult, -7.5f), 7.5f); }
    const i32x6v p = __builtin_amdgcn_cvt_scalef32_2xpk16_fp6_f32(a, b, 1.0f);
    lo = (v4u){(unsigned)p[0], (unsigned)p[1], (unsigned)p[2], (unsigned)p[3]}; hi = (v4u){(unsigned)p[4], (unsigned)p[5], (unsigned)sb, 0u};
}
__device__ __forceinline__ size_t mx6_off(int blk) { return (size_t)(blk >> 2) * 128 + 16 * (blk & 3); }
#define XB_TMO      128
#define XB_XCNT(j)  (256  + 64 * (j))
#define XB_XSUB(j)  (1280 + 64 * (j))
#define XB_XGEN(j)  (2304 + 64 * (j))
#define XB_TOP      3328
#define XB_TOPGEN   3392
#define XCD_BAR_WORDS 3456
#define XB_SPIN_CAP (1u << 18)

__device__ __forceinline__ unsigned xb_ld(unsigned* p)              { return __hip_atomic_load(p, __ATOMIC_RELAXED, __HIP_MEMORY_SCOPE_AGENT); }
__device__ __forceinline__ unsigned xb_add(unsigned* p, unsigned v) { return __hip_atomic_fetch_add(p, v, __ATOMIC_RELAXED, __HIP_MEMORY_SCOPE_AGENT); }
__device__ __forceinline__ unsigned xb_xcc_id() { return (unsigned)__builtin_amdgcn_s_getreg((3 << 11) | 20) & 0xFu; }
#define XB_SPIN(cond, bar) do { unsigned _sp = 0; while (cond) { __builtin_amdgcn_s_sleep(1); \
    if ((++_sp & 255u) == 0u) { if (xb_ld(&(bar)[XB_TMO])) break; if (_sp > XB_SPIN_CAP) { atomicAdd(&(bar)[XB_TMO], 1u); break; } } } } while (0)

struct XcdBarrier {
    unsigned* bar; unsigned x;
    volatile LAS unsigned* st;
};

__device__ __forceinline__ XcdBarrier xcd_barrier_post(unsigned* bar, volatile LAS unsigned* st) {
    XcdBarrier b; b.bar = bar; b.x = xb_xcc_id(); b.st = st;
    if (threadIdx.x == 0) (void)xb_add(&bar[XB_XCNT(b.x)], 1u);
    return b;
}
__device__ __forceinline__ void xcd_barrier_complete(unsigned* bar, unsigned x, unsigned& nloc, unsigned& nx) {
    const unsigned G = gridDim.x * gridDim.y * gridDim.z;
    unsigned sum, cnt, mine, sp = 0u;
    for (;;) {
        sum = 0u; cnt = 0u; mine = 0u;
#pragma unroll
        for (unsigned j = 0; j < 16; ++j) { const unsigned c = xb_ld(&bar[XB_XCNT(j)]); sum += c; cnt += (c > 0u) ? 1u : 0u; mine = (j == x) ? c : mine; }
        if (sum == G) break;
        __builtin_amdgcn_s_sleep(1);
        if ((++sp & 255u) == 0u) { if (xb_ld(&bar[XB_TMO])) break; if (sp > XB_SPIN_CAP) { atomicAdd(&bar[XB_TMO], 1u); break; } }
    }
    nloc = mine > 0u ? mine : 1u; nx = cnt > 0u ? cnt : 1u;
}

__device__ __forceinline__ void xcd_barrier(const XcdBarrier& b) {
    asm volatile("s_waitcnt vmcnt(0)" ::: "memory");
    __syncthreads();
    if (threadIdx.x == 0) {
        unsigned* bar = b.bar;
        __builtin_amdgcn_s_waitcnt(0);
        unsigned nloc = b.st[0], nx = b.st[1];
        if (nloc == 0u) { xcd_barrier_complete(bar, b.x, nloc, nx); b.st[0] = nloc; b.st[1] = nx; }
        const unsigned old = xb_add(&bar[XB_XSUB(b.x)], 1u);
        const unsigned gen = old / nloc;
        if (old + 1u == (gen + 1u) * nloc) {
            __builtin_amdgcn_fence(__ATOMIC_RELEASE, "agent");
            asm volatile("s_waitcnt vmcnt(0)" ::: "memory");
            const unsigned og = xb_add(&bar[XB_TOP], 1u);
            const unsigned tg = og / nx;
            if (og + 1u == (tg + 1u) * nx) xb_add(&bar[XB_TOPGEN], 1u);
            else XB_SPIN(xb_ld(&bar[XB_TOPGEN]) == tg, bar);
            __builtin_amdgcn_fence(__ATOMIC_ACQUIRE, "agent");
            xb_add(&bar[XB_XGEN(b.x)], 1u);
            asm volatile("s_waitcnt vmcnt(0)" ::: "memory");
        } else {
            XB_SPIN(xb_ld(&bar[XB_XGEN(b.x)]) == gen, bar);
            __builtin_amdgcn_fence(__ATOMIC_ACQUIRE, "agent");
            asm volatile("s_waitcnt vmcnt(0)" ::: "memory");
        }
    }
    __syncthreads();
}
namespace att8 {
typedef unsigned short bf16;
using i32x4 = __attribute__((ext_vector_type(4))) int;
using i32x8 = __attribute__((ext_vector_type(8))) int;
using i32x2 = __attribute__((ext_vector_type(2))) int;
using f32x16 = __attribute__((ext_vector_type(16))) float;
constexpr int DQ = 192, DVV = 128, NW = 8, QBLK = 32, KVBLK = 64;
constexpr float SCALE = 0.07216878364870323f;
constexpr float THR = 3.f, POFF = 4.f;
constexpr int SHM_V = DVV * KVBLK, SHM_K = KVBLK * DQ, SHM_ATTN = 2 * SHM_V + 2 * SHM_K + NW * 64 * 4;
#define A8BAR() __builtin_amdgcn_sched_barrier(0)
__device__ __forceinline__ int crow(int r, int hi) { return (r & 3) + 8 * (r >> 2) + 4 * hi; }
__device__ __forceinline__ int k_off(int r, int s) { return r * 192 + (((s & ~3) | ((s & 3) ^ ((r >> 2) & 3))) << 4); }
__device__ __forceinline__ int v_off(int c, int s) { return c * 64 + ((s ^ ((c >> 2) & 3)) << 4); }
__device__ __forceinline__ f32x16 mfma8(i32x8 a, i32x8 b, f32x16 c) { return __builtin_amdgcn_mfma_scale_f32_32x32x64_f8f6f4(a, b, c, 0, 0, 0, 0x7f7f7f7f, 0, 0x7f7f7f7f); }
#define A8CAT(v0, v1) __builtin_shufflevector(v0, v1, 0, 1, 2, 3, 4, 5, 6, 7)

__device__ __forceinline__ void partialSM(f32x16& p0, f32x16& p1, float& m_reg, float& mn, float& alpha) {
  constexpr float C = SCALE * 1.4426950408889634f;
  float pmax = p0[0];
#pragma unroll
  for (int r = 1; r < 16; ++r) pmax = fmaxf(pmax, p0[r]);
#pragma unroll
  for (int r = 0; r < 16; ++r) pmax = fmaxf(pmax, p1[r]);
  { auto rr = __builtin_amdgcn_permlane32_swap(__float_as_uint(pmax), __float_as_uint(pmax), false, false);
    pmax = fmaxf(__uint_as_float(rr[0]), __uint_as_float(rr[1])); }
  if (__builtin_expect(__all(pmax - m_reg <= THR / SCALE), 1)) { mn = m_reg; alpha = 1.f; }
  else { mn = fmaxf(m_reg, pmax); alpha = __builtin_amdgcn_exp2f((m_reg - mn) * C); m_reg = mn; }
  const float mnC = POFF - mn * C;
#pragma unroll
  for (int r = 0; r < 16; ++r) p0[r] = fmaf(p0[r], C, mnC);
#pragma unroll
  for (int r = 0; r < 16; ++r) p1[r] = fmaf(p1[r], C, mnC);
#pragma unroll
  for (int r = 0; r < 16; ++r) p0[r] = __builtin_amdgcn_exp2f(p0[r]);
}
__device__ __forceinline__ unsigned pk4(float a, float b, float c, float d) { int w = 0; w = __builtin_amdgcn_cvt_pk_fp8_f32(a, b, w, false); w = __builtin_amdgcn_cvt_pk_fp8_f32(c, d, w, true); return (unsigned)w; }
__device__ __forceinline__ void finishSM(f32x16& p0, f32x16& p1, float alpha, float& l_reg, i32x8& pa) {
#pragma unroll
  for (int r = 0; r < 16; ++r) p1[r] = __builtin_amdgcn_exp2f(p1[r]);
  float ps = 0;
#pragma unroll
  for (int r = 0; r < 16; ++r) ps += p0[r];
#pragma unroll
  for (int r = 0; r < 16; ++r) ps += p1[r];
  { auto rr = __builtin_amdgcn_permlane32_swap(__float_as_uint(ps), __float_as_uint(ps), false, false);
    ps = __uint_as_float(rr[0]) + __uint_as_float(rr[1]); }
  l_reg = l_reg * alpha + ps;
#pragma unroll
  for (int g = 0; g < 4; ++g) { pa[g] = (int)pk4(p0[4 * g], p0[4 * g + 1], p0[4 * g + 2], p0[4 * g + 3]); pa[4 + g] = (int)pk4(p1[4 * g], p1[4 * g + 1], p1[4 * g + 2], p1[4 * g + 3]); }
}
__device__ __forceinline__ void qkt(f32x16& p0, f32x16& p1, const char* Ks, const i32x8* qr, int r32, int hi) {
  p0 = f32x16{}; p1 = f32x16{};
#pragma unroll
  for (int c = 0; c < 3; ++c) {
    const i32x8 a0 = A8CAT(*(const i32x4*)(Ks + k_off(r32, 4 * c + 2 * hi)), *(const i32x4*)(Ks + k_off(r32, 4 * c + 2 * hi + 1)));
    const i32x8 a1 = A8CAT(*(const i32x4*)(Ks + k_off(32 + r32, 4 * c + 2 * hi)), *(const i32x4*)(Ks + k_off(32 + r32, 4 * c + 2 * hi + 1)));
    p0 = mfma8(a0, qr[c], p0); p1 = mfma8(a1, qr[c], p1); }
}
__device__ __forceinline__ void pv(f32x16* o, const char* Vs, i32x8 pa, int r32, int hi) {
#pragma unroll
  for (int d0 = 0; d0 < 4; ++d0) { const int c = 32 * d0 + r32;
    const i32x8 b = A8CAT(*(const i32x4*)(Vs + v_off(c, 2 * hi)), *(const i32x4*)(Vs + v_off(c, 2 * hi + 1)));
    o[d0] = mfma8(pa, b, o[d0]); }
}
constexpr int LDO = 6144;
constexpr int OT_OFF = 45056, OT_LD = 136;
__device__ __forceinline__ void attn_unit(const unsigned char* __restrict__ Qb, const unsigned char* __restrict__ Kh, const unsigned char* __restrict__ Vt, unsigned char* __restrict__ Ob, int seq, char* lds) {
  int tid_o = threadIdx.x; asm volatile("" : "+v"(tid_o));
  const int tid = tid_o, wid = tid >> 6, lane = tid & 63, r32 = lane & 31, hi = lane >> 5;
  char* V_lds = lds; char* K_lds = lds + 2 * SHM_V;
  float* ws = (float*)(lds + 2 * SHM_V + 2 * SHM_K) + wid * 64; float* li_l = ws; float* al_l = ws + 32;
  float m_reg = -1e30f, l_reg = 0; f32x16 o[4] = {}; i32x8 qr[3];
  { const unsigned char* Qw = Qb + (long)(wid * QBLK + r32) * DQ + hi * 32;
#pragma unroll
    for (int c = 0; c < 3; ++c) qr[c] = A8CAT(*(const i32x4*)(Qw + 64 * c), *(const i32x4*)(Qw + 64 * c + 16)); }
  i32x4 sv[2], sk0[2]; i32x2 sk1[2];
  const __amdgpu_buffer_rsrc_t rK = __builtin_amdgcn_make_buffer_rsrc((void*)Kh, 0, seq * DQ, 0x00020000), rV = __builtin_amdgcn_make_buffer_rsrc((void*)Vt, 0, seq * DVV, 0x00020000);
  const int lo16 = tid * 16, lo8 = 8192 + tid * 8;
  const int wv = v_off(tid >> 2, tid & 3), wk0 = k_off(tid / 12, tid % 12), wk1 = k_off((512 + (tid >> 1)) / 12, (512 + (tid >> 1)) % 12) + 8 * (tid & 1);
#define A8LOAD(i, k0) do { sv[i] = __builtin_amdgcn_raw_buffer_load_b128(rV, lo16, (k0) * DVV, 0); sk0[i] = __builtin_amdgcn_raw_buffer_load_b128(rK, lo16, (k0) * DQ, 0); sk1[i] = __builtin_amdgcn_raw_buffer_load_b64(rK, lo8, (k0) * DQ, 0); } while (0)
#define A8WRITE(b, i) do { *(i32x4*)(V_lds + (b) * SHM_V + wv) = sv[i]; *(i32x4*)(K_lds + (b) * SHM_K + wk0) = sk0[i]; *(i32x2*)(K_lds + (b) * SHM_K + wk1) = sk1[i]; } while (0)
#define A8WAIT() asm volatile("s_waitcnt vmcnt(3)" ::: "memory")
#define A8RESC(a) do { if (__any((a) < 1.f)) { if (hi == 0) al_l[r32] = (a); asm volatile("s_waitcnt lgkmcnt(0)" ::: "memory"); \
    _Pragma("unroll") for (int d = 0; d < 4; ++d) _Pragma("unroll") for (int r = 0; r < 16; ++r) o[d][r] *= al_l[crow(r, hi)]; } } while (0)
  f32x16 pA0, pA1, pB0, pB1; float mnA, mnB, alA, alB; i32x8 pa; const int NT = seq / KVBLK;
  A8LOAD(0, 0); asm volatile("s_waitcnt vmcnt(0)" ::: "memory"); A8WRITE(0, 0); __syncthreads();
  qkt(pA0, pA1, K_lds, qr, r32, hi); partialSM(pA0, pA1, m_reg, mnA, alA);
  A8LOAD(1, KVBLK); if (2 < NT) A8LOAD(0, 2 * KVBLK);
  A8WAIT(); A8WRITE(1, 1); __syncthreads();
  for (int j = 1; j + 1 < NT; j += 2) {
    A8BAR(); qkt(pB0, pB1, K_lds + SHM_K, qr, r32, hi);
    finishSM(pA0, pA1, alA, l_reg, pa); A8BAR();
    A8LOAD(1, (j + 2) * KVBLK); A8BAR();
    pv(o, V_lds, pa, r32, hi); partialSM(pB0, pB1, m_reg, mnB, alB);
    __syncthreads(); A8WAIT(); A8WRITE(0, 0);
    A8RESC(alB); __syncthreads();
    A8BAR(); qkt(pA0, pA1, K_lds, qr, r32, hi);
    finishSM(pB0, pB1, alB, l_reg, pa); A8BAR();
    if (j + 3 < NT) A8LOAD(0, (j + 3) * KVBLK); A8BAR();
    pv(o, V_lds + SHM_V, pa, r32, hi); partialSM(pA0, pA1, m_reg, mnA, alA);
    __syncthreads(); A8WAIT(); A8WRITE(1, 1);
    A8RESC(alA); __syncthreads();
  }
  A8BAR(); qkt(pB0, pB1, K_lds + SHM_K, qr, r32, hi);
  finishSM(pA0, pA1, alA, l_reg, pa); A8BAR();
  pv(o, V_lds, pa, r32, hi); partialSM(pB0, pB1, m_reg, mnB, alB);
  __syncthreads(); A8RESC(alB);
  finishSM(pB0, pB1, alB, l_reg, pa); A8BAR();
  pv(o, V_lds + SHM_V, pa, r32, hi);
  if (hi == 0) li_l[r32] = l_reg; asm volatile("s_waitcnt lgkmcnt(0)" ::: "memory");
  float rli[16];
#pragma unroll
  for (int r = 0; r < 16; ++r) rli[r] = __builtin_amdgcn_rcpf(li_l[crow(r, hi)]);
  LAS unsigned short* OT = (LAS unsigned short*)(lds + OT_OFF) + wid * (32 * OT_LD);
#pragma unroll
  for (int r = 0; r < 16; ++r) { const int orow = crow(r, hi);
#pragma unroll
    for (int d0 = 0; d0 < 4; ++d0) OT[orow * OT_LD + d0 * 32 + r32] = (unsigned short)f2bf(o[d0][r] * rli[r]); }
  asm volatile("s_waitcnt lgkmcnt(0)" ::: "memory");
  { const int row = lane >> 1, half = lane & 1; unsigned char* Ow = Ob + (long)(wid * QBLK + row) * LDO;
#pragma unroll
    for (int g2 = 0; g2 < 2; ++g2) { const int g = 2 * half + g2; f32x16v a, b; const LAS bf16x8* src = (const LAS bf16x8*)(OT + row * OT_LD + 32 * g);
#pragma unroll
      for (int q = 0; q < 2; ++q) { const bf16x8 va = src[q], vb = src[2 + q];
#pragma unroll
        for (int e = 0; e < 8; ++e) { a[8 * q + e] = __uint_as_float(((unsigned)(unsigned short)va[e]) << 16); b[8 * q + e] = __uint_as_float(((unsigned)(unsigned short)vb[e]) << 16); } }
      v4u lo, hi; mx6_pack(a, b, lo, hi);
      *(GAS v4u*)(Ow + 16 * g) = lo; *(GAS v4u*)(Ow + 64 + 16 * g) = hi; } }
  __syncthreads();
#undef A8LOAD
#undef A8WRITE
#undef A8WAIT
#undef A8RESC
}
}
namespace hy {
typedef float f2 __attribute__((ext_vector_type(2)));
typedef float f4 __attribute__((ext_vector_type(4)));
constexpr int NF = 16384, LH = 8192;
constexpr int FFT_LDS_F2 = 18944;
__device__ __forceinline__ int PH(int p) { return p + 2 * (p >> 4) + 16 * (p >> 9); }
__device__ constexpr float C32[16] = {1.0f, 0.98078528040323043f, 0.92387953251128674f, 0.83146961230254524f, 0.70710678118654752f, 0.55557023301960218f, 0.38268343236508978f, 0.19509032201612825f,
                                      0.0f, -0.19509032201612825f, -0.38268343236508978f, -0.55557023301960218f, -0.70710678118654752f, -0.83146961230254524f, -0.92387953251128674f, -0.98078528040323043f};
__device__ constexpr float S32[16] = {0.0f, 0.19509032201612825f, 0.38268343236508978f, 0.55557023301960218f, 0.70710678118654752f, 0.83146961230254524f, 0.92387953251128674f, 0.98078528040323043f,
                                      1.0f, 0.98078528040323043f, 0.92387953251128674f, 0.83146961230254524f, 0.70710678118654752f, 0.55557023301960218f, 0.38268343236508978f, 0.19509032201612825f};
__host__ __device__ constexpr int brev(int x, int bits) { int r = 0; for (int i = 0; i < bits; ++i) r |= ((x >> i) & 1) << (bits - 1 - i); return r; }
__device__ __forceinline__ f2 cmulf(f2 x, f2 w) { return x * (f2){w.x, w.x} + (f2){x.y, x.x} * (f2){-w.y, w.y}; }
__device__ __forceinline__ f2 cmulc(f2 x, f2 w) { return x * (f2){w.x, w.x} + (f2){x.y, x.x} * (f2){w.y, -w.y}; }
__device__ __forceinline__ f2 cmulf_rt(f2 x, f2 w) { f2 t, r;
    asm("v_pk_mul_f32 %0, %1, %2 op_sel:[0,1] op_sel_hi:[1,1] neg_hi:[0,1]" : "=v"(t) : "v"(x), "v"(w));
    asm("v_pk_fma_f32 %0, %1, %2, %3 op_sel:[0,0,1] op_sel_hi:[1,0,0]" : "=v"(r) : "v"(x), "v"(w), "v"(t)); return r; }
__device__ __forceinline__ f2 cmulc_rt(f2 x, f2 w) { f2 t, r;
    asm("v_pk_mul_f32 %0, %1, %2 op_sel:[0,1] op_sel_hi:[1,1] neg_hi:[0,1]" : "=v"(t) : "v"(x), "v"(w));
    asm("v_pk_fma_f32 %0, %1, %2, %3 op_sel:[0,0,1] op_sel_hi:[1,0,0] neg_lo:[0,0,1] neg_hi:[0,0,1]" : "=v"(r) : "v"(x), "v"(w), "v"(t)); return r; }
template <int R, bool INV, bool ZH = false> __device__ __forceinline__ void dft_r2(f2 (&x)[R]) {
    if (ZH) {
#pragma unroll
        for (int j = 0; j < R / 2; ++j) { const int ti = j * (32 / R); const f2 d = x[j];
            if (ti == 0) x[j + R / 2] = d;
            else if (ti == 8) x[j + R / 2] = INV ? (f2){-d.y, d.x} : (f2){d.y, -d.x};
            else { const f2 w = {C32[ti], S32[ti]}; x[j + R / 2] = INV ? cmulf(d, w) : cmulc(d, w); } }
    }
#pragma unroll
    for (int h = ZH ? R / 4 : R / 2; h >= 1; h >>= 1) {
#pragma unroll
        for (int s = 0; s < R; s += 2 * h) {
#pragma unroll
            for (int j = 0; j < h; ++j) {
                const int ti = j * (16 / h);
                const f2 a = x[s + j], b = x[s + j + h];
                x[s + j] = a + b;
                const f2 d = a - b;
                if (ti == 0) x[s + j + h] = d;
                else if (ti == 8) x[s + j + h] = INV ? (f2){-d.y, d.x} : (f2){d.y, -d.x};
                else { const f2 w = {C32[ti], S32[ti]}; x[s + j + h] = INV ? cmulf(d, w) : cmulc(d, w); }
            }
        }
    }
}
template <int STRIDE, bool INV, int NSTORE, bool ZH> __device__ __forceinline__ void pass32(LAS f2* X, int base, f2 w1) {
    f2 x[32];
#pragma unroll
    for (int a = 0; a < (ZH ? 16 : 32); ++a) x[a] = X[base + a * STRIDE];
    f2 pw = w1;
    if (!INV) {
        dft_r2<32, false, ZH>(x);
#pragma unroll
        for (int k = 1; k < 32; ++k) { const int i = brev(k, 5); x[i] = cmulc_rt(x[i], pw); if (k < 31) pw = cmulf_rt(pw, w1); }
#pragma unroll
        for (int k = 0; k < 32; ++k) X[base + k * STRIDE] = x[brev(k, 5)];
    } else {
#pragma unroll
        for (int k = 1; k < 32; ++k) { x[k] = cmulf_rt(x[k], pw); if (k < 31) pw = cmulf_rt(pw, w1); }
        dft_r2<32, true>(x);
#pragma unroll
        for (int k = 0; k < NSTORE; ++k) X[base + k * STRIDE] = x[brev(k, 5)];
    }
}
__device__ __forceinline__ int opaque(int v) { asm volatile("" : "+v"(v)); return v; }
struct Tw { f2 wa, wb; };
__device__ __forceinline__ Tw make_tw(int tid) { Tw t; float sn, cs; sincospif((float)tid * (2.0f / 16384.0f), &sn, &cs); t.wa = (f2){cs, sn}; sincospif((float)(tid & 15) * (2.0f / 512.0f), &sn, &cs); t.wb = (f2){cs, sn}; return t; }
template <bool ZH> __device__ __forceinline__ void fft_pass1(LAS f2* X, int tid, bool inv_, f2 wa) {
    tid = opaque(tid); asm volatile("" : "+v"(wa));
    const int base = tid + 2 * (tid >> 4);
    if (!inv_) pass32<592, false, 32, ZH>(X, base, wa); else pass32<592, true, 16, false>(X, base, wa);
}
__device__ __forceinline__ void fft_pass2(LAS f2* X, int tid, bool inv_, f2 wb) {
    tid = opaque(tid); asm volatile("" : "+v"(wb));
    const int r2 = tid & 15, blk = tid >> 4;
    const int base = blk * 592 + r2;
    if (!inv_) pass32<18, false, 32, false>(X, base, wb); else pass32<18, true, 32, false>(X, base, wb);
}
__device__ __forceinline__ void fft_pass3(LAS f2* X, int tid, const f2* __restrict__ KS) {
    tid = opaque(tid);
#pragma unroll 1
    for (int h = 0; h < 2; ++h) {
        const int q = tid + 512 * h, base = 18 * q + 16 * (q >> 5);
        f4 kv[8];
        if (KS) {
#pragma unroll
            for (int i = 0; i < 8; ++i) kv[i] = *(const f4*)(KS + q * 16 + 2 * i);
        }
        f2 x[16];
#pragma unroll
        for (int i = 0; i < 8; ++i) { const f4 v = *(const LAS f4*)(X + base + 2 * i); x[2 * i] = (f2){v.x, v.y}; x[2 * i + 1] = (f2){v.z, v.w}; }
        dft_r2<16, false>(x);
        if (!KS) {
#pragma unroll
            for (int i = 0; i < 8; ++i) { const f2 p = x[brev(2 * i, 4)], q2 = x[brev(2 * i + 1, 4)]; *(LAS f4*)(X + base + 2 * i) = (f4){p.x, p.y, q2.x, q2.y}; }
        } else {
            f2 y[16];
#pragma unroll
            for (int k = 0; k < 16; ++k) { const f2 kk = (k & 1) ? (f2){kv[k >> 1].z, kv[k >> 1].w} : (f2){kv[k >> 1].x, kv[k >> 1].y}; y[k] = cmulf_rt(x[brev(k, 4)], kk); }
            dft_r2<16, true>(y);
#pragma unroll
            for (int i = 0; i < 8; ++i) { const f2 p = y[brev(2 * i, 4)], q2 = y[brev(2 * i + 1, 4)]; *(LAS f4*)(X + base + 2 * i) = (f4){p.x, p.y, q2.x, q2.y}; }
        }
    }
}
#define HY_SYNC() __syncthreads()
__device__ __forceinline__ void fft_forward_plain(LAS f2* X, int tid, Tw tw) { fft_pass1<false>(X, tid, false, tw.wa); HY_SYNC(); fft_pass2(X, tid, false, tw.wb); HY_SYNC(); fft_pass3(X, tid, nullptr); HY_SYNC(); }
__device__ __forceinline__ void fft_conv(LAS f2* X, int tid, const f2* KS, Tw tw) {
    fft_pass1<true>(X, tid, false, tw.wa); HY_SYNC(); fft_pass2(X, tid, false, tw.wb); HY_SYNC(); fft_pass3(X, tid, KS); HY_SYNC(); fft_pass2(X, tid, true, tw.wb); HY_SYNC(); fft_pass1<false>(X, tid, true, tw.wa); HY_SYNC();
}
__device__ __forceinline__ float bf2f(unsigned short h) { return __uint_as_float(((unsigned)h) << 16); }
__device__ __forceinline__ void conv8(const unsigned short* __restrict__ p, int t0, float w0, float w1, float w2, float cb, float (&o)[8]) {
    const bf16x8 v = *(const bf16x8*)(p + t0);
    float x[10];
    x[0] = t0 > 0 ? bf2f(p[t0 - 1]) : 0.f; x[9] = (t0 + 8 < LH) ? bf2f(p[t0 + 8]) : 0.f;
#pragma unroll
    for (int i = 0; i < 8; ++i) x[i + 1] = bf2f((unsigned short)v[i]);
#pragma unroll
    for (int i = 0; i < 8; ++i) o[i] = w0 * x[i] + w1 * x[i + 1] + w2 * x[i + 2] + cb;
}
__device__ __forceinline__ void zero_upper(LAS f2* X, int tid) {
    LAS f4* z = (LAS f4*)(X + 9472);
    for (int i = tid; i < (FFT_LDS_F2 - 9472) / 2; i += 512) z[i] = (f4){0.f, 0.f, 0.f, 0.f};
}
__device__ __forceinline__ void hyena_channel(LAS f2* X, int tid, int c, const unsigned short* __restrict__ HyT, const unsigned short* __restrict__ FiltT, const float* __restrict__ convw, const float* __restrict__ convb,
                                              const float* __restrict__ hbias, f2* KSb, unsigned short* __restrict__ YT, Tw tw) {
    tid = opaque(tid);
    {
        const unsigned short* f00 = FiltT + (size_t)(0 * 4096 + 0 * 2048 + c) * LH; const unsigned short* f01 = FiltT + (size_t)(0 * 4096 + 1 * 2048 + c) * LH;
        const unsigned short* f10 = FiltT + (size_t)(1 * 4096 + 0 * 2048 + c) * LH; const unsigned short* f11 = FiltT + (size_t)(1 * 4096 + 1 * 2048 + c) * LH;
#pragma unroll 1
        for (int i = 0; i < 4; ++i) {
            const int t0 = 4 * (tid + 512 * i);
            typedef unsigned short u16x4 __attribute__((ext_vector_type(4)));
            const u16x4 ra = *(const u16x4*)(f00 + t0), rb = *(const u16x4*)(f01 + t0), rc = *(const u16x4*)(f10 + t0), rd = *(const u16x4*)(f11 + t0);
            const f4 a = {bf2f(ra.x), bf2f(ra.y), bf2f(ra.z), bf2f(ra.w)}, b = {bf2f(rb.x), bf2f(rb.y), bf2f(rb.z), bf2f(rb.w)}, cc = {bf2f(rc.x), bf2f(rc.y), bf2f(rc.z), bf2f(rc.w)}, d = {bf2f(rd.x), bf2f(rd.y), bf2f(rd.z), bf2f(rd.w)};
            const int e0 = PH(t0);
            *(LAS f4*)(X + e0) = (f4){a.x, b.x, a.y, b.y}; *(LAS f4*)(X + e0 + 2) = (f4){a.z, b.z, a.w, b.w};
            if (t0 == 0) X[PH(LH)] = (f2){0.f, 0.f}; else X[PH(NF - t0)] = (f2){cc.x, d.x};
            X[PH(NF - t0 - 1)] = (f2){cc.y, d.y}; X[PH(NF - t0 - 2)] = (f2){cc.z, d.z}; X[PH(NF - t0 - 3)] = (f2){cc.w, d.w};
        }
    }
    HY_SYNC();
    fft_forward_plain(X, tid, tw);
    tid = opaque(tid);
    {
        const float b1 = hbias[c], b2 = hbias[2048 + c]; const float sc = 1.0f / (float)NF;
#pragma unroll 4
        for (int i = 0; i < 32; ++i) {
            const int P = tid + 512 * i; const int k = (P >> 9) + 32 * ((P >> 4) & 31) + 1024 * (P & 15); const int kn = (NF - k) & (NF - 1);
            const int Pn = (kn & 31) * 512 + ((kn >> 5) & 31) * 16 + (kn >> 10);
            const f2 z = X[PH(P)], zn = X[PH(Pn)];
            KSb[P] = (f2){(0.5f * (z.x + zn.x) + b1) * sc, 0.5f * (z.y - zn.y) * sc};
            KSb[NF + P] = (f2){(0.5f * (z.y + zn.y) + b2) * sc, -0.5f * (z.x - zn.x) * sc};
        }
    }
    asm volatile("s_waitcnt vmcnt(0)" ::: "memory");
    HY_SYNC();
    tid = opaque(tid);
    const unsigned short* pv = HyT + (size_t)c * NF; const unsigned short* px1 = HyT + (size_t)(2048 + c) * NF; const unsigned short* px2 = HyT + (size_t)(4096 + c) * NF;
    {
        const float w0 = convw[c], w1 = convw[6144 + c], w2 = convw[2 * 6144 + c], cb = convb[c];
#pragma unroll 1
        for (int i = 0; i < 2; ++i) { const int t0 = 8 * (tid + 512 * i); float a[8], b[8]; conv8(pv, t0, w0, w1, w2, cb, a); conv8(pv + LH, t0, w0, w1, w2, cb, b);
            const int e0 = PH(t0);
#pragma unroll
            for (int j = 0; j < 4; ++j) *(LAS f4*)(X + e0 + 2 * j) = (f4){a[2 * j], b[2 * j], a[2 * j + 1], b[2 * j + 1]}; }
    }
    HY_SYNC();
    fft_conv(X, tid, KSb, tw);
    tid = opaque(tid);
    {
        const float w0 = convw[2048 + c], w1 = convw[6144 + 2048 + c], w2 = convw[2 * 6144 + 2048 + c], cb = convb[2048 + c];
#pragma unroll 1
        for (int i = 0; i < 2; ++i) { const int t0 = 8 * (tid + 512 * i); float a[8], b[8]; conv8(px1, t0, w0, w1, w2, cb, a); conv8(px1 + LH, t0, w0, w1, w2, cb, b);
            const int e0 = PH(t0);
#pragma unroll
            for (int j = 0; j < 4; ++j) { const f4 y = *(const LAS f4*)(X + e0 + 2 * j); *(LAS f4*)(X + e0 + 2 * j) = (f4){a[2 * j] * y.x, b[2 * j] * y.y, a[2 * j + 1] * y.z, b[2 * j + 1] * y.w}; } }
    }
    HY_SYNC();
    fft_conv(X, tid, KSb + NF, tw);
    tid = opaque(tid);
    {
        const float w0 = convw[4096 + c], w1 = convw[6144 + 4096 + c], w2 = convw[2 * 6144 + 4096 + c], cb = convb[4096 + c];
        unsigned short* yo = YT + (size_t)c * NF;
#pragma unroll 1
        for (int i = 0; i < 2; ++i) { const int t0 = 8 * (tid + 512 * i); float a[8], b[8]; conv8(px2, t0, w0, w1, w2, cb, a); conv8(px2 + LH, t0, w0, w1, w2, cb, b);
            const int e0 = PH(t0); float ya[8], yb[8];
#pragma unroll
            for (int j = 0; j < 4; ++j) { const f4 y = *(const LAS f4*)(X + e0 + 2 * j); ya[2 * j] = a[2 * j] * y.x; yb[2 * j] = b[2 * j] * y.y; ya[2 * j + 1] = a[2 * j + 1] * y.z; yb[2 * j + 1] = b[2 * j + 1] * y.w; }
            v4u wa, wb; wa.x = pg8::cvt_pk_bf16(ya[0], ya[1]); wa.y = pg8::cvt_pk_bf16(ya[2], ya[3]); wa.z = pg8::cvt_pk_bf16(ya[4], ya[5]); wa.w = pg8::cvt_pk_bf16(ya[6], ya[7]);
            wb.x = pg8::cvt_pk_bf16(yb[0], yb[1]); wb.y = pg8::cvt_pk_bf16(yb[2], yb[3]); wb.z = pg8::cvt_pk_bf16(yb[4], yb[5]); wb.w = pg8::cvt_pk_bf16(yb[6], yb[7]);
            *(v4u*)(yo + t0) = wa; *(v4u*)(yo + LH + t0) = wb; }
    }
    HY_SYNC();
}
}
constexpr int NWAVES = 8;
#ifndef MK_N_LAUNCHES
#define MK_N_LAUNCHES 1
#endif
constexpr int N_PHASES = 10;
#ifndef DUP_ID
#define DUP_ID -1
#endif
#define REP(id) _Pragma("unroll 1") for (int rep_ = 0; rep_ < ((DUP_ID == (id) || DUP_ID == 200 + (id)) ? 2 : 1); ++rep_) if ((rep_ == 1 && DUP_ID >= 200) ? (xcd_barrier(bar), true) : true)
constexpr int N_LAUNCHES = MK_N_LAUNCHES;
constexpr int DM = 4096, NB = 2, SEQ = 8192, MTOK = NB * SEQ, LCTX = 256, MCTX = NB * LCTX, MALL = MTOK + MCTX;
constexpr int HYW = 2048, HYC = 6144, QLORA = 1024, KVLORA = 512, INC = 7744, INP = 7936, NMODC = 24576;
constexpr int NHEAD = 16, DQK = 192, FF = 16384, SKEYS = LCTX + SEQ;
constexpr float EPS = 1e-6f;
constexpr int MIXLD = 3072;
constexpr float WQBSCALE = 32.f, WKVBSCALE = 16.f, W1SCALE = 64.f, W2SCALE = 128.f, WINSCALE = 64.f, WOSCALE = 64.f;
constexpr size_t MiB = 1u << 20;
constexpr size_t WS_CTL = 0, CTL_ZERO_BYTES = 1 * MiB;
constexpr size_t WS_MODP = 1 * MiB;
constexpr size_t WS_MODS = 3 * MiB;
constexpr size_t WS_TW1 = 4 * MiB, WS_TW2 = 5 * MiB;
constexpr size_t WS_WOUT = 8 * MiB, WS_W1 = 40 * MiB, WS_W2 = 168 * MiB, WS_WIN = 296 * MiB, WS_WQB = 358 * MiB, WS_WKVB = 364 * MiB, WS_HH = 368 * MiB;
constexpr size_t WS_FILT = 370 * MiB, WS_H = 626 * MiB, WS_HYT = 758 * MiB, WS_QA = 950 * MiB, WS_KVA = 982 * MiB, WS_KR = 999 * MiB, WS_QRAW = 1004 * MiB, WS_KVRAW = 1100 * MiB;
constexpr size_t WS_H8 = WS_QRAW, WS_WIN8 = WS_KVRAW;
constexpr size_t WS_YT = 1232 * MiB, WS_KS = 1296 * MiB, WS_END0 = 1360 * MiB;
constexpr size_t WS_QB = 370 * MiB, WS_KB = 466 * MiB, WS_VB = 565 * MiB, WS_MIX = 631 * MiB;
constexpr size_t WS_H2 = 760 * MiB;
constexpr size_t WS_HID = 900 * MiB, WS_END = 1412 * MiB;
static_assert(WS_MIX + (size_t)MTOK * DM * 2 <= WS_H2 && WS_H2 + (size_t)MTOK * DM * 2 <= WS_HID && WS_VB + (size_t)NB * NHEAD * SKEYS * 128 * 2 <= WS_MIX && WS_KB + (size_t)NB * NHEAD * SKEYS * 192 * 2 <= WS_VB, "d_ws map");
constexpr int CW_TMO = 0, CW_BAR = 4096;
constexpr int LDS_BYTES = 163840, MISC_OFF = 159744;

struct Args { const float* in[27]; float* out; unsigned char* ws; int ph_lo, ph_hi, li, pad; };
typedef const __attribute__((address_space(4))) Args CArgs;

__device__ __forceinline__ float wave_sum(float v) {
#define WS_SWZ(X) v += __int_as_float(__builtin_amdgcn_ds_swizzle(__float_as_int(v), ((X) << 10) | 0x1f))
    WS_SWZ(1); WS_SWZ(2); WS_SWZ(4); WS_SWZ(8); WS_SWZ(16);
#undef WS_SWZ
    { auto rr = __builtin_amdgcn_permlane32_swap(__float_as_uint(v), __float_as_uint(v), false, false); v = __uint_as_float(rr[0]) + __uint_as_float(rr[1]); }
    return v;
}
__device__ __forceinline__ float bf2f(unsigned short h) { return __uint_as_float(((unsigned)h) << 16); }
__device__ __forceinline__ void p0_transpose_item(const float* W, int K, int N, bf16* WT, int row_off, const float* kscale, LAS float* scr, int item, int lane, int ldw = 0, int kofs = 0) {
    const int nblk = N / 32, kb = item / nblk, nb = item % nblk, k0 = 64 * kb, n0 = 32 * nb;
#pragma unroll 8
    for (int i = 0; i < 32; ++i) { const int kk = 2 * i + (lane >> 5); float v = W[(size_t)(k0 + kk) * N + n0 + (lane & 31)]; if (kscale) v *= kscale[k0 + kk]; scr[kk * 33 + (lane & 31)] = v; }
    LDS_WAIT(); asm volatile("" ::: "memory");
    const int c = lane & 7;
#pragma unroll
    for (int j = 0; j < 4; ++j) { const int n = (lane >> 3) + 8 * j; const LAS float* s = scr + (8 * c) * 33 + n;
        v4u o; o.x = pk2(s[0 * 33], s[1 * 33]); o.y = pk2(s[2 * 33], s[3 * 33]); o.z = pk2(s[4 * 33], s[5 * 33]); o.w = pk2(s[6 * 33], s[7 * 33]);
        *(GAS v4u*)(WT + (size_t)(row_off + n0 + n) * (ldw ? ldw : K) + (k0 - kofs) + 8 * c) = o; }
    LDS_WAIT(); asm volatile("" ::: "memory");
}
__device__ __forceinline__ void p0_transpose_item_f8(const float* W, int K, int N, unsigned char* WT, float wscale, LAS float* scr, int item, int lane, int ldw = 0, int kofs = 0, const float* kscale = nullptr) {
    const int nblk = N / 32, kb = item / nblk, nb = item % nblk, k0 = 64 * kb, n0 = 32 * nb;
#pragma unroll 8
    for (int i = 0; i < 32; ++i) { const int kk = 2 * i + (lane >> 5); float v = W[(size_t)(k0 + kk) * N + n0 + (lane & 31)] * wscale; if (kscale) v *= kscale[k0 + kk]; scr[kk * 33 + (lane & 31)] = v; }
    LDS_WAIT(); asm volatile("" ::: "memory");
    const int c = lane & 3;
#pragma unroll
    for (int j = 0; j < 2; ++j) { const int n = (lane >> 2) + 16 * j; const LAS float* s = scr + (16 * c) * 33 + n;
        v4u o;
        o.x = pg8::pack4_fp8(fmaxf(s[0 * 33], -448.f), fmaxf(s[1 * 33], -448.f), fmaxf(s[2 * 33], -448.f), fmaxf(s[3 * 33], -448.f));
        o.y = pg8::pack4_fp8(fmaxf(s[4 * 33], -448.f), fmaxf(s[5 * 33], -448.f), fmaxf(s[6 * 33], -448.f), fmaxf(s[7 * 33], -448.f));
        o.z = pg8::pack4_fp8(fmaxf(s[8 * 33], -448.f), fmaxf(s[9 * 33], -448.f), fmaxf(s[10 * 33], -448.f), fmaxf(s[11 * 33], -448.f));
        o.w = pg8::pack4_fp8(fmaxf(s[12 * 33], -448.f), fmaxf(s[13 * 33], -448.f), fmaxf(s[14 * 33], -448.f), fmaxf(s[15 * 33], -448.f));
        *(GAS v4u*)(WT + (size_t)(n0 + n) * (ldw ? ldw : K) + (k0 - kofs) + 16 * c) = o; }
    LDS_WAIT(); asm volatile("" ::: "memory");
}
__device__ __forceinline__ unsigned f8pack(float a, float b, float c, float d) { return pg8::pack4_fp8(fmaxf(a, -448.f), fmaxf(b, -448.f), fmaxf(c, -448.f), fmaxf(d, -448.f)); }
__device__ __forceinline__ void p0_transpose_item_mx6(const float* W, int K, int N, unsigned char* WT, LAS float* scr, int item, int lane, int ldw = 0  , int kofs = 0) {
    const int nblk = N / 32, kb = item / nblk, nb = item % nblk, k0 = 64 * kb, n0 = 32 * nb;
#pragma unroll 8
    for (int i = 0; i < 32; ++i) { const int kk = 2 * i + (lane >> 5); scr[kk * 33 + (lane & 31)] = W[(size_t)(k0 + kk) * N + n0 + (lane & 31)]; }
    LDS_WAIT(); asm volatile("" ::: "memory");
    const int n = lane & 31, bl = lane >> 5; const LAS float* sp = scr + (32 * bl) * 33 + n;
    f32x16v a, b;
#pragma unroll
    for (int i = 0; i < 16; ++i) { a[i] = sp[i * 33]; b[i] = sp[(16 + i) * 33]; }
    v4u lo, hi; mx6_pack(a, b, lo, hi);
    unsigned char* d = WT + (size_t)(n0 + n) * (ldw ? ldw : K) + mx6_off(((k0 - kofs) >> 5) + bl);
    *(GAS v4u*)d = lo; *(GAS v4u*)(d + 64) = hi;
    LDS_WAIT(); asm volatile("" ::: "memory");
}
__device__ __forceinline__ void modulate_row_mx6(const float* xrow, unsigned char* orow, const LAS float* g, const LAS float* sh, const LAS float* sc, int lane) {
    asm volatile("" : "+v"(lane));
    f32x4 v[2][8]; float s = 0.f;
#pragma unroll
    for (int j = 0; j < 2; ++j)
#pragma unroll
        for (int q = 0; q < 8; ++q) { v[j][q] = *(const GAS f32x4*)(xrow + 32 * (lane + 64 * j) + 4 * q); s += (v[j][q].x * v[j][q].x + v[j][q].y * v[j][q].y) + (v[j][q].z * v[j][q].z + v[j][q].w * v[j][q].w); }
    const float rstd = 1.0f / sqrtf(wave_sum(s) * (1.f / DM) + EPS);
#pragma unroll
    for (int j = 0; j < 2; ++j) { const int blk = lane + 64 * j, c0 = 32 * blk; f32x16v a, b;
#pragma unroll
        for (int q = 0; q < 8; ++q) { const f32x4 gg = *(const LAS f32x4*)(g + c0 + 4 * q), hh = *(const LAS f32x4*)(sh + c0 + 4 * q), cc = *(const LAS f32x4*)(sc + c0 + 4 * q);
            const f32x4 y = (v[j][q] * rstd * gg) * (cc + 1.0f) + hh;
            if (q < 4) { a[4 * q] = y.x; a[4 * q + 1] = y.y; a[4 * q + 2] = y.z; a[4 * q + 3] = y.w; } else { b[4 * q - 16] = y.x; b[4 * q - 15] = y.y; b[4 * q - 14] = y.z; b[4 * q - 13] = y.w; } }
        v4u lo, hi; mx6_pack(a, b, lo, hi);
        unsigned char* d = orow + mx6_off(blk); *(GAS v4u*)d = lo; *(GAS v4u*)(d + 64) = hi;
        asm volatile("" ::: "memory"); }
}
template <int F8  > __device__ __forceinline__ void modulate_row(const float* xrow, void* orow, void* orow8, const LAS float* g, const LAS float* sh, const LAS float* sc, int lane) {
    asm volatile("" : "+v"(lane));
    const GAS f32x4* xr = (const GAS f32x4*)xrow + lane;
    f32x4 v[16]; float s = 0.f;
#pragma unroll
    for (int j = 0; j < 16; ++j) { v[j] = xr[64 * j]; s += (v[j].x * v[j].x + v[j].y * v[j].y) + (v[j].z * v[j].z + v[j].w * v[j].w); }
    const float rstd = 1.0f / sqrtf(wave_sum(s) * (1.f / DM) + EPS);
    GAS unsigned long long* o8 = (GAS unsigned long long*)orow + lane; GAS unsigned* o4 = (GAS unsigned*)(F8 == 2 ? orow8 : orow) + lane;
#pragma unroll
    for (int j = 0; j < 16; ++j) { const int c0 = 4 * (lane + 64 * j); const f32x4 gg = *(const LAS f32x4*)(g + c0), hh = *(const LAS f32x4*)(sh + c0), cc = *(const LAS f32x4*)(sc + c0);
        const f32x4 y = (v[j] * rstd * gg) * (cc + 1.0f) + hh;
        if (F8 != 0) o4[64 * j] = pg8::pack4_fp8(fmaxf(y.x, -448.f), fmaxf(y.y, -448.f), fmaxf(y.z, -448.f), fmaxf(y.w, -448.f));
        if (F8 != 1) o8[64 * j] = (unsigned long long)pk2(y.x, y.y) | ((unsigned long long)pk2(y.z, y.w) << 32);
        if (j & 1) asm volatile("" ::: "memory"); }
}

__global__ void __launch_bounds__(NWAVES * 64, 2) mega_fwd(Args args) {
    extern __shared__ __attribute__((aligned(16))) unsigned char lds_raw[];
    LAS unsigned char* lds = (LAS unsigned char*)lds_raw;
    volatile LAS unsigned* MISC = (volatile LAS unsigned*)(lds + MISC_OFF);
#define PHASE_IDS() const CArgs* ap = (const CArgs*)__builtin_amdgcn_kernarg_segment_ptr(); asm volatile("" : "+s"(ap)); unsigned char* ws = ap->ws; const int tid = hy::opaque((int)threadIdx.x), lane = tid & 63, wave = __builtin_amdgcn_readfirstlane(tid >> 6), gw = vcu * NWAVES + wave, NGW = G * NWAVES; (void)lane; (void)gw; (void)NGW
    const int G = gridDim.x; const int bx = blockIdx.x; const int vcu = (G % 8 == 0) ? (bx % 8) * (G / 8) + bx / 8 : bx;
    gu32* ctl = (gu32*)(args.ws + WS_CTL);
#define x_in ((const float*)ap->in[0])
#define cvec ((const float*)ap->in[1])
#define ctx ((const float*)ap->in[2])
#define c_ctx ((const float*)ap->in[3])
#define norm1_g ((const float*)ap->in[4])
#define norm2_g ((const float*)ap->in[5])
#define w_ada ((const float*)ap->in[6])
#define b_ada ((const float*)ap->in[7])
#define w_in ((const float*)ap->in[8])
#define hy_conv_w ((const float*)ap->in[9])
#define hy_conv_b ((const float*)ap->in[10])
#define hy_w1 ((const float*)ap->in[11])
#define hy_b1 ((const float*)ap->in[12])
#define hy_w2 ((const float*)ap->in[13])
#define hy_b2 ((const float*)ap->in[14])
#define hy_w3 ((const float*)ap->in[15])
#define hy_freq ((const float*)ap->in[16])
#define hy_bias ((const float*)ap->in[17])
#define g_qa ((const float*)ap->in[18])
#define w_qb ((const float*)ap->in[19])
#define g_kva ((const float*)ap->in[20])
#define w_kvb ((const float*)ap->in[21])
#define q_norm_g ((const float*)ap->in[22])
#define k_norm_g ((const float*)ap->in[23])
#define w_out ((const float*)ap->in[24])
#define w_mlp1 ((const float*)ap->in[25])
#define w_mlp2 ((const float*)ap->in[26])
#define out_p (ap->out)
#define MODP ((float*)(ws + WS_MODP))
#define MODS ((float*)(ws + WS_MODS))
#define TW1 ((hy::f2*)(ws + WS_TW1))
#define TW2 ((hy::f2*)(ws + WS_TW2))
#define W1T ((bf16*)(ws + WS_W1))
#define W2T ((bf16*)(ws + WS_W2))
#define WinT ((bf16*)(ws + WS_WIN))
#define WinT8 ((unsigned char*)(ws + WS_WIN8))
#define H8 ((unsigned char*)(ws + WS_H8))
#define WqbT ((bf16*)(ws + WS_WQB))
#define WkvbT ((bf16*)(ws + WS_WKVB))
#define Hh ((float*)(ws + WS_HH))
#define FiltT ((float*)(ws + WS_FILT))
#define Hb ((bf16*)(ws + WS_H))
#define HyT ((bf16*)(ws + WS_HYT))
#define QA ((bf16*)(ws + WS_QA))
#define KVA ((bf16*)(ws + WS_KVA))
#define KR ((float*)(ws + WS_KR))
#define Qraw ((bf16*)(ws + WS_QRAW))
#define KVraw ((bf16*)(ws + WS_KVRAW))
#define YT ((bf16*)(ws + WS_YT))
#define KSall ((hy::f2*)(ws + WS_KS))
#define Qb ((bf16*)(ws + WS_QB))
#define Kb ((bf16*)(ws + WS_KB))
#define Vb ((bf16*)(ws + WS_VB))
#define MIX ((bf16*)(ws + WS_MIX))
#define WoutT ((bf16*)(ws + WS_WOUT))
#define H2 ((bf16*)(ws + WS_H2))
#define HID ((bf16*)(ws + WS_HID))
    for (int u = hy::opaque((int)threadIdx.x); u < (LDS_BYTES - MISC_OFF) / 4; u += NWAVES * 64) ((LAS unsigned*)(lds + MISC_OFF))[u] = 0u;
    __syncthreads();
    XcdBarrier bar; bar.bar = (unsigned*)(ctl + CW_BAR); bar.x = 0; bar.st = nullptr;
    if (N_LAUNCHES == 1) bar = xcd_barrier_post((unsigned*)(ctl + CW_BAR), MISC + 8);
#define GRID_BAR() do { if (N_LAUNCHES == 1) xcd_barrier(bar); } while (0)
    const int lo = args.ph_lo, hi = args.ph_hi;
#ifndef PH_MASK
#define PH_MASK 0x3ff
#endif
#define IN(k) (((PH_MASK >> (k)) & 1) && lo <= (k) && (k) < hi)
#define BOTH(k) (IN(k) && IN((k) + 1))

    if (IN(0)) {
        PHASE_IDS();
        REP(0) {
            LAS float* scr = (LAS float*)(lds + wave * 16384);
            constexpr int I_IN = (DM / 64) * (INC / 32), I_QB = (QLORA / 64) * (3072 / 32), I_KVB = (KVLORA / 64) * (4096 / 32), I_O = (DM / 64) * (DM / 32), I_1 = (DM / 64) * (FF / 32), I_2 = (FF / 64) * (DM / 32);
            constexpr int NITEMS = I_IN + I_QB + I_KVB + I_O + I_1 + I_2;
            for (int it = gw; it < NITEMS; it += NGW) {
                int r = it;
                if (r < I_IN) { const int n0 = 32 * (r % (INC / 32));
                    if (n0 < HYC) p0_transpose_item(w_in, DM, INC, WinT, 0, nullptr, scr, r, lane); else p0_transpose_item_f8(w_in, DM, INC, WinT8, WINSCALE, scr, r, lane); continue; } r -= I_IN;
                if (r < I_QB) { p0_transpose_item_f8(w_qb, QLORA, 3072, (unsigned char*)WqbT, WQBSCALE, scr, r, lane, 0, 0, g_qa); continue; } r -= I_QB;
                if (r < I_KVB) { p0_transpose_item_f8(w_kvb, KVLORA, 4096, (unsigned char*)WkvbT, WKVBSCALE, scr, r, lane, 0, 0, g_kva); continue; } r -= I_KVB;
                if (r < I_O) { if (64 * (r / (DM / 32)) < HYW) p0_transpose_item(w_out, DM, DM, WoutT, 0, nullptr, scr, r, lane, MIXLD, 0);
                                else p0_transpose_item_mx6(w_out, DM, DM, (unsigned char*)WoutT + 2 * HYW, scr, r, lane, 2 * MIXLD, HYW); continue; } r -= I_O;
                if (r < I_1) { p0_transpose_item_mx6(w_mlp1, DM, FF, (unsigned char*)W1T, scr, r, lane); continue; } r -= I_1;
                p0_transpose_item_f8(w_mlp2, FF, DM, (unsigned char*)W2T, W2SCALE, scr, r, lane);
            }
            { GAS v4u* z = (GAS v4u*)(WinT8 + (size_t)INC * DM); const size_t n16 = (size_t)(INP - INC) * DM / 16;
              for (size_t i = (size_t)vcu * 512 + tid; i < n16; i += (size_t)G * 512) z[i] = (v4u){0u, 0u, 0u, 0u}; }
        }
        __syncthreads();
        REP(1) {
            LAS float* S = (LAS float*)lds;
            LAS float* RED = (LAS float*)(lds + 49152);
            for (int i = tid; i < 3 * DM; i += 512) { const float v = i < 2 * DM ? cvec[i] : c_ctx[i - 2 * DM]; S[i] = v / (1.0f + __expf(-v)); }
            __syncthreads();
            for (int it = vcu; it < 192 * 4; it += G) {
                const int cb = it % 192, ks = it / 192, col = cb * 128 + 2 * lane, kbeg = ks * 1024;
                float a0 = 0, a1 = 0, b0 = 0, b1 = 0, c0 = 0, c1 = 0;
#pragma unroll 8
                for (int i = 0; i < 128; ++i) { const int k = kbeg + wave + 8 * i; const float2 w = *(const float2*)(w_ada + (size_t)k * NMODC + col);
                    const float s0 = S[k], s1 = S[DM + k], s2 = S[2 * DM + k];
                    a0 += s0 * w.x; a1 += s0 * w.y; b0 += s1 * w.x; b1 += s1 * w.y; c0 += s2 * w.x; c1 += s2 * w.y; }
                LAS float* rw = RED + wave * 384;
                rw[2 * lane] = a0; rw[2 * lane + 1] = a1; rw[128 + 2 * lane] = b0; rw[128 + 2 * lane + 1] = b1; rw[256 + 2 * lane] = c0; rw[256 + 2 * lane + 1] = c1;
                __syncthreads();
                if (tid < 384) { float s = 0.f;
#pragma unroll
                    for (int w = 0; w < 8; ++w) s += RED[w * 384 + tid];
                    const int r = tid >> 7, cc = tid & 127; MODP[(size_t)(ks * 3 + r) * NMODC + cb * 128 + cc] = s; }
                __syncthreads();
            }
        }
        REP(2) {
            LAS float* FE = (LAS float*)lds;
            LAS float* H1 = (LAS float*)(lds + 2048);
            const int tl = tid >> 6, j = tid & 63;
            for (int it = vcu; it < SEQ / 8; it += G) {
                const int t = it * 8 + tl;
                if (j < 33) { float f;
                    if (j == 0) f = (float)t / (float)(SEQ - 1);
                    else { const int bi = (j - 1) & 15; const float band = 1e-4f + (float)bi * ((15.0f - 1e-4f) / 15.0f); const float ang = ((float)(2.0 * 3.14159265358979323846 / SEQ) * (float)t) * band; f = (j <= 16) ? cosf(ang) : -sinf(ang); }
                    FE[tl * 33 + j] = f; }
                __syncthreads();
                { float a = hy_b1[j];
#pragma unroll 11
                  for (int i = 0; i < 33; ++i) a += FE[tl * 33 + i] * hy_w1[i * 64 + j];
                  H1[tl * 64 + j] = sinf(hy_freq[j] * a); }
                __syncthreads();
                { float a = hy_b2[j];
#pragma unroll 8
                  for (int i = 0; i < 64; ++i) a += H1[tl * 64 + i] * hy_w2[i * 64 + j];
                  ((unsigned short*)Hh)[(size_t)t * 64 + j] = (unsigned short)f2bf(sinf(hy_freq[j] * a)); }
                __syncthreads();
            }
        }
        if (BOTH(0)) GRID_BAR();
    }

    if (IN(1)) {
        PHASE_IDS();
        REP(10) {
            LAS float* SH = (LAS float*)lds;
            LAS float* SC = (LAS float*)(lds + 49152);
            LAS float* GN = (LAS float*)(lds + 98304);
            for (int i = tid; i < 3 * 2 * DM; i += 512) { const int r = i / (2 * DM), col = i % (2 * DM);
                float s = b_ada[col];
#pragma unroll
                for (int ks = 0; ks < 4; ++ks) s += MODP[(size_t)(ks * 3 + r) * NMODC + col];
                if (col < DM) SH[r * DM + col] = s; else SC[r * DM + col - DM] = s; }
            for (int i = tid; i < DM; i += 512) GN[i] = norm1_g[i];
            for (int i = vcu * 512 + tid; i < 3 * NMODC; i += G * 512) { const int r = i / NMODC, col = i % NMODC;
                float s = b_ada[col];
#pragma unroll
                for (int ks = 0; ks < 4; ++ks) s += MODP[(size_t)(ks * 3 + r) * NMODC + col];
                MODS[i] = s; }
            __syncthreads();
            for (int m = gw; m < MALL; m += NGW) {
                const int r = m < MTOK ? m / SEQ : 2;
                const float* src = m < MTOK ? x_in + (size_t)m * DM : ctx + (size_t)(m - MTOK) * DM;
                modulate_row<2>(src, Hb + (size_t)m * DM, H8 + (size_t)m * DM, GN, SH + r * DM, SC + r * DM, lane);
            }
            __syncthreads();
        }
        REP(11) {
            typedef float f32x16 __attribute__((ext_vector_type(16)));
            typedef short s16x8 __attribute__((ext_vector_type(8)));
            const int cb = vcu & 127, col0 = cb * 64, l31 = lane & 31, kh = lane >> 5;
            s16x8 af[2][4];
#pragma unroll
            for (int tl = 0; tl < 2; ++tl)
#pragma unroll
                for (int kk = 0; kk < 4; ++kk)
#pragma unroll
                    for (int e = 0; e < 8; ++e) af[tl][kk][e] = (short)f2bf(hy_w3[(size_t)(16 * kk + 8 * kh + e) * 8192 + col0 + 32 * tl + l31]);
            const unsigned short* HhB = (const unsigned short*)Hh;
            for (int tb = vcu >> 7; tb < 8; tb += (G >> 7)) {
                const int t0w = tb * 1024 + wave * 128 + 4 * l31;
                s16x8 bfr[4][4];
#pragma unroll
                for (int i = 0; i < 4; ++i)
#pragma unroll
                    for (int kk = 0; kk < 4; ++kk) bfr[i][kk] = *(const s16x8*)(HhB + (size_t)(t0w + i) * 64 + 16 * kk + 8 * kh);
#pragma unroll
                for (int tl = 0; tl < 2; ++tl) {
                    f32x16 acc[4];
#pragma unroll
                    for (int i = 0; i < 4; ++i) { acc[i] = (f32x16){};
#pragma unroll
                        for (int kk = 0; kk < 4; ++kk) acc[i] = __builtin_amdgcn_mfma_f32_32x32x16_bf16(af[tl][kk], bfr[i][kk], acc[i], 0, 0, 0); }
#pragma unroll
                    for (int r = 0; r < 16; ++r) { const int col = hy::opaque(col0 + 32 * tl + 4 * kh) + (r & 3) + 8 * (r >> 2), c = col & 2047;
                        const float a0 = -3.0701134573253944f, a1 = -15.350567286626972f; const float delta = fabsf(a0 + (float)c * ((a1 - a0) / 2047.0f));
                        const float dl = delta * (1.4426950408889634f / (float)(SEQ - 1));
                        const float e1 = __builtin_amdgcn_exp2f(-dl), E0 = __builtin_amdgcn_exp2f(-(float)t0w * dl), E1 = E0 * e1, E2 = E1 * e1, E3 = E2 * e1;
                        uint2 w; w.x = pg8::cvt_pk_bf16(acc[0][r] * E0, acc[1][r] * E1); w.y = pg8::cvt_pk_bf16(acc[2][r] * E2, acc[3][r] * E3);
                        *(uint2*)((bf16*)FiltT + (size_t)col * SEQ + t0w) = w; if ((r & 3) == 3) __builtin_amdgcn_sched_barrier(0); }
                    __builtin_amdgcn_sched_barrier(0);
                }
            }
        }
        if (BOTH(1)) GRID_BAR();
        if (DUP_ID == 103) { for (int i = 0; i < 20; ++i) GRID_BAR(); }
    }

    if (IN(2)) {
        PHASE_IDS();
        REP(20) { pg8::Gemm g{WinT, Hb, HYC, MTOK, DM}; pg8::StaticOrder S; S.init(HYC, MTOK, G, bx); pg8::EpiBf16A<0> E{HyT, MTOK, 1.0f};
          pg8::gemm_phase<pg8::EpiBf16A<0>, pg8::StaticOrder, PG8_ALIGN, PG8_SP2>(lds, g, S, E); }
        REP(21) { pg8::Gemm g{(const bf16*)H8, (const bf16*)(WinT8 + (size_t)HYC * DM), MALL, INP - HYC, DM / 2}; pg8::AttProjOrder S{G, bx}; pg8::EpiAttProj E{(unsigned char*)QA, (unsigned char*)KVA, KR, 1.0f / WINSCALE};
          pg8::gemm_phase<pg8::EpiAttProj, pg8::AttProjOrder, PG8_ALIGN, PG8_SP2F8, 1>(lds, g, S, E); }
        if (BOTH(2)) GRID_BAR();
    }

    if (IN(3)) {
        PHASE_IDS();
        REP(30) { pg8::Gemm g{QA, WqbT, MTOK, 3072, QLORA / 2}; pg8::StaticOrder S; S.init(MTOK, 3072, G, bx); pg8::EpiF8A E{(unsigned char*)Qraw, 3072, 1.0f / WQBSCALE};
          pg8::gemm_phase<pg8::EpiF8A, pg8::StaticOrder, PG8_ALIGN, PG8_SP2F8, 1>(lds, g, S, E); }
        REP(31) { pg8::Gemm g{KVA, WkvbT, MALL, 4096, KVLORA / 2}; pg8::StaticOrder S; S.init(MALL, 4096, G, bx); pg8::EpiF8A E{(unsigned char*)KVraw, 4096, 1.0f / WKVBSCALE};
          pg8::gemm_phase<pg8::EpiF8A, pg8::StaticOrder, PG8_ALIGN, PG8_SP2F8, 1>(lds, g, S, E); }
        __syncthreads();
        REP(32) { hy::f2* KSb = KSall + (size_t)bx * 2 * hy::NF; const hy::Tw tw = hy::make_tw(tid);
          for (int c = vcu; c < HYW; c += G) hy::hyena_channel((LAS hy::f2*)lds, tid, c, HyT, (const bf16*)FiltT, hy_conv_w, hy_conv_b, hy_bias, KSb, YT, tw); }
        if (BOTH(3)) GRID_BAR();
    }

    if (IN(4)) {
        PHASE_IDS();
        REP(40) {
            LAS float* GQ = (LAS float*)lds; LAS float* GK = GQ + 192;
            LAS hy::f2* ROPE = (LAS hy::f2*)(lds + 2048);
            LAS unsigned char* VT = lds + 20480;
            for (int i = tid; i < 192; i += 512) { GQ[i] = q_norm_g[i]; GK[i] = k_norm_g[i]; }
            for (int i = tid; i < 2048; i += 512) { const float ang = (float)(i >> 4) * powf(10000.0f, -(float)(i & 15) / 16.0f); ROPE[i] = (hy::f2){cosf(ang), sinf(ang)}; }
            __syncthreads();
#define SUM16(v) do { v += __int_as_float(__builtin_amdgcn_update_dpp(0, __float_as_int(v), 0xB1, 0xf, 0xf, true)); v += __int_as_float(__builtin_amdgcn_update_dpp(0, __float_as_int(v), 0x4E, 0xf, 0xf, true)); \
                      v += __int_as_float(__builtin_amdgcn_update_dpp(0, __float_as_int(v), 0x124, 0xf, 0xf, true)); v += __int_as_float(__builtin_amdgcn_update_dpp(0, __float_as_int(v), 0x128, 0xf, 0xf, true)); } while (0)
            const int hl = lane >> 4, sub = lane & 15;
            float gk8[8], gk4[4], gq8[8], gq4[4];
#pragma unroll
            for (int i = 0; i < 8; ++i) { gk8[i] = GK[8 * sub + i]; gq8[i] = GQ[8 * sub + i]; }
#pragma unroll
            for (int j = 0; j < 4; ++j) { gk4[j] = GK[128 + 4 * sub + j]; gq4[j] = GQ[128 + 4 * sub + j]; }
            LAS float* STAT = (LAS float*)(lds + 57344) + wave * 16;
            int stat_tile = -1;
            for (int it = (vcu * 33) >> 3; it < ((vcu + 1) * 33) >> 3; ++it) {
                const int hq = it & 3, tile = it >> 2, b = tile / 132, kt = tile % 132, h = hq * 4 + hl;
                const bool lat = kt >= 4;
                if (tile != stat_tile) { stat_tile = tile;
#pragma unroll 1
                    for (int e = 0; e < 8; ++e) {
                        const int key = kt * 64 + wave * 8 + e, t = key - LCTX; const int m = lat ? b * SEQ + t : MTOK + b * LCTX + key;
                        float rs_kv, rs_q = 0.f;
                        { typedef unsigned u32x2 __attribute__((ext_vector_type(2))); typedef float f32x2 __attribute__((ext_vector_type(2)));
                          const u32x2 v = *(const u32x2*)((const unsigned char*)KVA + (size_t)m * KVLORA + lane * 8); float s = 0.f;
#pragma unroll
                          for (int i = 0; i < 2; ++i) { const f32x2 a = __builtin_amdgcn_cvt_pk_f32_fp8((int)v[i], false), c = __builtin_amdgcn_cvt_pk_f32_fp8((int)v[i], true); s += (a.x * a.x + a.y * a.y) + (c.x * c.x + c.y * c.y); }
                          rs_kv = 1.0f / sqrtf(wave_sum(s) * (1.f / KVLORA) + EPS);
                          if (lat) { const v4u q = *(const v4u*)((const unsigned char*)QA + (size_t)m * QLORA + lane * 16); float s2 = 0.f;
#pragma unroll
                            for (int i = 0; i < 4; ++i) { const f32x2 a = __builtin_amdgcn_cvt_pk_f32_fp8((int)q[i], false), c = __builtin_amdgcn_cvt_pk_f32_fp8((int)q[i], true); s2 += (a.x * a.x + a.y * a.y) + (c.x * c.x + c.y * c.y); }
                            rs_q = 1.0f / sqrtf(wave_sum(s2) * (1.f / QLORA) + EPS); } }
                        if (lane == 0) { STAT[2 * e] = rs_kv; STAT[2 * e + 1] = rs_q; }
                    }
                    LDS_WAIT(); asm volatile("" ::: "memory");
                }
#pragma unroll 2
                for (int e = 0; e < 8; ++e) {
                    const int ki = wave * 8 + e, key = kt * 64 + ki, t = key - LCTX;
                    const int m = lat ? b * SEQ + t : MTOK + b * LCTX + key;
                    const float rs_kv = STAT[2 * e], rs_q = STAT[2 * e + 1];
                    float cs[4], sn[4];
#pragma unroll
                    for (int j = 0; j < 4; ++j) { cs[j] = 1.f; sn[j] = 0.f; }
                    if (lat) { const int pos = (sub >> 3) ? (t & 63) : (t >> 6);
#pragma unroll
                        for (int j = 0; j < 4; ++j) { const hy::f2 r = ROPE[pos * 16 + 4 * (sub & 3) + j]; cs[j] = r.x; sn[j] = (sub & 4) ? r.y : -r.y; } }
                    const f32x4 kr = *(const f32x4*)(KR + (size_t)m * 64 + 4 * sub);
                    float ss_r = (kr.x * kr.x + kr.y * kr.y) + (kr.z * kr.z + kr.w * kr.w); SUM16(ss_r);
                    typedef unsigned u32x2 __attribute__((ext_vector_type(2))); typedef float f32x2 __attribute__((ext_vector_type(2)));
                    const unsigned char* kvr = (const unsigned char*)KVraw + (size_t)m * 4096 + h * 256 + 8 * sub;
                    const u32x2 kn8 = *(const u32x2*)kvr, v8 = *(const u32x2*)(kvr + 128);
                    float kn[8], vv[8], ssk = 0.f;
#pragma unroll
                    for (int i = 0; i < 2; ++i) { const f32x2 a = __builtin_amdgcn_cvt_pk_f32_fp8((int)kn8[i], false), c = __builtin_amdgcn_cvt_pk_f32_fp8((int)kn8[i], true), d = __builtin_amdgcn_cvt_pk_f32_fp8((int)v8[i], false), f = __builtin_amdgcn_cvt_pk_f32_fp8((int)v8[i], true);
                        kn[4 * i] = a.x; kn[4 * i + 1] = a.y; kn[4 * i + 2] = c.x; kn[4 * i + 3] = c.y; vv[4 * i] = d.x; vv[4 * i + 1] = d.y; vv[4 * i + 2] = f.x; vv[4 * i + 3] = f.y; }
#pragma unroll
                    for (int i = 0; i < 8; ++i) { kn[i] *= rs_kv; vv[i] *= rs_kv; ssk += kn[i] * kn[i]; }
                    SUM16(ssk);
                    const float rk = 1.0f / sqrtf((ssk + ss_r) * (1.f / 192.f) + EPS);
                    float kx[4] = {kr.x, kr.y, kr.z, kr.w};
#pragma unroll
                    for (int j = 0; j < 4; ++j) { kx[j] = kx[j] * rk * gk4[j]; const float px = __int_as_float(__builtin_amdgcn_ds_swizzle(__float_as_int(kx[j]), (4 << 10) | 0x1f)); kx[j] = kx[j] * cs[j] + px * sn[j]; }
#pragma unroll
                    for (int i = 0; i < 8; ++i) kn[i] = kn[i] * rk * gk8[i];
                    unsigned char* kd = (unsigned char*)Kb + ((size_t)(b * NHEAD + h) * SKEYS + key) * 192;
                    { typedef unsigned u32x2 __attribute__((ext_vector_type(2))); u32x2 w; w.x = f8pack(kn[0], kn[1], kn[2], kn[3]); w.y = f8pack(kn[4], kn[5], kn[6], kn[7]);
                      *(u32x2*)(kd + 8 * sub) = w; *(unsigned*)(kd + 128 + 4 * sub) = f8pack(kx[0], kx[1], kx[2], kx[3]); }
                    { const int k5 = ki & 31, slot = 32 * ((k5 >> 2) & 1) + 16 * (ki >> 5) + (k5 & 3) + 4 * (k5 >> 3);
                      const unsigned w0 = f8pack(vv[0], vv[1], vv[2], vv[3]), w1 = f8pack(vv[4], vv[5], vv[6], vv[7]);
                      LAS unsigned char* vd = VT + hl * 8704 + sub * 68 + slot;
#pragma unroll
                      for (int i = 0; i < 4; ++i) { vd[i * 1088] = (unsigned char)(w0 >> (8 * i)); vd[(4 + i) * 1088] = (unsigned char)(w1 >> (8 * i)); } }
                    if (lat) {
                        const unsigned char* qrp = (const unsigned char*)Qraw + (size_t)m * 3072 + h * 192;
                        const u32x2 q8 = *(const u32x2*)(qrp + 8 * sub); const unsigned q4 = *(const unsigned*)(qrp + 128 + 4 * sub);
                        float qn[8], qx[4], ssq = 0.f;
#pragma unroll
                        for (int i = 0; i < 2; ++i) { const f32x2 a = __builtin_amdgcn_cvt_pk_f32_fp8((int)q8[i], false), c = __builtin_amdgcn_cvt_pk_f32_fp8((int)q8[i], true); qn[4 * i] = a.x; qn[4 * i + 1] = a.y; qn[4 * i + 2] = c.x; qn[4 * i + 3] = c.y; }
                        { const f32x2 a = __builtin_amdgcn_cvt_pk_f32_fp8((int)q4, false), c = __builtin_amdgcn_cvt_pk_f32_fp8((int)q4, true); qx[0] = a.x; qx[1] = a.y; qx[2] = c.x; qx[3] = c.y; }
#pragma unroll
                        for (int i = 0; i < 8; ++i) { qn[i] *= rs_q; ssq += qn[i] * qn[i]; }
#pragma unroll
                        for (int j = 0; j < 4; ++j) { qx[j] *= rs_q; ssq += qx[j] * qx[j]; }
                        SUM16(ssq);
                        const float rq = 1.0f / sqrtf(ssq * (1.f / 192.f) + EPS);
#pragma unroll
                        for (int j = 0; j < 4; ++j) { qx[j] = qx[j] * rq * gq4[j]; const float px = __int_as_float(__builtin_amdgcn_ds_swizzle(__float_as_int(qx[j]), (4 << 10) | 0x1f)); qx[j] = qx[j] * cs[j] + px * sn[j]; }
#pragma unroll
                        for (int i = 0; i < 8; ++i) qn[i] = qn[i] * rq * gq8[i];
                        unsigned char* qd = (unsigned char*)Qb + ((size_t)(b * NHEAD + h) * SEQ + t) * 192;
                        typedef unsigned u32x2 __attribute__((ext_vector_type(2))); u32x2 w; w.x = f8pack(qn[0], qn[1], qn[2], qn[3]); w.y = f8pack(qn[4], qn[5], qn[6], qn[7]);
                        *(u32x2*)(qd + 8 * sub) = w; *(unsigned*)(qd + 128 + 4 * sub) = f8pack(qx[0], qx[1], qx[2], qx[3]);
                    }
                }
                __syncthreads();
#pragma unroll
                for (int j = 0; j < 4; ++j) { const int id = tid + 512 * j, hh = id >> 9, within = id & 511;
                    const int col = within >> 2; const LAS unsigned* src = (const LAS unsigned*)(VT + hh * 8704 + ((col & 7) * 16 + (col >> 3)) * 68 + (within & 3) * 16);
                    *(v4u*)((unsigned char*)Vb + ((size_t)((b * NHEAD + hq * 4 + hh) * 132 + kt)) * 8192 + within * 16) = (v4u){src[0], src[1], src[2], src[3]}; }
                __syncthreads();
            }
#undef SUM16
        }
        REP(41) {
            LAS unsigned short* T = (LAS unsigned short*)(lds + 4096 + wave * 8704);
            for (int it = gw; it < 32 * 256; it += NGW) {
                const int c0 = (it & 31) * 64, tk0 = (it >> 5) * 64;
#pragma unroll 8
                for (int i = 0; i < 64; ++i) T[i * 66 + lane] = YT[(size_t)(c0 + i) * MTOK + tk0 + lane];
                LDS_WAIT(); asm volatile("" ::: "memory");
#pragma unroll 8
                for (int j = 0; j < 64; ++j) MIX[(size_t)(tk0 + j) * MIXLD + c0 + lane] = T[lane * 66 + j];
                LDS_WAIT(); asm volatile("" ::: "memory");
            }
        }
        if (BOTH(4)) GRID_BAR();
    }

    if (IN(5)) {
        PHASE_IDS();
        REP(5) for (int u = vcu; u < NB * NHEAD * (SEQ / 256); u += G) {
            const int bh = u >> 5, qb = u & 31, b = bh >> 4, h = bh & 15;
            att8::attn_unit((const unsigned char*)Qb + ((size_t)bh * SEQ + qb * 256) * 192, (const unsigned char*)Kb + (size_t)bh * SKEYS * 192, (const unsigned char*)Vb + (size_t)bh * SKEYS * 128,
                            (unsigned char*)MIX + ((size_t)b * SEQ + qb * 256) * (2 * MIXLD) + 2 * HYW + h * 128, SKEYS, (char*)lds_raw);
        }
        if (BOTH(5)) GRID_BAR();
    }

    if (IN(6)) {
        PHASE_IDS();
        REP(6) { pg8::Gemm g{MIX, WoutT, MTOK, DM, MIXLD, HYW / 64}; pg8::StaticOrder S; S.init(MTOK, DM, G, bx); pg8::EpiResGate E{x_in, out_p, MODS + 2 * DM, DM, 1.0f};
        pg8::gemm_phase<pg8::EpiResGate, pg8::StaticOrder, PG8_ALIGN, PG8_SP2F8, 3>(lds, g, S, E); }
        if (BOTH(6)) GRID_BAR();
    }

    if (IN(7) && DUP_ID != 100) {
        PHASE_IDS();
        REP(7) {
        LAS float* SH = (LAS float*)lds; LAS float* SC = (LAS float*)(lds + 32768); LAS float* GN = (LAS float*)(lds + 65536);
        for (int i = tid; i < 2 * DM; i += 512) { const int r = i / DM, col = i % DM; SH[i] = MODS[(size_t)r * NMODC + 3 * DM + col]; SC[i] = MODS[(size_t)r * NMODC + 4 * DM + col]; }
        for (int i = tid; i < DM; i += 512) GN[i] = norm2_g[i];
        __syncthreads();
        for (int m = gw; m < MTOK; m += NGW) { const int r = m / SEQ; modulate_row_mx6(out_p + (size_t)m * DM, (unsigned char*)H2 + (size_t)m * DM, GN, SH + r * DM, SC + r * DM, lane); }
        __syncthreads();
        }
        if (BOTH(7)) GRID_BAR();
    }

    if (IN(8) && DUP_ID != 100) {
        PHASE_IDS();
        REP(8) { pg8::Gemm g{H2, W1T, MTOK, FF, DM / 2}; pg8::StaticOrder S; S.init(MTOK, FF, G, bx); pg8::EpiF8Relu2 E{(unsigned char*)HID, FF, 1.0f};
        if (DUP_ID == 8 && GEXP != 0 && rep_ == 0) pg8::gemm_phase<pg8::EpiF8Relu2, pg8::StaticOrder, PG8_ALIGN, PG8_SP2F8, 2, GEXP>(lds, g, S, E); else
        pg8::gemm_phase<pg8::EpiF8Relu2, pg8::StaticOrder, PG8_ALIGN, PG8_SP2F8, 2>(lds, g, S, E); }
        if (BOTH(8)) GRID_BAR();
    }

    if (IN(9) && DUP_ID != 100) {
        PHASE_IDS();
        REP(9) { float* o9 = (DUP_ID == 9 && rep_ == 0) ? (float*)(ws + WS_WIN) : out_p;
        pg8::Gemm g{HID, W2T, MTOK, DM, FF / 2}; pg8::StaticOrder S; S.init(MTOK, DM, G, bx); pg8::EpiResGate E{out_p, o9, MODS + 5 * DM, DM, 1.0f / W2SCALE};
        if (DUP_ID == 9 && GEXP != 0 && rep_ == 0) pg8::gemm_phase<pg8::EpiResGate, pg8::StaticOrder, PG8_ALIGN, PG8_SP2F8, 1, GEXP>(lds, g, S, E); else
        pg8::gemm_phase<pg8::EpiResGate, pg8::StaticOrder, PG8_ALIGN, PG8_SP2F8, 1>(lds, g, S, E); }
    }
#undef PHASE_IDS
#undef IN
#undef BOTH
#undef GRID_BAR
#undef x_in
#undef cvec
#undef ctx
#undef c_ctx
#undef norm1_g
#undef norm2_g
#undef w_ada
#undef b_ada
#undef w_in
#undef hy_conv_w
#undef hy_conv_b
#undef hy_w1
#undef hy_b1
#undef hy_w2
#undef hy_b2
#undef hy_w3
#undef hy_freq
#undef hy_bias
#undef g_qa
#undef w_qb
#undef g_kva
#undef w_kvb
#undef q_norm_g
#undef k_norm_g
#undef w_out
#undef w_mlp1
#undef w_mlp2
#undef out_p
#undef MODP
#undef MODS
#undef TW1
#undef TW2
#undef W1T
#undef W2T
#undef WinT
#undef WinT8
#undef H8
#undef WqbT
#undef WkvbT
#undef Hh
#undef FiltT
#undef Hb
#undef HyT
#undef QA
#undef KVA
#undef KR
#undef Qraw
#undef KVraw
#undef YT
#undef KSall
#undef Qb
#undef Kb
#undef Vb
#undef MIX
#undef WoutT
#undef H2
#undef HID
}

extern "C" void kernel_launch(void* const* d_in, const int* in_sizes, int n_in, void* d_out, int out_size, void* d_ws, size_t ws_size, hipStream_t stream) {
    static int grid = 0;
    if (grid == 0) {
        if (n_in != 27 || out_size != MTOK * DM || ws_size < WS_END) { fprintf(stderr, "kernel_launch: unexpected shapes: n_in %d out %d ws %zu (need %zu)\n", n_in, out_size, ws_size, (size_t)WS_END); grid = -1; return; }
        int dev = 0, cus = 0, per_cu = 0;
        if (hipGetDevice(&dev) != hipSuccess || hipDeviceGetAttribute(&cus, hipDeviceAttributeMultiprocessorCount, dev) != hipSuccess) { grid = -1; return; }
        if (hipFuncSetAttribute((const void*)mega_fwd, hipFuncAttributeMaxDynamicSharedMemorySize, LDS_BYTES) != hipSuccess) { fprintf(stderr, "kernel_launch: hipFuncSetAttribute failed\n"); grid = -1; return; }
        if (hipOccupancyMaxActiveBlocksPerMultiprocessor(&per_cu, (const void*)mega_fwd, NWAVES * 64, LDS_BYTES) != hipSuccess || per_cu < 1) { fprintf(stderr, "kernel_launch: occupancy query reports %d\n", per_cu); }
        (void)hipGetLastError();
        if (cus != 256) { fprintf(stderr, "kernel_launch: built for 256 CUs (several phases deal their work in fixed per-workgroup shares of a 256-workgroup grid); this device has %d; nothing launched\n", cus); grid = -1; return; }
        grid = cus;
    }
    if (grid < 0) return;
    if (hipMemsetAsync((char*)d_ws + WS_CTL, 0, CTL_ZERO_BYTES, stream) != hipSuccess) return;
    Args a{};
    for (int i = 0; i < 27; ++i) a.in[i] = (const float*)d_in[i];
    a.out = (float*)d_out; a.ws = (unsigned char*)d_ws;
    for (int li = 0; li < N_LAUNCHES; ++li) {
        a.ph_lo = (N_LAUNCHES == 1) ? 0 : li; a.ph_hi = (N_LAUNCHES == 1) ? N_PHASES : li + 1; a.li = li; a.pad = 0;
        hipLaunchKernelGGL(mega_fwd, dim3(grid), dim3(NWAVES * 64), LDS_BYTES, stream, a);
        const hipError_t le = hipPeekAtLastError();
        if (le != hipSuccess) { fprintf(stderr, "kernel_launch: launch %d failed: %s\n", li, hipGetErrorName(le)); break; }
    }
}
```

```cpp
#include <hip/hip_runtime.h>
#include <cstdio>
#include <cstdint>
#define GEXP 0
#ifndef MK_N_LAUNCHES
#define MK_N_LAUNCHES 1
#endif
namespace pg8 {
#define PG8_LAS __attribute__((address_space(3)))
typedef unsigned short bf16_t;
typedef short bf16x8 __attribute__((ext_vector_type(8)));
typedef float f32x4 __attribute__((ext_vector_type(4)));
typedef unsigned u32x4 __attribute__((ext_vector_type(4)));
typedef int i32x4 __attribute__((ext_vector_type(4)));
typedef int i32x8 __attribute__((ext_vector_type(8)));
constexpr int BM = 256, BK = 64, HALF = 128, HTB = HALF * BK * 2  , STAGE_BYTES = 8 * HTB, NXCD = 8, WGM = 4;

__host__ __device__ __forceinline__ int lds_byte(int r, int c) { const int st = (r >> 4) * 2 + (c >> 5), rr = r & 15, cc = c & 31, ob = rr * 64 + cc * 2; return st * 1024 + (ob ^ (((ob >> 9) & 1) << 5)); }
__host__ __device__ __forceinline__ void stage_rc(int b, int& R, int& C) { const int st = b / 1024, sb = b % 1024, swz = sb ^ (((sb >> 9) & 1) << 5); R = (st >> 1) * 16 + swz / 64; C = (st & 1) * 32 + (swz % 64) / 2; }
__host__ __device__ __forceinline__ int perm32(int rho) { const int n = rho >> 4, i = rho & 15; return 8 * (i >> 2) + 4 * n + (i & 3); }

struct Unit { int pm, pn; };
struct Gemm { const bf16_t* A; const bf16_t* Bt; int M, N, K; int tsplit = 0; };

struct StaticOrder {
    int nM, nN, nwg, G, c;
    __host__ __device__ void init(int M, int N, int G_, int c_) { nM = M / BM; nN = N / BM; nwg = nM * nN; G = G_; c = c_; }
    __host__ __device__ bool next(int i, Unit& u) const {
        const long L = (long)i * G + c; if (L >= nwg) return false;
        int wgid = (int)L; { const int q = nwg / NXCD, r = nwg % NXCD, xcd = wgid % NXCD, off = wgid / NXCD; wgid = (xcd < r ? xcd * (q + 1) : r * (q + 1) + (xcd - r) * q) + off; }
        const int nig = WGM * nN, gid = wgid / nig, fm = gid * WGM, gsz = (nM - fm) < WGM ? (nM - fm) : WGM;
        u.pm = fm + ((wgid % nig) % gsz); u.pn = (wgid % nig) / gsz; return true;
    }
    __device__ __forceinline__ void a_ready(const Unit&) const {}
    __device__ __forceinline__ void done(const Unit&) const {}
};

__device__ __forceinline__ unsigned cvt_pk_bf16(float lo, float hi) { unsigned r; asm volatile("v_cvt_pk_bf16_f32 %0, %1, %2" : "=v"(r) : "v"(lo), "v"(hi)); return r; }
typedef float f32x2 __attribute__((ext_vector_type(2)));
template <int ACT> struct EpiBf16A {
    static constexpr bool PERM = true, AFTER_DRAIN = false;
    bf16_t* O; int ldc; float s;
    __device__ __forceinline__ void operator()(const f32x4 (&acc)[2][2][4][2], const Unit& u, int wr, int wc, int fr, int fq) const {
        const int row0 = u.pm * BM + wr * 64 + fr, col0 = u.pn * BM + wc * 32 + 8 * fq;
#pragma unroll
        for (int ai = 0; ai < 2; ++ai)
#pragma unroll
            for (int m = 0; m < 4; ++m) { bf16_t* rowp = O + (size_t)(row0 + ai * HALF + m * 16) * ldc + col0;
#pragma unroll
                for (int bj = 0; bj < 2; ++bj) { f32x4 v0 = acc[ai][bj][m][0] * s, v1 = acc[ai][bj][m][1] * s;
                    if (ACT == 1) {
#pragma unroll
                        for (int j = 0; j < 4; ++j) { const float a = fmaxf(v0[j], 0.f), b = fmaxf(v1[j], 0.f); v0[j] = a * a; v1[j] = b * b; } }
                    u32x4 w; w.x = cvt_pk_bf16(v0[0], v0[1]); w.y = cvt_pk_bf16(v0[2], v0[3]); w.z = cvt_pk_bf16(v1[0], v1[1]); w.w = cvt_pk_bf16(v1[2], v1[3]);
                    *(u32x4*)(rowp + bj * HALF) = w; } }
    }
};
__device__ __forceinline__ unsigned pack4_fp8(float a, float b, float c, float d) {
    a = fminf(a, 448.f); b = fminf(b, 448.f); c = fminf(c, 448.f); d = fminf(d, 448.f);
    int w = 0; w = __builtin_amdgcn_cvt_pk_fp8_f32(a, b, w, false); w = __builtin_amdgcn_cvt_pk_fp8_f32(c, d, w, true); return (unsigned)w; }
struct EpiF8A {
    static constexpr bool PERM = true, AFTER_DRAIN = false;
    unsigned char* O; int ldc; float s;
    __device__ __forceinline__ void operator()(const f32x4 (&acc)[2][2][4][2], const Unit& u, int wr, int wc, int fr, int fq) const {
        const int row0 = u.pm * BM + wr * 64 + fr, col0 = u.pn * BM + wc * 32 + 8 * fq;
#pragma unroll
        for (int ai = 0; ai < 2; ++ai)
#pragma unroll
            for (int m = 0; m < 4; ++m) { unsigned char* rowp = O + (size_t)(row0 + ai * HALF + m * 16) * ldc + col0;
#pragma unroll
                for (int bj = 0; bj < 2; ++bj) { const f32x4 v0 = acc[ai][bj][m][0] * s, v1 = acc[ai][bj][m][1] * s;
                    typedef unsigned u32x2 __attribute__((ext_vector_type(2)));
                    u32x2 w; w.x = pack4_fp8(fmaxf(v0[0], -448.f), fmaxf(v0[1], -448.f), fmaxf(v0[2], -448.f), fmaxf(v0[3], -448.f)); w.y = pack4_fp8(fmaxf(v1[0], -448.f), fmaxf(v1[1], -448.f), fmaxf(v1[2], -448.f), fmaxf(v1[3], -448.f));
                    *(u32x2*)(rowp + bj * HALF) = w; } }
    }
};
struct EpiF8Relu2 {
    static constexpr bool PERM = true, AFTER_DRAIN = false;
    unsigned char* O; int ldc; float s;
    __device__ __forceinline__ void operator()(const f32x4 (&acc)[2][2][4][2], const Unit& u, int wr, int wc, int fr, int fq) const {
        const int row0 = u.pm * BM + wr * 64 + fr, col0 = u.pn * BM + wc * 32 + 8 * fq;
#pragma unroll
        for (int ai = 0; ai < 2; ++ai)
#pragma unroll
            for (int m = 0; m < 4; ++m) { unsigned char* rowp = O + (size_t)(row0 + ai * HALF + m * 16) * ldc + col0;
#pragma unroll
                for (int bj = 0; bj < 2; ++bj) { f32x4 v0 = acc[ai][bj][m][0] * s, v1 = acc[ai][bj][m][1] * s;
#pragma unroll
                    for (int j = 0; j < 4; ++j) { const float a = fmaxf(v0[j], 0.f), b = fmaxf(v1[j], 0.f); v0[j] = a * a; v1[j] = b * b; }
                    typedef unsigned u32x2 __attribute__((ext_vector_type(2)));
                    u32x2 w; w.x = pack4_fp8(v0[0], v0[1], v0[2], v0[3]); w.y = pack4_fp8(v1[0], v1[1], v1[2], v1[3]);
                    *(u32x2*)(rowp + bj * HALF) = w; } }
    }
};
struct EpiAttProj {
    static constexpr bool PERM = true, AFTER_DRAIN = false;
    unsigned char* QA; unsigned char* KVA; float* KR; float s;
    __device__ __forceinline__ void operator()(const f32x4 (&acc)[2][2][4][2], const Unit& u, int wr, int wc, int fr, int fq) const {
        const int row0 = u.pm * BM + wr * 64 + fr;
        if (u.pn < 6) {
            unsigned char* base = u.pn < 4 ? QA : KVA; const int ldc = u.pn < 4 ? 1024 : 512; const int col0 = (u.pn < 4 ? u.pn : u.pn - 4) * BM + wc * 32 + 8 * fq;
#pragma unroll
            for (int ai = 0; ai < 2; ++ai)
#pragma unroll
                for (int m = 0; m < 4; ++m) { unsigned char* rowp = base + (size_t)(row0 + ai * HALF + m * 16) * ldc + col0;
#pragma unroll
                    for (int bj = 0; bj < 2; ++bj) { const f32x4 v0 = acc[ai][bj][m][0] * s, v1 = acc[ai][bj][m][1] * s;
                        typedef unsigned u32x2 __attribute__((ext_vector_type(2)));
                        u32x2 w; w.x = pack4_fp8(fmaxf(v0[0], -448.f), fmaxf(v0[1], -448.f), fmaxf(v0[2], -448.f), fmaxf(v0[3], -448.f)); w.y = pack4_fp8(fmaxf(v1[0], -448.f), fmaxf(v1[1], -448.f), fmaxf(v1[2], -448.f), fmaxf(v1[3], -448.f));
                        *(u32x2*)(rowp + bj * HALF) = w; } }
        } else if (wc < 2) {
            const int col0 = wc * 32 + 8 * fq;
#pragma unroll
            for (int ai = 0; ai < 2; ++ai)
#pragma unroll
                for (int m = 0; m < 4; ++m) { float* rowp = KR + (size_t)(row0 + ai * HALF + m * 16) * 64 + col0;
                    *(f32x4*)(rowp) = acc[ai][0][m][0] * s; *(f32x4*)(rowp + 4) = acc[ai][0][m][1] * s; }
        }
    }
};
struct EpiResGate {
    static constexpr bool PERM = false, AFTER_DRAIN = false;
    const float* base; float* out; const float* gate; int ldc; float scale;
    __device__ __forceinline__ void operator()(const f32x4 (&acc)[2][2][4][2], const Unit& u, int wr, int wc, int fr, int fq) const {
        const int row0 = u.pm * BM + wr * 64 + fr, col0 = u.pn * BM + wc * 32 + 4 * fq;
        const float* g = gate + (size_t)(u.pm >> 5) * 24576;
        f32x4 gv[2][2];
#pragma unroll
        for (int bj = 0; bj < 2; ++bj)
#pragma unroll
            for (int n = 0; n < 2; ++n) gv[bj][n] = *(const f32x4*)(g + col0 + bj * HALF + n * 16) * scale;
#pragma unroll
        for (int ai = 0; ai < 2; ++ai) { f32x4 bs[4][2][2];
#pragma unroll
            for (int m = 0; m < 4; ++m) { const size_t off = (size_t)(row0 + ai * HALF + m * 16) * ldc + col0;
#pragma unroll
                for (int bj = 0; bj < 2; ++bj)
#pragma unroll
                    for (int n = 0; n < 2; ++n) bs[m][bj][n] = *(const f32x4*)(base + off + bj * HALF + n * 16); }
#pragma unroll
            for (int m = 0; m < 4; ++m) { const size_t off = (size_t)(row0 + ai * HALF + m * 16) * ldc + col0;
#pragma unroll
                for (int bj = 0; bj < 2; ++bj)
#pragma unroll
                    for (int n = 0; n < 2; ++n) *(f32x4*)(out + off + bj * HALF + n * 16) = bs[m][bj][n] + gv[bj][n] * acc[ai][bj][m][n]; }
            asm volatile("" ::: "memory"); }
    }
};
struct AttProjOrder {
    int G, c;
    __device__ __forceinline__ bool next(int i, Unit& u) const {
        const long L = (long)i * G + c; if (L >= 454) return false;
        int wgid = (int)L; { const int q = 454 / NXCD, r = 454 % NXCD, xcd = wgid % NXCD, off = wgid / NXCD; wgid = (xcd < r ? xcd * (q + 1) : r * (q + 1) + (xcd - r) * q) + off; }
        if (wgid < 448) { u.pm = wgid / 7; u.pn = wgid % 7; } else { const int r2 = wgid - 448; u.pm = 64 + r2 / 3; u.pn = 4 + r2 % 3; }
        return true;
    }
    __device__ __forceinline__ void a_ready(const Unit&) const {}
    __device__ __forceinline__ void done(const Unit&) const {}
};
template <class Epi, class Sched, bool ALIGN_EPI = false, bool SP2 = false, int FP8 = 0  , int EXP = 0  >
__device__ __forceinline__ void gemm_phase(PG8_LAS unsigned char* lds, const Gemm g, const Sched& S, const Epi& E) {
    int tid_o = threadIdx.x; asm volatile("" : "+v"(tid_o));
    const int tid = tid_o, wid = __builtin_amdgcn_readfirstlane(tid >> 6), lane = tid & 63, wr = wid >> 2, wc = wid & 3, fr = lane & 15, fq = lane >> 4;
    const int K = g.K, nt = K / BK;
    unsigned voffA[2], voffB[2];
#pragma unroll
    for (int i = 0; i < 2; ++i) { int R, C; stage_rc(tid * 16 + i * 8192, R, C); const int Rb = Epi::PERM ? ((R & ~31) + perm32(R & 31)) : R;
        voffA[i] = (unsigned)(R * K + C) * 2u; voffB[i] = (unsigned)(Rb * K + C) * 2u; }
    const size_t kstep = (size_t)(BK * 2);
    const size_t hstep = (size_t)HALF * K * 2;
    const size_t tstep = 2 * hstep;
    const unsigned ldsw = (unsigned)wid * 1024u;
    const int aoff = lds_byte(wr * 64 + fr, fq * 8), boff = lds_byte(wc * 32 + fr, fq * 8);
#define PG8_SA(b, h) (((b) * 2 + (h)) * HTB)
#define PG8_SB(b, h) ((4 + (b) * 2 + (h)) * HTB)
#define PG8_STAGE(bufoff, gbase, voff) do { _Pragma("unroll") for (int _i = 0; _i < 2; ++_i) \
        __builtin_amdgcn_global_load_lds((const unsigned*)((const char*)(gbase) + (voff)[_i]), (PG8_LAS unsigned*)(lds + (bufoff) + ldsw + _i * 8192), 16, 0, 0); } while (0)
#define PG8_STAGE_L(bufoff, gbase, voff) do { if constexpr (EXP != 3) PG8_STAGE(bufoff, gbase, voff); } while (0)
#define PG8_CAT(v0, v1) __builtin_shufflevector(v0, v1, 0, 1, 2, 3, 4, 5, 6, 7)
#define PG8_LDA(dst, b, h) do { _Pragma("unroll") for (int m = 0; m < 4; ++m) { if constexpr (FP8) dst##8[m] = PG8_CAT(*(const PG8_LAS i32x4*)(lds + PG8_SA(b, h) + aoff + m * 2048), *(const PG8_LAS i32x4*)(lds + PG8_SA(b, h) + aoff + m * 2048 + 1024)); \
        else { _Pragma("unroll") for (int k = 0; k < 2; ++k) dst[m][k] = *(const PG8_LAS bf16x8*)(lds + PG8_SA(b, h) + aoff + m * 2048 + k * 1024); } } } while (0)
#define PG8_LDB(dst, b, h) do { _Pragma("unroll") for (int n = 0; n < 2; ++n) { if constexpr (FP8) dst##8[n] = PG8_CAT(*(const PG8_LAS i32x4*)(lds + PG8_SB(b, h) + boff + n * 2048), *(const PG8_LAS i32x4*)(lds + PG8_SB(b, h) + boff + n * 2048 + 1024)); \
        else { _Pragma("unroll") for (int k = 0; k < 2; ++k) dst[n][k] = *(const PG8_LAS bf16x8*)(lds + PG8_SB(b, h) + boff + n * 2048 + k * 1024); } } } while (0)
#define PG8_MMA(ai, bj, At, Bt) do { __builtin_amdgcn_s_setprio(1); _Pragma("unroll") for (int m = 0; m < 4; ++m) _Pragma("unroll") for (int n = 0; n < 2; ++n) { \
        if constexpr (EXP == 2) { asm volatile("" :: "v"(Bt##8[n]), "v"(At##8[m])); } else if constexpr (PG8_F == 1) asm volatile("s_nop 1\n\tv_mfma_scale_f32_16x16x128_f8f6f4 %0, %1, %2, %0, %3, %3 op_sel_hi:[0,0,0]" : "+v"(acc[ai][bj][m][n]) : "v"(Bt##8[n]), "v"(At##8[m]), "v"(f8scale)); \
        else if constexpr (PG8_F == 2) asm volatile("s_nop 1\n\tv_mfma_scale_f32_16x16x128_f8f6f4 %0, %1, %2, %0, %3, %4 op_sel_hi:[0,0,0] cbsz:2 blgp:2" : "+v"(acc[ai][bj][m][n]) \
            : "v"(__builtin_shufflevector(Bt##8[n], Bt##8[n], 0, 1, 2, 3, 4, 5)), "v"(__builtin_shufflevector(At##8[m], At##8[m], 0, 1, 2, 3, 4, 5)), "v"(Bt##8[n][6]), "v"(At##8[m][6])); \
        else if constexpr (FP8 == 3) { _Pragma("unroll") for (int k = 0; k < 2; ++k) { if (k == 0) asm volatile("s_nop 1\n\tv_mfma_f32_16x16x32_bf16 %0, %1, %2, %0" : "+v"(acc[ai][bj][m][n]) : "v"(__builtin_shufflevector(Bt##8[n], Bt##8[n], 0, 1, 2, 3)), "v"(__builtin_shufflevector(At##8[m], At##8[m], 0, 1, 2, 3))); \
            else asm volatile("s_nop 1\n\tv_mfma_f32_16x16x32_bf16 %0, %1, %2, %0" : "+v"(acc[ai][bj][m][n]) : "v"(__builtin_shufflevector(Bt##8[n], Bt##8[n], 4, 5, 6, 7)), "v"(__builtin_shufflevector(At##8[m], At##8[m], 4, 5, 6, 7))); } }   \
        else { _Pragma("unroll") for (int k = 0; k < 2; ++k) acc[ai][bj][m][n] = __builtin_amdgcn_mfma_f32_16x16x32_bf16(Bt[n][k], At[m][k], acc[ai][bj][m][n], 0, 0, 0); } } __builtin_amdgcn_s_setprio(0); } while (0)
#define PG8_F (FP8 == 3 ? 2 : FP8)
#define PG8_WAIT_V(n) asm volatile("s_waitcnt vmcnt(" #n ")" ::: "memory")
#define PG8_WAIT_L(n) asm volatile("s_waitcnt lgkmcnt(" #n ")" ::: "memory")
#define PG8_BAR __builtin_amdgcn_s_barrier()
#define PG8_SCHED __builtin_amdgcn_sched_barrier(0)
#define PG8_SP2_BODY \
            PG8_LDB(B0, 0, 0); PG8_LDB(B1, 0, 1); PG8_SCHED; PG8_LDA(At, 0, 0); PG8_STAGE_L(PG8_SA(1, 1), a1 + hstep, voffA); \
            PG8_WAIT_V(8); PG8_WAIT_L(0); PG8_BAR; PG8_MMA(0, 0, At, B0); PG8_MMA(0, 1, At, B1); PG8_BAR; PG8_SCHED; \
            PG8_LDA(At, 0, 1); PG8_STAGE_L(PG8_SB(0, 0), b2, voffB); PG8_STAGE_L(PG8_SB(0, 1), b2 + hstep, voffB); PG8_STAGE_L(PG8_SA(0, 0), a2, voffA); \
            PG8_WAIT_V(8); PG8_WAIT_L(0); PG8_BAR; PG8_MMA(1, 0, At, B0); PG8_MMA(1, 1, At, B1); PG8_BAR; PG8_SCHED; \
            PG8_LDB(B0, 1, 0); PG8_LDB(B1, 1, 1); PG8_SCHED; PG8_LDA(At, 1, 0); PG8_STAGE_L(PG8_SA(0, 1), a2 + hstep, voffA); \
            PG8_WAIT_V(8); PG8_WAIT_L(0); PG8_BAR; PG8_MMA(0, 0, At, B0); PG8_MMA(0, 1, At, B1); PG8_BAR; PG8_SCHED; \
            PG8_LDA(At, 1, 1); PG8_STAGE_L(PG8_SB(1, 0), b3, voffB); PG8_STAGE_L(PG8_SB(1, 1), b3 + hstep, voffB); PG8_STAGE_L(PG8_SA(1, 0), a3, voffA); \
            PG8_WAIT_V(8); PG8_WAIT_L(0); PG8_BAR; PG8_MMA(1, 0, At, B0); PG8_MMA(1, 1, At, B1); PG8_BAR; PG8_SCHED;
    Unit cur, nxt; int ui = 0;
    if (!S.next(0, cur)) return;
    f32x4 acc[2][2][4][2];
#pragma unroll
    for (int a = 0; a < 2; ++a)
#pragma unroll
        for (int b = 0; b < 2; ++b)
#pragma unroll
            for (int m = 0; m < 4; ++m)
#pragma unroll
                for (int n = 0; n < 2; ++n) acc[a][b][m][n] = (f32x4){0.f, 0.f, 0.f, 0.f};
    const int f8scale = 0x7f7f7f7f;
    bf16x8 At[4][2], B0[2][2], B1[2][2]; i32x8 At8[4], B08[2], B18[2];
    const char* cA = (const char*)g.A + (size_t)(EXP == 1 ? 0 : cur.pm) * tstep; const char* cB = (const char*)g.Bt + (size_t)(EXP == 1 ? 0 : cur.pn) * tstep;
    S.a_ready(cur);
    if constexpr (SP2) {
        PG8_STAGE(PG8_SB(0, 0), cB, voffB); PG8_STAGE(PG8_SB(0, 1), cB + hstep, voffB); PG8_STAGE(PG8_SA(0, 0), cA, voffA); PG8_STAGE(PG8_SA(0, 1), cA + hstep, voffA);
        if (wr == 1) PG8_BAR;
        PG8_WAIT_V(2); PG8_BAR;
        PG8_STAGE(PG8_SB(1, 0), cB + kstep, voffB); PG8_STAGE(PG8_SA(1, 0), cA + kstep, voffA); PG8_STAGE(PG8_SB(1, 1), cB + hstep + kstep, voffB);
        PG8_WAIT_V(6); PG8_BAR;
    } else {
        PG8_STAGE(PG8_SB(0, 0), cB, voffB); PG8_STAGE(PG8_SA(0, 0), cA, voffA); PG8_STAGE(PG8_SB(0, 1), cB + hstep, voffB); PG8_STAGE(PG8_SA(0, 1), cA + hstep, voffA);
        if (wr == 1) PG8_BAR;
        PG8_WAIT_V(4); PG8_BAR;
        PG8_STAGE(PG8_SB(1, 0), cB + kstep, voffB); PG8_STAGE(PG8_SA(1, 0), cA + kstep, voffA); PG8_STAGE(PG8_SB(1, 1), cB + hstep + kstep, voffB);
        PG8_WAIT_V(6); PG8_BAR;
    }
    for (;;) {
        const bool has_next = S.next(ui + 1, nxt);
        const char* nA = (has_next && EXP != 1) ? (const char*)g.A + (size_t)nxt.pm * tstep : cA; const char* nB = (has_next && EXP != 1) ? (const char*)g.Bt + (size_t)nxt.pn * tstep : cB;
        int t = 0;
        if constexpr (FP8 == 3) {
            for (; t < g.tsplit; t += 2) {
                const char* a1 = cA + (size_t)(t + 1) * kstep; const char* a2 = cA + (size_t)(t + 2) * kstep; const char* b2 = cB + (size_t)(t + 2) * kstep; const char* a3 = a2 + kstep; const char* b3 = b2 + kstep;
#undef PG8_F
#define PG8_F 0
                PG8_SP2_BODY
#undef PG8_F
#define PG8_F (FP8 == 3 ? 2 : FP8)
            }
        }
        for (; t < nt; t += 2) {
            const bool last = (t == nt - 2);
            const char* a1 = cA + (size_t)(t + 1) * kstep;
            const char* a2 = last ? nA : cA + (size_t)(t + 2) * kstep; const char* b2 = last ? nB : cB + (size_t)(t + 2) * kstep;
            const char* a3 = a2 + kstep; const char* b3 = b2 + kstep;
            if (last && has_next) S.a_ready(nxt);
            if constexpr (SP2) {
            PG8_SP2_BODY
            } else {
            PG8_LDB(B0, 0, 0); PG8_SCHED; PG8_LDA(At, 0, 0); PG8_STAGE_L(PG8_SA(1, 1), a1 + hstep, voffA);
            PG8_WAIT_L(8); PG8_BAR; PG8_WAIT_L(0); PG8_MMA(0, 0, At, B0); PG8_BAR; PG8_SCHED;
            PG8_LDB(B1, 0, 1); PG8_STAGE_L(PG8_SB(0, 0), b2, voffB);
            PG8_BAR; PG8_WAIT_L(0); PG8_MMA(0, 1, At, B1); PG8_BAR;
            PG8_LDA(At, 0, 1); PG8_STAGE_L(PG8_SA(0, 0), a2, voffA);
            PG8_BAR; PG8_WAIT_L(0); PG8_MMA(1, 0, At, B0); PG8_BAR; PG8_SCHED;
            PG8_STAGE_L(PG8_SB(0, 1), b2 + hstep, voffB);
            PG8_WAIT_V(6); PG8_BAR; PG8_MMA(1, 1, At, B1); PG8_BAR;
            PG8_LDB(B0, 1, 0); PG8_SCHED; PG8_LDA(At, 1, 0); PG8_STAGE_L(PG8_SA(0, 1), a2 + hstep, voffA);
            PG8_WAIT_L(8); PG8_BAR; PG8_WAIT_L(0); PG8_MMA(0, 0, At, B0); PG8_BAR; PG8_SCHED;
            PG8_LDB(B1, 1, 1); PG8_STAGE_L(PG8_SB(1, 0), b3, voffB);
            PG8_BAR; PG8_WAIT_L(0); PG8_MMA(0, 1, At, B1); PG8_BAR;
            PG8_LDA(At, 1, 1); PG8_STAGE_L(PG8_SA(1, 0), a3, voffA);
            PG8_BAR; PG8_WAIT_L(0); PG8_MMA(1, 0, At, B0); PG8_BAR; PG8_SCHED;
            PG8_STAGE_L(PG8_SB(1, 1), b3 + hstep, voffB);
            PG8_WAIT_V(6); PG8_BAR; PG8_MMA(1, 1, At, B1); PG8_BAR;
            }
        }
        if constexpr (FP8) asm volatile("s_nop 15\n\ts_nop 15" ::: "memory");
        if constexpr (ALIGN_EPI) { if (wr == 0) PG8_BAR; }
        if constexpr (!Epi::AFTER_DRAIN) { E(acc, cur, wr, wc, fr, fq); S.done(cur); }
        if (!has_next) break;
#pragma unroll
        for (int a = 0; a < 2; ++a)
#pragma unroll
            for (int b = 0; b < 2; ++b)
#pragma unroll
                for (int m = 0; m < 4; ++m)
#pragma unroll
                    for (int n = 0; n < 2; ++n) acc[a][b][m][n] = (f32x4){0.f, 0.f, 0.f, 0.f};
        if constexpr (FP8) asm volatile("s_nop 7" ::: "memory");
        cur = nxt; cA = nA; cB = nB; ++ui;
        if constexpr (ALIGN_EPI) { if (wr == 1) PG8_BAR; }
    }
    PG8_WAIT_V(0);
    if constexpr (!ALIGN_EPI) { if (wr == 0) PG8_BAR; }
    PG8_BAR;
    if constexpr (Epi::AFTER_DRAIN) { E.fused(acc, cur, wr, wc, fr, fq, lds, wid, lane); S.done(cur); }
#undef PG8_SA
#undef PG8_SB
#undef PG8_STAGE
#undef PG8_SP2_BODY
#undef PG8_F
#undef PG8_STAGE_L
#undef PG8_LDA
#undef PG8_LDB
#undef PG8_MMA
#undef PG8_CAT
#undef PG8_WAIT_V
#undef PG8_WAIT_L
#undef PG8_BAR
#undef PG8_SCHED
}
}
#ifndef PG8_SP2
#define PG8_SP2 true
#endif
#ifndef PG8_SP2F8
#define PG8_SP2F8 true
#endif
#ifndef PG8_ALIGN
#define PG8_ALIGN true
#endif
#define GAS __attribute__((address_space(1)))
#define LAS __attribute__((address_space(3)))
typedef unsigned short bf16;
typedef unsigned v4u __attribute__((ext_vector_type(4)));
typedef float f32x4 __attribute__((ext_vector_type(4)));
typedef short bf16x8 __attribute__((ext_vector_type(8)));
typedef GAS unsigned gu32;
typedef GAS unsigned long long gu64;
#define RLX_AGENT __ATOMIC_RELAXED, __HIP_MEMORY_SCOPE_AGENT
#define LDS_WAIT() asm volatile("s_waitcnt lgkmcnt(0)" ::: "memory")
#define VM_WAIT() asm volatile("s_waitcnt vmcnt(0)" ::: "memory")
__device__ __forceinline__ unsigned long long rt() { return __builtin_amdgcn_s_memrealtime(); }
__device__ __forceinline__ unsigned f2bf(float f) { unsigned u = __builtin_bit_cast(unsigned, f); return (u + 0x7fffu + ((u >> 16) & 1u)) >> 16; }
__device__ __forceinline__ unsigned pk2(float lo, float hi) { return f2bf(lo) | (f2bf(hi) << 16); }
typedef float f32x16v __attribute__((ext_vector_type(16)));
typedef int i32x6v __attribute__((ext_vector_type(6)));
__device__ __forceinline__ void mx6_pack(f32x16v a, f32x16v b, v4u& lo, v4u& hi) {
    float mx = 0.f;
#pragma unroll
    for (int i = 0; i < 16; ++i) mx = fmaxf(mx, fmaxf(fabsf(a[i]), fabsf(b[i])));
    int sb = (int)((__float_as_uint(mx) >> 23) & 0xffu) - 2; sb = sb < 1 ? 1 : sb;
    const float mult = __uint_as_float((unsigned)(254 - sb) << 23);
#pragma unroll
    for (int i = 0; i < 16; ++i) { a[i] = fminf(fmaxf(a[i] * mult, -7.5f), 7.5f); b[i] = fminf(fmaxf(b[i] * mult, -7.5f), 7.5f); }
    const i32x6v p = __builtin_amdgcn_cvt_scalef32_2xpk16_fp6_f32(a, b, 1.0f);
    lo = (v4u){(unsigned)p[0], (unsigned)p[1], (unsigned)p[2], (unsigned)p[3]}; hi = (v4u){(unsigned)p[4], (unsigned)p[5], (unsigned)sb, 0u};
}
__device__ __forceinline__ size_t mx6_off(int blk) { return (size_t)(blk >> 2) * 128 + 16 * (blk & 3); }
#define XB_TMO      128
#define XB_XCNT(j)  (256  + 64 * (j))
#define XB_XSUB(j)  (1280 + 64 * (j))
#define XB_XGEN(j)  (2304 + 64 * (j))
#define XB_TOP      3328
#define XB_TOPGEN   3392
#define XCD_BAR_WORDS 3456
#define XB_SPIN_CAP (1u << 18)

__device__ __forceinline__ unsigned xb_ld(unsigned* p)              { return __hip_atomic_load(p, __ATOMIC_RELAXED, __HIP_MEMORY_SCOPE_AGENT); }
__device__ __forceinline__ unsigned xb_add(unsigned* p, unsigned v) { return __hip_atomic_fetch_add(p, v, __ATOMIC_RELAXED, __HIP_MEMORY_SCOPE_AGENT); }
__device__ __forceinline__ unsigned xb_xcc_id() { return (unsigned)__builtin_amdgcn_s_getreg((3 << 11) | 20) & 0xFu; }
#define XB_SPIN(cond, bar) do { unsigned _sp = 0; while (cond) { __builtin_amdgcn_s_sleep(1); \
    if ((++_sp & 255u) == 0u) { if (xb_ld(&(bar)[XB_TMO])) break; if (_sp > XB_SPIN_CAP) { atomicAdd(&(bar)[XB_TMO], 1u); break; } } } } while (0)

struct XcdBarrier {
    unsigned* bar; unsigned x;
    volatile LAS unsigned* st;
};

__device__ __forceinline__ XcdBarrier xcd_barrier_post(unsigned* bar, volatile LAS unsigned* st) {
    XcdBarrier b; b.bar = bar; b.x = xb_xcc_id(); b.st = st;
    if (threadIdx.x == 0) (void)xb_add(&bar[XB_XCNT(b.x)], 1u);
    return b;
}
__device__ __forceinline__ void xcd_barrier_complete(unsigned* bar, unsigned x, unsigned& nloc, unsigned& nx) {
    const unsigned G = gridDim.x * gridDim.y * gridDim.z;
    unsigned sum, cnt, mine, sp = 0u;
    for (;;) {
        sum = 0u; cnt = 0u; mine = 0u;
#pragma unroll
        for (unsigned j = 0; j < 16; ++j) { const unsigned c = xb_ld(&bar[XB_XCNT(j)]); sum += c; cnt += (c > 0u) ? 1u : 0u; mine = (j == x) ? c : mine; }
        if (sum == G) break;
        __builtin_amdgcn_s_sleep(1);
        if ((++sp & 255u) == 0u) { if (xb_ld(&bar[XB_TMO])) break; if (sp > XB_SPIN_CAP) { atomicAdd(&bar[XB_TMO], 1u); break; } }
    }
    nloc = mine > 0u ? mine : 1u; nx = cnt > 0u ? cnt : 1u;
}

__device__ __forceinline__ void xcd_barrier(const XcdBarrier& b) {
    asm volatile("s_waitcnt vmcnt(0)" ::: "memory");
    __syncthreads();
    if (threadIdx.x == 0) {
        unsigned* bar = b.bar;
        __builtin_amdgcn_s_waitcnt(0);
        unsigned nloc = b.st[0], nx = b.st[1];
        if (nloc == 0u) { xcd_barrier_complete(bar, b.x, nloc, nx); b.st[0] = nloc; b.st[1] = nx; }
        const unsigned old = xb_add(&bar[XB_XSUB(b.x)], 1u);
        const unsigned gen = old / nloc;
        if (old + 1u == (gen + 1u) * nloc) {
            __builtin_amdgcn_fence(__ATOMIC_RELEASE, "agent");
            asm volatile("s_waitcnt vmcnt(0)" ::: "memory");
            const unsigned og = xb_add(&bar[XB_TOP], 1u);
            const unsigned tg = og / nx;
            if (og + 1u == (tg + 1u) * nx) xb_add(&bar[XB_TOPGEN], 1u);
            else XB_SPIN(xb_ld(&bar[XB_TOPGEN]) == tg, bar);
            __builtin_amdgcn_fence(__ATOMIC_ACQUIRE, "agent");
            xb_add(&bar[XB_XGEN(b.x)], 1u);
            asm volatile("s_waitcnt vmcnt(0)" ::: "memory");
        } else {
            XB_SPIN(xb_ld(&bar[XB_XGEN(b.x)]) == gen, bar);
            __builtin_amdgcn_fence(__ATOMIC_ACQUIRE, "agent");
            asm volatile("s_waitcnt vmcnt(0)" ::: "memory");
        }
    }
    __syncthreads();
}
namespace att8 {
typedef unsigned short bf16;
using i32x4 = __attribute__((ext_vector_type(4))) int;
using i32x8 = __attribute__((ext_vector_type(8))) int;
using i32x2 = __attribute__((ext_vector_type(2))) int;
using f32x16 = __attribute__((ext_vector_type(16))) float;
constexpr int DQ = 192, DVV = 128, NW = 8, QBLK = 32, KVBLK = 64;
constexpr float SCALE = 0.07216878364870323f;
constexpr float THR = 3.f, POFF = 4.f;
constexpr int SHM_V = DVV * KVBLK, SHM_K = KVBLK * DQ, SHM_ATTN = 2 * SHM_V + 2 * SHM_K + NW * 64 * 4;
#define A8BAR() __builtin_amdgcn_sched_barrier(0)
__device__ __forceinline__ int crow(int r, int hi) { return (r & 3) + 8 * (r >> 2) + 4 * hi; }
__device__ __forceinline__ int k_off(int r, int s) { return r * 192 + (((s & ~3) | ((s & 3) ^ ((r >> 2) & 3))) << 4); }
__device__ __forceinline__ int v_off(int c, int s) { return c * 64 + ((s ^ ((c >> 2) & 3)) << 4); }
__device__ __forceinline__ f32x16 mfma8(i32x8 a, i32x8 b, f32x16 c) { return __builtin_amdgcn_mfma_scale_f32_32x32x64_f8f6f4(a, b, c, 0, 0, 0, 0x7f7f7f7f, 0, 0x7f7f7f7f); }
#define A8CAT(v0, v1) __builtin_shufflevector(v0, v1, 0, 1, 2, 3, 4, 5, 6, 7)

__device__ __forceinline__ void partialSM(f32x16& p0, f32x16& p1, float& m_reg, float& mn, float& alpha) {
  constexpr float C = SCALE * 1.4426950408889634f;
  float pmax = p0[0];
#pragma unroll
  for (int r = 1; r < 16; ++r) pmax = fmaxf(pmax, p0[r]);
#pragma unroll
  for (int r = 0; r < 16; ++r) pmax = fmaxf(pmax, p1[r]);
  { auto rr = __builtin_amdgcn_permlane32_swap(__float_as_uint(pmax), __float_as_uint(pmax), false, false);
    pmax = fmaxf(__uint_as_float(rr[0]), __uint_as_float(rr[1])); }
  if (__builtin_expect(__all(pmax - m_reg <= THR / SCALE), 1)) { mn = m_reg; alpha = 1.f; }
  else { mn = fmaxf(m_reg, pmax); alpha = __builtin_amdgcn_exp2f((m_reg - mn) * C); m_reg = mn; }
  const float mnC = POFF - mn * C;
#pragma unroll
  for (int r = 0; r < 16; ++r) p0[r] = fmaf(p0[r], C, mnC);
#pragma unroll
  for (int r = 0; r < 16; ++r) p1[r] = fmaf(p1[r], C, mnC);
#pragma unroll
  for (int r = 0; r < 16; ++r) p0[r] = __builtin_amdgcn_exp2f(p0[r]);
}
__device__ __forceinline__ unsigned pk4(float a, float b, float c, float d) { int w = 0; w = __builtin_amdgcn_cvt_pk_fp8_f32(a, b, w, false); w = __builtin_amdgcn_cvt_pk_fp8_f32(c, d, w, true); return (unsigned)w; }
__device__ __forceinline__ void finishSM(f32x16& p0, f32x16& p1, float alpha, float& l_reg, i32x8& pa) {
#pragma unroll
  for (int r = 0; r < 16; ++r) p1[r] = __builtin_amdgcn_exp2f(p1[r]);
  float ps = 0;
#pragma unroll
  for (int r = 0; r < 16; ++r) ps += p0[r];
#pragma unroll
  for (int r = 0; r < 16; ++r) ps += p1[r];
  { auto rr = __builtin_amdgcn_permlane32_swap(__float_as_uint(ps), __float_as_uint(ps), false, false);
    ps = __uint_as_float(rr[0]) + __uint_as_float(rr[1]); }
  l_reg = l_reg * alpha + ps;
#pragma unroll
  for (int g = 0; g < 4; ++g) { pa[g] = (int)pk4(p0[4 * g], p0[4 * g + 1], p0[4 * g + 2], p0[4 * g + 3]); pa[4 + g] = (int)pk4(p1[4 * g], p1[4 * g + 1], p1[4 * g + 2], p1[4 * g + 3]); }
}
__device__ __forceinline__ void qkt(f32x16& p0, f32x16& p1, const char* Ks, const i32x8* qr, int r32, int hi) {
  p0 = f32x16{}; p1 = f32x16{};
#pragma unroll
  for (int c = 0; c < 3; ++c) {
    const i32x8 a0 = A8CAT(*(const i32x4*)(Ks + k_off(r32, 4 * c + 2 * hi)), *(const i32x4*)(Ks + k_off(r32, 4 * c + 2 * hi + 1)));
    const i32x8 a1 = A8CAT(*(const i32x4*)(Ks + k_off(32 + r32, 4 * c + 2 * hi)), *(const i32x4*)(Ks + k_off(32 + r32, 4 * c + 2 * hi + 1)));
    p0 = mfma8(a0, qr[c], p0); p1 = mfma8(a1, qr[c], p1); }
}
__device__ __forceinline__ void pv(f32x16* o, const char* Vs, i32x8 pa, int r32, int hi) {
#pragma unroll
  for (int d0 = 0; d0 < 4; ++d0) { const int c = 32 * d0 + r32;
    const i32x8 b = A8CAT(*(const i32x4*)(Vs + v_off(c, 2 * hi)), *(const i32x4*)(Vs + v_off(c, 2 * hi + 1)));
    o[d0] = mfma8(pa, b, o[d0]); }
}
constexpr int LDO = 6144;
constexpr int OT_OFF = 45056, OT_LD = 136;
__device__ __forceinline__ void attn_unit(const unsigned char* __restrict__ Qb, const unsigned char* __restrict__ Kh, const unsigned char* __restrict__ Vt, unsigned char* __restrict__ Ob, int seq, char* lds) {
  int tid_o = threadIdx.x; asm volatile("" : "+v"(tid_o));
  const int tid = tid_o, wid = tid >> 6, lane = tid & 63, r32 = lane & 31, hi = lane >> 5;
  char* V_lds = lds; char* K_lds = lds + 2 * SHM_V;
  float* ws = (float*)(lds + 2 * SHM_V + 2 * SHM_K) + wid * 64; float* li_l = ws; float* al_l = ws + 32;
  float m_reg = -1e30f, l_reg = 0; f32x16 o[4] = {}; i32x8 qr[3];
  { const unsigned char* Qw = Qb + (long)(wid * QBLK + r32) * DQ + hi * 32;
#pragma unroll
    for (int c = 0; c < 3; ++c) qr[c] = A8CAT(*(const i32x4*)(Qw + 64 * c), *(const i32x4*)(Qw + 64 * c + 16)); }
  i32x4 sv[2], sk0[2]; i32x2 sk1[2];
  const __amdgpu_buffer_rsrc_t rK = __builtin_amdgcn_make_buffer_rsrc((void*)Kh, 0, seq * DQ, 0x00020000), rV = __builtin_amdgcn_make_buffer_rsrc((void*)Vt, 0, seq * DVV, 0x00020000);
  const int lo16 = tid * 16, lo8 = 8192 + tid * 8;
  const int wv = v_off(tid >> 2, tid & 3), wk0 = k_off(tid / 12, tid % 12), wk1 = k_off((512 + (tid >> 1)) / 12, (512 + (tid >> 1)) % 12) + 8 * (tid & 1);
#define A8LOAD(i, k0) do { sv[i] = __builtin_amdgcn_raw_buffer_load_b128(rV, lo16, (k0) * DVV, 0); sk0[i] = __builtin_amdgcn_raw_buffer_load_b128(rK, lo16, (k0) * DQ, 0); sk1[i] = __builtin_amdgcn_raw_buffer_load_b64(rK, lo8, (k0) * DQ, 0); } while (0)
#define A8WRITE(b, i) do { *(i32x4*)(V_lds + (b) * SHM_V + wv) = sv[i]; *(i32x4*)(K_lds + (b) * SHM_K + wk0) = sk0[i]; *(i32x2*)(K_lds + (b) * SHM_K + wk1) = sk1[i]; } while (0)
#define A8WAIT() asm volatile("s_waitcnt vmcnt(3)" ::: "memory")
#define A8RESC(a) do { if (__any((a) < 1.f)) { if (hi == 0) al_l[r32] = (a); asm volatile("s_waitcnt lgkmcnt(0)" ::: "memory"); \
    _Pragma("unroll") for (int d = 0; d < 4; ++d) _Pragma("unroll") for (int r = 0; r < 16; ++r) o[d][r] *= al_l[crow(r, hi)]; } } while (0)
  f32x16 pA0, pA1, pB0, pB1; float mnA, mnB, alA, alB; i32x8 pa; const int NT = seq / KVBLK;
  A8LOAD(0, 0); asm volatile("s_waitcnt vmcnt(0)" ::: "memory"); A8WRITE(0, 0); __syncthreads();
  qkt(pA0, pA1, K_lds, qr, r32, hi); partialSM(pA0, pA1, m_reg, mnA, alA);
  A8LOAD(1, KVBLK); if (2 < NT) A8LOAD(0, 2 * KVBLK);
  A8WAIT(); A8WRITE(1, 1); __syncthreads();
  for (int j = 1; j + 1 < NT; j += 2) {
    A8BAR(); qkt(pB0, pB1, K_lds + SHM_K, qr, r32, hi);
    finishSM(pA0, pA1, alA, l_reg, pa); A8BAR();
    A8LOAD(1, (j + 2) * KVBLK); A8BAR();
    pv(o, V_lds, pa, r32, hi); partialSM(pB0, pB1, m_reg, mnB, alB);
    __syncthreads(); A8WAIT(); A8WRITE(0, 0);
    A8RESC(alB); __syncthreads();
    A8BAR(); qkt(pA0, pA1, K_lds, qr, r32, hi);
    finishSM(pB0, pB1, alB, l_reg, pa); A8BAR();
    if (j + 3 < NT) A8LOAD(0, (j + 3) * KVBLK); A8BAR();
    pv(o, V_lds + SHM_V, pa, r32, hi); partialSM(pA0, pA1, m_reg, mnA, alA);
    __syncthreads(); A8WAIT(); A8WRITE(1, 1);
    A8RESC(alA); __syncthreads();
  }
  A8BAR(); qkt(pB0, pB1, K_lds + SHM_K, qr, r32, hi);
  finishSM(pA0, pA1, alA, l_reg, pa); A8BAR();
  pv(o, V_lds, pa, r32, hi); partialSM(pB0, pB1, m_reg, mnB, alB);
  __syncthreads(); A8RESC(alB);
  finishSM(pB0, pB1, alB, l_reg, pa); A8BAR();
  pv(o, V_lds + SHM_V, pa, r32, hi);
  if (hi == 0) li_l[r32] = l_reg; asm volatile("s_waitcnt lgkmcnt(0)" ::: "memory");
  float rli[16];
#pragma unroll
  for (int r = 0; r < 16; ++r) rli[r] = __builtin_amdgcn_rcpf(li_l[crow(r, hi)]);
  LAS unsigned short* OT = (LAS unsigned short*)(lds + OT_OFF) + wid * (32 * OT_LD);
#pragma unroll
  for (int r = 0; r < 16; ++r) { const int orow = crow(r, hi);
#pragma unroll
    for (int d0 = 0; d0 < 4; ++d0) OT[orow * OT_LD + d0 * 32 + r32] = (unsigned short)f2bf(o[d0][r] * rli[r]); }
  asm volatile("s_waitcnt lgkmcnt(0)" ::: "memory");
  { const int row = lane >> 1, half = lane & 1; unsigned char* Ow = Ob + (long)(wid * QBLK + row) * LDO;
#pragma unroll
    for (int g2 = 0; g2 < 2; ++g2) { const int g = 2 * half + g2; f32x16v a, b; const LAS bf16x8* src = (const LAS bf16x8*)(OT + row * OT_LD + 32 * g);
#pragma unroll
      for (int q = 0; q < 2; ++q) { const bf16x8 va = src[q], vb = src[2 + q];
#pragma unroll
        for (int e = 0; e < 8; ++e) { a[8 * q + e] = __uint_as_float(((unsigned)(unsigned short)va[e]) << 16); b[8 * q + e] = __uint_as_float(((unsigned)(unsigned short)vb[e]) << 16); } }
      v4u lo, hi; mx6_pack(a, b, lo, hi);
      *(GAS v4u*)(Ow + 16 * g) = lo; *(GAS v4u*)(Ow + 64 + 16 * g) = hi; } }
  __syncthreads();
#undef A8LOAD
#undef A8WRITE
#undef A8WAIT
#undef A8RESC
}
}
namespace hy {
typedef float f2 __attribute__((ext_vector_type(2)));
typedef float f4 __attribute__((ext_vector_type(4)));
constexpr int NF = 16384, LH = 8192;
constexpr int FFT_LDS_F2 = 18944;
__device__ __forceinline__ int PH(int p) { return p + 2 * (p >> 4) + 16 * (p >> 9); }
__device__ constexpr float C32[16] = {1.0f, 0.98078528040323043f, 0.92387953251128674f, 0.83146961230254524f, 0.70710678118654752f, 0.55557023301960218f, 0.38268343236508978f, 0.19509032201612825f,
                                      0.0f, -0.19509032201612825f, -0.38268343236508978f, -0.55557023301960218f, -0.70710678118654752f, -0.83146961230254524f, -0.92387953251128674f, -0.98078528040323043f};
__device__ constexpr float S32[16] = {0.0f, 0.19509032201612825f, 0.38268343236508978f, 0.55557023301960218f, 0.70710678118654752f, 0.83146961230254524f, 0.92387953251128674f, 0.98078528040323043f,
                                      1.0f, 0.98078528040323043f, 0.92387953251128674f, 0.83146961230254524f, 0.70710678118654752f, 0.55557023301960218f, 0.38268343236508978f, 0.19509032201612825f};
__host__ __device__ constexpr int brev(int x, int bits) { int r = 0; for (int i = 0; i < bits; ++i) r |= ((x >> i) & 1) << (bits - 1 - i); return r; }
__device__ __forceinline__ f2 cmulf(f2 x, f2 w) { return x * (f2){w.x, w.x} + (f2){x.y, x.x} * (f2){-w.y, w.y}; }
__device__ __forceinline__ f2 cmulc(f2 x, f2 w) { return x * (f2){w.x, w.x} + (f2){x.y, x.x} * (f2){w.y, -w.y}; }
__device__ __forceinline__ f2 cmulf_rt(f2 x, f2 w) { f2 t, r;
    asm("v_pk_mul_f32 %0, %1, %2 op_sel:[0,1] op_sel_hi:[1,1] neg_hi:[0,1]" : "=v"(t) : "v"(x), "v"(w));
    asm("v_pk_fma_f32 %0, %1, %2, %3 op_sel:[0,0,1] op_sel_hi:[1,0,0]" : "=v"(r) : "v"(x), "v"(w), "v"(t)); return r; }
__device__ __forceinline__ f2 cmulc_rt(f2 x, f2 w) { f2 t, r;
    asm("v_pk_mul_f32 %0, %1, %2 op_sel:[0,1] op_sel_hi:[1,1] neg_hi:[0,1]" : "=v"(t) : "v"(x), "v"(w));
    asm("v_pk_fma_f32 %0, %1, %2, %3 op_sel:[0,0,1] op_sel_hi:[1,0,0] neg_lo:[0,0,1] neg_hi:[0,0,1]" : "=v"(r) : "v"(x), "v"(w), "v"(t)); return r; }
template <int R, bool INV, bool ZH = false> __device__ __forceinline__ void dft_r2(f2 (&x)[R]) {
    if (ZH) {
#pragma unroll
        for (int j = 0; j < R / 2; ++j) { const int ti = j * (32 / R); const f2 d = x[j];
            if (ti == 0) x[j + R / 2] = d;
            else if (ti == 8) x[j + R / 2] = INV ? (f2){-d.y, d.x} : (f2){d.y, -d.x};
            else { const f2 w = {C32[ti], S32[ti]}; x[j + R / 2] = INV ? cmulf(d, w) : cmulc(d, w); } }
    }
#pragma unroll
    for (int h = ZH ? R / 4 : R / 2; h >= 1; h >>= 1) {
#pragma unroll
        for (int s = 0; s < R; s += 2 * h) {
#pragma unroll
            for (int j = 0; j < h; ++j) {
                const int ti = j * (16 / h);
                const f2 a = x[s + j], b = x[s + j + h];
                x[s + j] = a + b;
                const f2 d = a - b;
                if (ti == 0) x[s + j + h] = d;
                else if (ti == 8) x[s + j + h] = INV ? (f2){-d.y, d.x} : (f2){d.y, -d.x};
                else { const f2 w = {C32[ti], S32[ti]}; x[s + j + h] = INV ? cmulf(d, w) : cmulc(d, w); }
            }
        }
    }
}
template <int STRIDE, bool INV, int NSTORE, bool ZH> __device__ __forceinline__ void pass32(LAS f2* X, int base, f2 w1) {
    f2 x[32];
#pragma unroll
    for (int a = 0; a < (ZH ? 16 : 32); ++a) x[a] = X[base + a * STRIDE];
    f2 pw = w1;
    if (!INV) {
        dft_r2<32, false, ZH>(x);
#pragma unroll
        for (int k = 1; k < 32; ++k) { const int i = brev(k, 5); x[i] = cmulc_rt(x[i], pw); if (k < 31) pw = cmulf_rt(pw, w1); }
#pragma unroll
        for (int k = 0; k < 32; ++k) X[base + k * STRIDE] = x[brev(k, 5)];
    } else {
#pragma unroll
        for (int k = 1; k < 32; ++k) { x[k] = cmulf_rt(x[k], pw); if (k < 31) pw = cmulf_rt(pw, w1); }
        dft_r2<32, true>(x);
#pragma unroll
        for (int k = 0; k < NSTORE; ++k) X[base + k * STRIDE] = x[brev(k, 5)];
    }
}
__device__ __forceinline__ int opaque(int v) { asm volatile("" : "+v"(v)); return v; }
struct Tw { f2 wa, wb; };
__device__ __forceinline__ Tw make_tw(int tid) { Tw t; float sn, cs; sincospif((float)tid * (2.0f / 16384.0f), &sn, &cs); t.wa = (f2){cs, sn}; sincospif((float)(tid & 15) * (2.0f / 512.0f), &sn, &cs); t.wb = (f2){cs, sn}; return t; }
template <bool ZH> __device__ __forceinline__ void fft_pass1(LAS f2* X, int tid, bool inv_, f2 wa) {
    tid = opaque(tid); asm volatile("" : "+v"(wa));
    const int base = tid + 2 * (tid >> 4);
    if (!inv_) pass32<592, false, 32, ZH>(X, base, wa); else pass32<592, true, 16, false>(X, base, wa);
}
__device__ __forceinline__ void fft_pass2(LAS f2* X, int tid, bool inv_, f2 wb) {
    tid = opaque(tid); asm volatile("" : "+v"(wb));
    const int r2 = tid & 15, blk = tid >> 4;
    const int base = blk * 592 + r2;
    if (!inv_) pass32<18, false, 32, false>(X, base, wb); else pass32<18, true, 32, false>(X, base, wb);
}
__device__ __forceinline__ void fft_pass3(LAS f2* X, int tid, const f2* __restrict__ KS) {
    tid = opaque(tid);
#pragma unroll 1
    for (int h = 0; h < 2; ++h) {
        const int q = tid + 512 * h, base = 18 * q + 16 * (q >> 5);
        f4 kv[8];
        if (KS) {
#pragma unroll
            for (int i = 0; i < 8; ++i) kv[i] = *(const f4*)(KS + q * 16 + 2 * i);
        }
        f2 x[16];
#pragma unroll
        for (int i = 0; i < 8; ++i) { const f4 v = *(const LAS f4*)(X + base + 2 * i); x[2 * i] = (f2){v.x, v.y}; x[2 * i + 1] = (f2){v.z, v.w}; }
        dft_r2<16, false>(x);
        if (!KS) {
#pragma unroll
            for (int i = 0; i < 8; ++i) { const f2 p = x[brev(2 * i, 4)], q2 = x[brev(2 * i + 1, 4)]; *(LAS f4*)(X + base + 2 * i) = (f4){p.x, p.y, q2.x, q2.y}; }
        } else {
            f2 y[16];
#pragma unroll
            for (int k = 0; k < 16; ++k) { const f2 kk = (k & 1) ? (f2){kv[k >> 1].z, kv[k >> 1].w} : (f2){kv[k >> 1].x, kv[k >> 1].y}; y[k] = cmulf_rt(x[brev(k, 4)], kk); }
            dft_r2<16, true>(y);
#pragma unroll
            for (int i = 0; i < 8; ++i) { const f2 p = y[brev(2 * i, 4)], q2 = y[brev(2 * i + 1, 4)]; *(LAS f4*)(X + base + 2 * i) = (f4){p.x, p.y, q2.x, q2.y}; }
        }
    }
}
#define HY_SYNC() __syncthreads()
__device__ __forceinline__ void fft_forward_plain(LAS f2* X, int tid, Tw tw) { fft_pass1<false>(X, tid, false, tw.wa); HY_SYNC(); fft_pass2(X, tid, false, tw.wb); HY_SYNC(); fft_pass3(X, tid, nullptr); HY_SYNC(); }
__device__ __forceinline__ void fft_conv(LAS f2* X, int tid, const f2* KS, Tw tw) {
    fft_pass1<true>(X, tid, false, tw.wa); HY_SYNC(); fft_pass2(X, tid, false, tw.wb); HY_SYNC(); fft_pass3(X, tid, KS); HY_SYNC(); fft_pass2(X, tid, true, tw.wb); HY_SYNC(); fft_pass1<false>(X, tid, true, tw.wa); HY_SYNC();
}
__device__ __forceinline__ float bf2f(unsigned short h) { return __uint_as_float(((unsigned)h) << 16); }
__device__ __forceinline__ void conv8(const unsigned short* __restrict__ p, int t0, float w0, float w1, float w2, float cb, float (&o)[8]) {
    const bf16x8 v = *(const bf16x8*)(p + t0);
    float x[10];
    x[0] = t0 > 0 ? bf2f(p[t0 - 1]) : 0.f; x[9] = (t0 + 8 < LH) ? bf2f(p[t0 + 8]) : 0.f;
#pragma unroll
    for (int i = 0; i < 8; ++i) x[i + 1] = bf2f((unsigned short)v[i]);
#pragma unroll
    for (int i = 0; i < 8; ++i) o[i] = w0 * x[i] + w1 * x[i + 1] + w2 * x[i + 2] + cb;
}
__device__ __forceinline__ void zero_upper(LAS f2* X, int tid) {
    LAS f4* z = (LAS f4*)(X + 9472);
    for (int i = tid; i < (FFT_LDS_F2 - 9472) / 2; i += 512) z[i] = (f4){0.f, 0.f, 0.f, 0.f};
}
__device__ __forceinline__ void hyena_channel(LAS f2* X, int tid, int c, const unsigned short* __restrict__ HyT, const unsigned short* __restrict__ FiltT, const float* __restrict__ convw, const float* __restrict__ convb,
                                              const float* __restrict__ hbias, f2* KSb, unsigned short* __restrict__ YT, Tw tw) {
    tid = opaque(tid);
    {
        const unsigned short* f00 = FiltT + (size_t)(0 * 4096 + 0 * 2048 + c) * LH; const unsigned short* f01 = FiltT + (size_t)(0 * 4096 + 1 * 2048 + c) * LH;
        const unsigned short* f10 = FiltT + (size_t)(1 * 4096 + 0 * 2048 + c) * LH; const unsigned short* f11 = FiltT + (size_t)(1 * 4096 + 1 * 2048 + c) * LH;
#pragma unroll 1
        for (int i = 0; i < 4; ++i) {
            const int t0 = 4 * (tid + 512 * i);
            typedef unsigned short u16x4 __attribute__((ext_vector_type(4)));
            const u16x4 ra = *(const u16x4*)(f00 + t0), rb = *(const u16x4*)(f01 + t0), rc = *(const u16x4*)(f10 + t0), rd = *(const u16x4*)(f11 + t0);
            const f4 a = {bf2f(ra.x), bf2f(ra.y), bf2f(ra.z), bf2f(ra.w)}, b = {bf2f(rb.x), bf2f(rb.y), bf2f(rb.z), bf2f(rb.w)}, cc = {bf2f(rc.x), bf2f(rc.y), bf2f(rc.z), bf2f(rc.w)}, d = {bf2f(rd.x), bf2f(rd.y), bf2f(rd.z), bf2f(rd.w)};
            const int e0 = PH(t0);
            *(LAS f4*)(X + e0) = (f4){a.x, b.x, a.y, b.y}; *(LAS f4*)(X + e0 + 2) = (f4){a.z, b.z, a.w, b.w};
            if (t0 == 0) X[PH(LH)] = (f2){0.f, 0.f}; else X[PH(NF - t0)] = (f2){cc.x, d.x};
            X[PH(NF - t0 - 1)] = (f2){cc.y, d.y}; X[PH(NF - t0 - 2)] = (f2){cc.z, d.z}; X[PH(NF - t0 - 3)] = (f2){cc.w, d.w};
        }
    }
    HY_SYNC();
    fft_forward_plain(X, tid, tw);
    tid = opaque(tid);
    {
        const float b1 = hbias[c], b2 = hbias[2048 + c]; const float sc = 1.0f / (float)NF;
#pragma unroll 4
        for (int i = 0; i < 32; ++i) {
            const int P = tid + 512 * i; const int k = (P >> 9) + 32 * ((P >> 4) & 31) + 1024 * (P & 15); const int kn = (NF - k) & (NF - 1);
            const int Pn = (kn & 31) * 512 + ((kn >> 5) & 31) * 16 + (kn >> 10);
            const f2 z = X[PH(P)], zn = X[PH(Pn)];
            KSb[P] = (f2){(0.5f * (z.x + zn.x) + b1) * sc, 0.5f * (z.y - zn.y) * sc};
            KSb[NF + P] = (f2){(0.5f * (z.y + zn.y) + b2) * sc, -0.5f * (z.x - zn.x) * sc};
        }
    }
    asm volatile("s_waitcnt vmcnt(0)" ::: "memory");
    HY_SYNC();
    tid = opaque(tid);
    const unsigned short* pv = HyT + (size_t)c * NF; const unsigned short* px1 = HyT + (size_t)(2048 + c) * NF; const unsigned short* px2 = HyT + (size_t)(4096 + c) * NF;
    {
        const float w0 = convw[c], w1 = convw[6144 + c], w2 = convw[2 * 6144 + c], cb = convb[c];
#pragma unroll 1
        for (int i = 0; i < 2; ++i) { const int t0 = 8 * (tid + 512 * i); float a[8], b[8]; conv8(pv, t0, w0, w1, w2, cb, a); conv8(pv + LH, t0, w0, w1, w2, cb, b);
            const int e0 = PH(t0);
#pragma unroll
            for (int j = 0; j < 4; ++j) *(LAS f4*)(X + e0 + 2 * j) = (f4){a[2 * j], b[2 * j], a[2 * j + 1], b[2 * j + 1]}; }
    }
    HY_SYNC();
    fft_conv(X, tid, KSb, tw);
    tid = opaque(tid);
    {
        const float w0 = convw[2048 + c], w1 = convw[6144 + 2048 + c], w2 = convw[2 * 6144 + 2048 + c], cb = convb[2048 + c];
#pragma unroll 1
        for (int i = 0; i < 2; ++i) { const int t0 = 8 * (tid + 512 * i); float a[8], b[8]; conv8(px1, t0, w0, w1, w2, cb, a); conv8(px1 + LH, t0, w0, w1, w2, cb, b);
            const int e0 = PH(t0);
#pragma unroll
            for (int j = 0; j < 4; ++j) { const f4 y = *(const LAS f4*)(X + e0 + 2 * j); *(LAS f4*)(X + e0 + 2 * j) = (f4){a[2 * j] * y.x, b[2 * j] * y.y, a[2 * j + 1] * y.z, b[2 * j + 1] * y.w}; } }
    }
    HY_SYNC();
    fft_conv(X, tid, KSb + NF, tw);
    tid = opaque(tid);
    {
        const float w0 = convw[4096 + c], w1 = convw[6144 + 4096 + c], w2 = convw[2 * 6144 + 4096 + c], cb = convb[4096 + c];
        unsigned short* yo = YT + (size_t)c * NF;
#pragma unroll 1
        for (int i = 0; i < 2; ++i) { const int t0 = 8 * (tid + 512 * i); float a[8], b[8]; conv8(px2, t0, w0, w1, w2, cb, a); conv8(px2 + LH, t0, w0, w1, w2, cb, b);
            const int e0 = PH(t0); float ya[8], yb[8];
#pragma unroll
            for (int j = 0; j < 4; ++j) { const f4 y = *(const LAS f4*)(X + e0 + 2 * j); ya[2 * j] = a[2 * j] * y.x; yb[2 * j] = b[2 * j] * y.y; ya[2 * j + 1] = a[2 * j + 1] * y.z; yb[2 * j + 1] = b[2 * j + 1] * y.w; }
            v4u wa, wb; wa.x = pg8::cvt_pk_bf16(ya[0], ya[1]); wa.y = pg8::cvt_pk_bf16(ya[2], ya[3]); wa.z = pg8::cvt_pk_bf16(ya[4], ya[5]); wa.w = pg8::cvt_pk_bf16(ya[6], ya[7]);
            wb.x = pg8::cvt_pk_bf16(yb[0], yb[1]); wb.y = pg8::cvt_pk_bf16(yb[2], yb[3]); wb.z = pg8::cvt_pk_bf16(yb[4], yb[5]); wb.w = pg8::cvt_pk_bf16(yb[6], yb[7]);
            *(v4u*)(yo + t0) = wa; *(v4u*)(yo + LH + t0) = wb; }
    }
    HY_SYNC();
}
}
constexpr int NWAVES = 8;
#ifndef MK_N_LAUNCHES
#define MK_N_LAUNCHES 1
#endif
constexpr int N_PHASES = 10;
#ifndef DUP_ID
#define DUP_ID -1
#endif
#define REP(id) _Pragma("unroll 1") for (int rep_ = 0; rep_ < ((DUP_ID == (id) || DUP_ID == 200 + (id)) ? 2 : 1); ++rep_) if ((rep_ == 1 && DUP_ID >= 200) ? (xcd_barrier(bar), true) : true)
constexpr int N_LAUNCHES = MK_N_LAUNCHES;
constexpr int DM = 4096, NB = 2, SEQ = 8192, MTOK = NB * SEQ, LCTX = 256, MCTX = NB * LCTX, MALL = MTOK + MCTX;
constexpr int HYW = 2048, HYC = 6144, QLORA = 1024, KVLORA = 512, INC = 7744, INP = 7936, NMODC = 24576;
constexpr int NHEAD = 16, DQK = 192, FF = 16384, SKEYS = LCTX + SEQ;
constexpr float EPS = 1e-6f;
constexpr int MIXLD = 3072;
constexpr float WQBSCALE = 32.f, WKVBSCALE = 16.f, W1SCALE = 64.f, W2SCALE = 128.f, WINSCALE = 64.f, WOSCALE = 64.f;
constexpr size_t MiB = 1u << 20;
constexpr size_t WS_CTL = 0, CTL_ZERO_BYTES = 1 * MiB;
constexpr size_t WS_MODP = 1 * MiB;
constexpr size_t WS_MODS = 3 * MiB;
constexpr size_t WS_TW1 = 4 * MiB, WS_TW2 = 5 * MiB;
constexpr size_t WS_WOUT = 8 * MiB, WS_W1 = 40 * MiB, WS_W2 = 168 * MiB, WS_WIN = 296 * MiB, WS_WQB = 358 * MiB, WS_WKVB = 364 * MiB, WS_HH = 368 * MiB;
constexpr size_t WS_FILT = 370 * MiB, WS_H = 626 * MiB, WS_HYT = 758 * MiB, WS_QA = 950 * MiB, WS_KVA = 982 * MiB, WS_KR = 999 * MiB, WS_QRAW = 1004 * MiB, WS_KVRAW = 1100 * MiB;
constexpr size_t WS_H8 = WS_QRAW, WS_WIN8 = WS_KVRAW;
constexpr size_t WS_YT = 1232 * MiB, WS_KS = 1296 * MiB, WS_END0 = 1360 * MiB;
constexpr size_t WS_QB = 370 * MiB, WS_KB = 466 * MiB, WS_VB = 565 * MiB, WS_MIX = 631 * MiB;
constexpr size_t WS_H2 = 760 * MiB;
constexpr size_t WS_HID = 900 * MiB, WS_END = 1412 * MiB;
static_assert(WS_MIX + (size_t)MTOK * DM * 2 <= WS_H2 && WS_H2 + (size_t)MTOK * DM * 2 <= WS_HID && WS_VB + (size_t)NB * NHEAD * SKEYS * 128 * 2 <= WS_MIX && WS_KB + (size_t)NB * NHEAD * SKEYS * 192 * 2 <= WS_VB, "d_ws map");
constexpr int CW_TMO = 0, CW_BAR = 4096;
constexpr int LDS_BYTES = 163840, MISC_OFF = 159744;

struct Args { const float* in[27]; float* out; unsigned char* ws; int ph_lo, ph_hi, li, pad; };
typedef const __attribute__((address_space(4))) Args CArgs;

__device__ __forceinline__ float wave_sum(float v) {
#define WS_SWZ(X) v += __int_as_float(__builtin_amdgcn_ds_swizzle(__float_as_int(v), ((X) << 10) | 0x1f))
    WS_SWZ(1); WS_SWZ(2); WS_SWZ(4); WS_SWZ(8); WS_SWZ(16);
#undef WS_SWZ
    { auto rr = __builtin_amdgcn_permlane32_swap(__float_as_uint(v), __float_as_uint(v), false, false); v = __uint_as_float(rr[0]) + __uint_as_float(rr[1]); }
    return v;
}
__device__ __forceinline__ float bf2f(unsigned short h) { return __uint_as_float(((unsigned)h) << 16); }
__device__ __forceinline__ void p0_transpose_item(const float* W, int K, int N, bf16* WT, int row_off, const float* kscale, LAS float* scr, int item, int lane, int ldw = 0, int kofs = 0) {
    const int nblk = N / 32, kb = item / nblk, nb = item % nblk, k0 = 64 * kb, n0 = 32 * nb;
#pragma unroll 8
    for (int i = 0; i < 32; ++i) { const int kk = 2 * i + (lane >> 5); float v = W[(size_t)(k0 + kk) * N + n0 + (lane & 31)]; if (kscale) v *= kscale[k0 + kk]; scr[kk * 33 + (lane & 31)] = v; }
    LDS_WAIT(); asm volatile("" ::: "memory");
    const int c = lane & 7;
#pragma unroll
    for (int j = 0; j < 4; ++j) { const int n = (lane >> 3) + 8 * j; const LAS float* s = scr + (8 * c) * 33 + n;
        v4u o; o.x = pk2(s[0 * 33], s[1 * 33]); o.y = pk2(s[2 * 33], s[3 * 33]); o.z = pk2(s[4 * 33], s[5 * 33]); o.w = pk2(s[6 * 33], s[7 * 33]);
        *(GAS v4u*)(WT + (size_t)(row_off + n0 + n) * (ldw ? ldw : K) + (k0 - kofs) + 8 * c) = o; }
    LDS_WAIT(); asm volatile("" ::: "memory");
}
__device__ __forceinline__ void p0_transpose_item_f8(const float* W, int K, int N, unsigned char* WT, float wscale, LAS float* scr, int item, int lane, int ldw = 0, int kofs = 0, const float* kscale = nullptr) {
    const int nblk = N / 32, kb = item / nblk, nb = item % nblk, k0 = 64 * kb, n0 = 32 * nb;
#pragma unroll 8
    for (int i = 0; i < 32; ++i) { const int kk = 2 * i + (lane >> 5); float v = W[(size_t)(k0 + kk) * N + n0 + (lane & 31)] * wscale; if (kscale) v *= kscale[k0 + kk]; scr[kk * 33 + (lane & 31)] = v; }
    LDS_WAIT(); asm volatile("" ::: "memory");
    const int c = lane & 3;
#pragma unroll
    for (int j = 0; j < 2; ++j) { const int n = (lane >> 2) + 16 * j; const LAS float* s = scr + (16 * c) * 33 + n;
        v4u o;
        o.x = pg8::pack4_fp8(fmaxf(s[0 * 33], -448.f), fmaxf(s[1 * 33], -448.f), fmaxf(s[2 * 33], -448.f), fmaxf(s[3 * 33], -448.f));
        o.y = pg8::pack4_fp8(fmaxf(s[4 * 33], -448.f), fmaxf(s[5 * 33], -448.f), fmaxf(s[6 * 33], -448.f), fmaxf(s[7 * 33], -448.f));
        o.z = pg8::pack4_fp8(fmaxf(s[8 * 33], -448.f), fmaxf(s[9 * 33], -448.f), fmaxf(s[10 * 33], -448.f), fmaxf(s[11 * 33], -448.f));
        o.w = pg8::pack4_fp8(fmaxf(s[12 * 33], -448.f), fmaxf(s[13 * 33], -448.f), fmaxf(s[14 * 33], -448.f), fmaxf(s[15 * 33], -448.f));
        *(GAS v4u*)(WT + (size_t)(n0 + n) * (ldw ? ldw : K) + (k0 - kofs) + 16 * c) = o; }
    LDS_WAIT(); asm volatile("" ::: "memory");
}
__device__ __forceinline__ unsigned f8pack(float a, float b, float c, float d) { return pg8::pack4_fp8(fmaxf(a, -448.f), fmaxf(b, -448.f), fmaxf(c, -448.f), fmaxf(d, -448.f)); }
__device__ __forceinline__ void p0_transpose_item_mx6(const float* W, int K, int N, unsigned char* WT, LAS float* scr, int item, int lane, int ldw = 0  , int kofs = 0) {
    const int nblk = N / 32, kb = item / nblk, nb = item % nblk, k0 = 64 * kb, n0 = 32 * nb;
#pragma unroll 8
    for (int i = 0; i < 32; ++i) { const int kk = 2 * i + (lane >> 5); scr[kk * 33 + (lane & 31)] = W[(size_t)(k0 + kk) * N + n0 + (lane & 31)]; }
    LDS_WAIT(); asm volatile("" ::: "memory");
    const int n = lane & 31, bl = lane >> 5; const LAS float* sp = scr + (32 * bl) * 33 + n;
    f32x16v a, b;
#pragma unroll
    for (int i = 0; i < 16; ++i) { a[i] = sp[i * 33]; b[i] = sp[(16 + i) * 33]; }
    v4u lo, hi; mx6_pack(a, b, lo, hi);
    unsigned char* d = WT + (size_t)(n0 + n) * (ldw ? ldw : K) + mx6_off(((k0 - kofs) >> 5) + bl);
    *(GAS v4u*)d = lo; *(GAS v4u*)(d + 64) = hi;
    LDS_WAIT(); asm volatile("" ::: "memory");
}
__device__ __forceinline__ void modulate_row_mx6(const float* xrow, unsigned char* orow, const LAS float* g, const LAS float* sh, const LAS float* sc, int lane) {
    asm volatile("" : "+v"(lane));
    f32x4 v[2][8]; float s = 0.f;
#pragma unroll
    for (int j = 0; j < 2; ++j)
#pragma unroll
        for (int q = 0; q < 8; ++q) { v[j][q] = *(const GAS f32x4*)(xrow + 32 * (lane + 64 * j) + 4 * q); s += (v[j][q].x * v[j][q].x + v[j][q].y * v[j][q].y) + (v[j][q].z * v[j][q].z + v[j][q].w * v[j][q].w); }
    const float rstd = 1.0f / sqrtf(wave_sum(s) * (1.f / DM) + EPS);
#pragma unroll
    for (int j = 0; j < 2; ++j) { const int blk = lane + 64 * j, c0 = 32 * blk; f32x16v a, b;
#pragma unroll
        for (int q = 0; q < 8; ++q) { const f32x4 gg = *(const LAS f32x4*)(g + c0 + 4 * q), hh = *(const LAS f32x4*)(sh + c0 + 4 * q), cc = *(const LAS f32x4*)(sc + c0 + 4 * q);
            const f32x4 y = (v[j][q] * rstd * gg) * (cc + 1.0f) + hh;
            if (q < 4) { a[4 * q] = y.x; a[4 * q + 1] = y.y; a[4 * q + 2] = y.z; a[4 * q + 3] = y.w; } else { b[4 * q - 16] = y.x; b[4 * q - 15] = y.y; b[4 * q - 14] = y.z; b[4 * q - 13] = y.w; } }
        v4u lo, hi; mx6_pack(a, b, lo, hi);
        unsigned char* d = orow + mx6_off(blk); *(GAS v4u*)d = lo; *(GAS v4u*)(d + 64) = hi;
        asm volatile("" ::: "memory"); }
}
template <int F8  > __device__ __forceinline__ void modulate_row(const float* xrow, void* orow, void* orow8, const LAS float* g, const LAS float* sh, const LAS float* sc, int lane) {
    asm volatile("" : "+v"(lane));
    const GAS f32x4* xr = (const GAS f32x4*)xrow + lane;
    f32x4 v[16]; float s = 0.f;
#pragma unroll
    for (int j = 0; j < 16; ++j) { v[j] = xr[64 * j]; s += (v[j].x * v[j].x + v[j].y * v[j].y) + (v[j].z * v[j].z + v[j].w * v[j].w); }
    const float rstd = 1.0f / sqrtf(wave_sum(s) * (1.f / DM) + EPS);
    GAS unsigned long long* o8 = (GAS unsigned long long*)orow + lane; GAS unsigned* o4 = (GAS unsigned*)(F8 == 2 ? orow8 : orow) + lane;
#pragma unroll
    for (int j = 0; j < 16; ++j) { const int c0 = 4 * (lane + 64 * j); const f32x4 gg = *(const LAS f32x4*)(g + c0), hh = *(const LAS f32x4*)(sh + c0), cc = *(const LAS f32x4*)(sc + c0);
        const f32x4 y = (v[j] * rstd * gg) * (cc + 1.0f) + hh;
        if (F8 != 0) o4[64 * j] = pg8::pack4_fp8(fmaxf(y.x, -448.f), fmaxf(y.y, -448.f), fmaxf(y.z, -448.f), fmaxf(y.w, -448.f));
        if (F8 != 1) o8[64 * j] = (unsigned long long)pk2(y.x, y.y) | ((unsigned long long)pk2(y.z, y.w) << 32);
        if (j & 1) asm volatile("" ::: "memory"); }
}

__global__ void __launch_bounds__(NWAVES * 64, 2) mega_fwd(Args args) {
    extern __shared__ __attribute__((aligned(16))) unsigned char lds_raw[];
    LAS unsigned char* lds = (LAS unsigned char*)lds_raw;
    volatile LAS unsigned* MISC = (volatile LAS unsigned*)(lds + MISC_OFF);
#define PHASE_IDS() const CArgs* ap = (const CArgs*)__builtin_amdgcn_kernarg_segment_ptr(); asm volatile("" : "+s"(ap)); unsigned char* ws = ap->ws; const int tid = hy::opaque((int)threadIdx.x), lane = tid & 63, wave = __builtin_amdgcn_readfirstlane(tid >> 6), gw = vcu * NWAVES + wave, NGW = G * NWAVES; (void)lane; (void)gw; (void)NGW
    const int G = gridDim.x; const int bx = blockIdx.x; const int vcu = (G % 8 == 0) ? (bx % 8) * (G / 8) + bx / 8 : bx;
    gu32* ctl = (gu32*)(args.ws + WS_CTL);
#define x_in ((const float*)ap->in[0])
#define cvec ((const float*)ap->in[1])
#define ctx ((const float*)ap->in[2])
#define c_ctx ((const float*)ap->in[3])
#define norm1_g ((const float*)ap->in[4])
#define norm2_g ((const float*)ap->in[5])
#define w_ada ((const float*)ap->in[6])
#define b_ada ((const float*)ap->in[7])
#define w_in ((const float*)ap->in[8])
#define hy_conv_w ((const float*)ap->in[9])
#define hy_conv_b ((const float*)ap->in[10])
#define hy_w1 ((const float*)ap->in[11])
#define hy_b1 ((const float*)ap->in[12])
#define hy_w2 ((const float*)ap->in[13])
#define hy_b2 ((const float*)ap->in[14])
#define hy_w3 ((const float*)ap->in[15])
#define hy_freq ((const float*)ap->in[16])
#define hy_bias ((const float*)ap->in[17])
#define g_qa ((const float*)ap->in[18])
#define w_qb ((const float*)ap->in[19])
#define g_kva ((const float*)ap->in[20])
#define w_kvb ((const float*)ap->in[21])
#define q_norm_g ((const float*)ap->in[22])
#define k_norm_g ((const float*)ap->in[23])
#define w_out ((const float*)ap->in[24])
#define w_mlp1 ((const float*)ap->in[25])
#define w_mlp2 ((const float*)ap->in[26])
#define out_p (ap->out)
#define MODP ((float*)(ws + WS_MODP))
#define MODS ((float*)(ws + WS_MODS))
#define TW1 ((hy::f2*)(ws + WS_TW1))
#define TW2 ((hy::f2*)(ws + WS_TW2))
#define W1T ((bf16*)(ws + WS_W1))
#define W2T ((bf16*)(ws + WS_W2))
#define WinT ((bf16*)(ws + WS_WIN))
#define WinT8 ((unsigned char*)(ws + WS_WIN8))
#define H8 ((unsigned char*)(ws + WS_H8))
#define WqbT ((bf16*)(ws + WS_WQB))
#define WkvbT ((bf16*)(ws + WS_WKVB))
#define Hh ((float*)(ws + WS_HH))
#define FiltT ((float*)(ws + WS_FILT))
#define Hb ((bf16*)(ws + WS_H))
#define HyT ((bf16*)(ws + WS_HYT))
#define QA ((bf16*)(ws + WS_QA))
#define KVA ((bf16*)(ws + WS_KVA))
#define KR ((float*)(ws + WS_KR))
#define Qraw ((bf16*)(ws + WS_QRAW))
#define KVraw ((bf16*)(ws + WS_KVRAW))
#define YT ((bf16*)(ws + WS_YT))
#define KSall ((hy::f2*)(ws + WS_KS))
#define Qb ((bf16*)(ws + WS_QB))
#define Kb ((bf16*)(ws + WS_KB))
#define Vb ((bf16*)(ws + WS_VB))
#define MIX ((bf16*)(ws + WS_MIX))
#define WoutT ((bf16*)(ws + WS_WOUT))
#define H2 ((bf16*)(ws + WS_H2))
#define HID ((bf16*)(ws + WS_HID))
    for (int u = hy::opaque((int)threadIdx.x); u < (LDS_BYTES - MISC_OFF) / 4; u += NWAVES * 64) ((LAS unsigned*)(lds + MISC_OFF))[u] = 0u;
    __syncthreads();
    XcdBarrier bar; bar.bar = (unsigned*)(ctl + CW_BAR); bar.x = 0; bar.st = nullptr;
    if (N_LAUNCHES == 1) bar = xcd_barrier_post((unsigned*)(ctl + CW_BAR), MISC + 8);
#define GRID_BAR() do { if (N_LAUNCHES == 1) xcd_barrier(bar); } while (0)
    const int lo = args.ph_lo, hi = args.ph_hi;
#ifndef PH_MASK
#define PH_MASK 0x3ff
#endif
#define IN(k) (((PH_MASK >> (k)) & 1) && lo <= (k) && (k) < hi)
#define BOTH(k) (IN(k) && IN((k) + 1))

    if (IN(0)) {
        PHASE_IDS();
        REP(0) {
            LAS float* scr = (LAS float*)(lds + wave * 16384);
            constexpr int I_IN = (DM / 64) * (INC / 32), I_QB = (QLORA / 64) * (3072 / 32), I_KVB = (KVLORA / 64) * (4096 / 32), I_O = (DM / 64) * (DM / 32), I_1 = (DM / 64) * (FF / 32), I_2 = (FF / 64) * (DM / 32);
            constexpr int NITEMS = I_IN + I_QB + I_KVB + I_O + I_1 + I_2;
            for (int it = gw; it < NITEMS; it += NGW) {
                int r = it;
                if (r < I_IN) { const int n0 = 32 * (r % (INC / 32));
                    if (n0 < HYC) p0_transpose_item(w_in, DM, INC, WinT, 0, nullptr, scr, r, lane); else p0_transpose_item_f8(w_in, DM, INC, WinT8, WINSCALE, scr, r, lane); continue; } r -= I_IN;
                if (r < I_QB) { p0_transpose_item_f8(w_qb, QLORA, 3072, (unsigned char*)WqbT, WQBSCALE, scr, r, lane, 0, 0, g_qa); continue; } r -= I_QB;
                if (r < I_KVB) { p0_transpose_item_f8(w_kvb, KVLORA, 4096, (unsigned char*)WkvbT, WKVBSCALE, scr, r, lane, 0, 0, g_kva); continue; } r -= I_KVB;
                if (r < I_O) { if (64 * (r / (DM / 32)) < HYW) p0_transpose_item(w_out, DM, DM, WoutT, 0, nullptr, scr, r, lane, MIXLD, 0);
                                else p0_transpose_item_mx6(w_out, DM, DM, (unsigned char*)WoutT + 2 * HYW, scr, r, lane, 2 * MIXLD, HYW); continue; } r -= I_O;
                if (r < I_1) { p0_transpose_item_mx6(w_mlp1, DM, FF, (unsigned char*)W1T, scr, r, lane); continue; } r -= I_1;
                p0_transpose_item_f8(w_mlp2, FF, DM, (unsigned char*)W2T, W2SCALE, scr, r, lane);
            }
            { GAS v4u* z = (GAS v4u*)(WinT8 + (size_t)INC * DM); const size_t n16 = (size_t)(INP - INC) * DM / 16;
              for (size_t i = (size_t)vcu * 512 + tid; i < n16; i += (size_t)G * 512) z[i] = (v4u){0u, 0u, 0u, 0u}; }
        }
        __syncthreads();
        REP(1) {
            LAS float* S = (LAS float*)lds;
            LAS float* RED = (LAS float*)(lds + 49152);
            for (int i = tid; i < 3 * DM; i += 512) { const float v = i < 2 * DM ? cvec[i] : c_ctx[i - 2 * DM]; S[i] = v / (1.0f + __expf(-v)); }
            __syncthreads();
            for (int it = vcu; it < 192 * 4; it += G) {
                const int cb = it % 192, ks = it / 192, col = cb * 128 + 2 * lane, kbeg = ks * 1024;
                float a0 = 0, a1 = 0, b0 = 0, b1 = 0, c0 = 0, c1 = 0;
#pragma unroll 8
                for (int i = 0; i < 128; ++i) { const int k = kbeg + wave + 8 * i; const float2 w = *(const float2*)(w_ada + (size_t)k * NMODC + col);
                    const float s0 = S[k], s1 = S[DM + k], s2 = S[2 * DM + k];
                    a0 += s0 * w.x; a1 += s0 * w.y; b0 += s1 * w.x; b1 += s1 * w.y; c0 += s2 * w.x; c1 += s2 * w.y; }
                LAS float* rw = RED + wave * 384;
                rw[2 * lane] = a0; rw[2 * lane + 1] = a1; rw[128 + 2 * lane] = b0; rw[128 + 2 * lane + 1] = b1; rw[256 + 2 * lane] = c0; rw[256 + 2 * lane + 1] = c1;
                __syncthreads();
                if (tid < 384) { float s = 0.f;
#pragma unroll
                    for (int w = 0; w < 8; ++w) s += RED[w * 384 + tid];
                    const int r = tid >> 7, cc = tid & 127; MODP[(size_t)(ks * 3 + r) * NMODC + cb * 128 + cc] = s; }
                __syncthreads();
            }
        }
        REP(2) {
            LAS float* FE = (LAS float*)lds;
            LAS float* H1 = (LAS float*)(lds + 2048);
            const int tl = tid >> 6, j = tid & 63;
            for (int it = vcu; it < SEQ / 8; it += G) {
                const int t = it * 8 + tl;
                if (j < 33) { float f;
                    if (j == 0) f = (float)t / (float)(SEQ - 1);
                    else { const int bi = (j - 1) & 15; const float band = 1e-4f + (float)bi * ((15.0f - 1e-4f) / 15.0f); const float ang = ((float)(2.0 * 3.14159265358979323846 / SEQ) * (float)t) * band; f = (j <= 16) ? cosf(ang) : -sinf(ang); }
                    FE[tl * 33 + j] = f; }
                __syncthreads();
                { float a = hy_b1[j];
#pragma unroll 11
                  for (int i = 0; i < 33; ++i) a += FE[tl * 33 + i] * hy_w1[i * 64 + j];
                  H1[tl * 64 + j] = sinf(hy_freq[j] * a); }
                __syncthreads();
                { float a = hy_b2[j];
#pragma unroll 8
                  for (int i = 0; i < 64; ++i) a += H1[tl * 64 + i] * hy_w2[i * 64 + j];
                  ((unsigned short*)Hh)[(size_t)t * 64 + j] = (unsigned short)f2bf(sinf(hy_freq[j] * a)); }
                __syncthreads();
            }
        }
        if (BOTH(0)) GRID_BAR();
    }

    if (IN(1)) {
        PHASE_IDS();
        REP(10) {
            LAS float* SH = (LAS float*)lds;
            LAS float* SC = (LAS float*)(lds + 49152);
            LAS float* GN = (LAS float*)(lds + 98304);
            for (int i = tid; i < 3 * 2 * DM; i += 512) { const int r = i / (2 * DM), col = i % (2 * DM);
                float s = b_ada[col];
#pragma unroll
                for (int ks = 0; ks < 4; ++ks) s += MODP[(size_t)(ks * 3 + r) * NMODC + col];
                if (col < DM) SH[r * DM + col] = s; else SC[r * DM + col - DM] = s; }
            for (int i = tid; i < DM; i += 512) GN[i] = norm1_g[i];
            for (int i = vcu * 512 + tid; i < 3 * NMODC; i += G * 512) { const int r = i / NMODC, col = i % NMODC;
                float s = b_ada[col];
#pragma unroll
                for (int ks = 0; ks < 4; ++ks) s += MODP[(size_t)(ks * 3 + r) * NMODC + col];
                MODS[i] = s; }
            __syncthreads();
            for (int m = gw; m < MALL; m += NGW) {
                const int r = m < MTOK ? m / SEQ : 2;
                const float* src = m < MTOK ? x_in + (size_t)m * DM : ctx + (size_t)(m - MTOK) * DM;
                modulate_row<2>(src, Hb + (size_t)m * DM, H8 + (size_t)m * DM, GN, SH + r * DM, SC + r * DM, lane);
            }
            __syncthreads();
        }
        REP(11) {
            typedef float f32x16 __attribute__((ext_vector_type(16)));
            typedef short s16x8 __attribute__((ext_vector_type(8)));
            const int cb = vcu & 127, col0 = cb * 64, l31 = lane & 31, kh = lane >> 5;
            s16x8 af[2][4];
#pragma unroll
            for (int tl = 0; tl < 2; ++tl)
#pragma unroll
                for (int kk = 0; kk < 4; ++kk)
#pragma unroll
                    for (int e = 0; e < 8; ++e) af[tl][kk][e] = (short)f2bf(hy_w3[(size_t)(16 * kk + 8 * kh + e) * 8192 + col0 + 32 * tl + l31]);
            const unsigned short* HhB = (const unsigned short*)Hh;
            for (int tb = vcu >> 7; tb < 8; tb += (G >> 7)) {
                const int t0w = tb * 1024 + wave * 128 + 4 * l31;
                s16x8 bfr[4][4];
#pragma unroll
                for (int i = 0; i < 4; ++i)
#pragma unroll
                    for (int kk = 0; kk < 4; ++kk) bfr[i][kk] = *(const s16x8*)(HhB + (size_t)(t0w + i) * 64 + 16 * kk + 8 * kh);
#pragma unroll
                for (int tl = 0; tl < 2; ++tl) {
                    f32x16 acc[4];
#pragma unroll
                    for (int i = 0; i < 4; ++i) { acc[i] = (f32x16){};
#pragma unroll
                        for (int kk = 0; kk < 4; ++kk) acc[i] = __builtin_amdgcn_mfma_f32_32x32x16_bf16(af[tl][kk], bfr[i][kk], acc[i], 0, 0, 0); }
#pragma unroll
                    for (int r = 0; r < 16; ++r) { const int col = hy::opaque(col0 + 32 * tl + 4 * kh) + (r & 3) + 8 * (r >> 2), c = col & 2047;
                        const float a0 = -3.0701134573253944f, a1 = -15.350567286626972f; const float delta = fabsf(a0 + (float)c * ((a1 - a0) / 2047.0f));
                        const float dl = delta * (1.4426950408889634f / (float)(SEQ - 1));
                        const float e1 = __builtin_amdgcn_exp2f(-dl), E0 = __builtin_amdgcn_exp2f(-(float)t0w * dl), E1 = E0 * e1, E2 = E1 * e1, E3 = E2 * e1;
                        uint2 w; w.x = pg8::cvt_pk_bf16(acc[0][r] * E0, acc[1][r] * E1); w.y = pg8::cvt_pk_bf16(acc[2][r] * E2, acc[3][r] * E3);
                        *(uint2*)((bf16*)FiltT + (size_t)col * SEQ + t0w) = w; if ((r & 3) == 3) __builtin_amdgcn_sched_barrier(0); }
                    __builtin_amdgcn_sched_barrier(0);
                }
            }
        }
        if (BOTH(1)) GRID_BAR();
        if (DUP_ID == 103) { for (int i = 0; i < 20; ++i) GRID_BAR(); }
    }

    if (IN(2)) {
        PHASE_IDS();
        REP(20) { pg8::Gemm g{WinT, Hb, HYC, MTOK, DM}; pg8::StaticOrder S; S.init(HYC, MTOK, G, bx); pg8::EpiBf16A<0> E{HyT, MTOK, 1.0f};
          pg8::gemm_phase<pg8::EpiBf16A<0>, pg8::StaticOrder, PG8_ALIGN, PG8_SP2>(lds, g, S, E); }
        REP(21) { pg8::Gemm g{(const bf16*)H8, (const bf16*)(WinT8 + (size_t)HYC * DM), MALL, INP - HYC, DM / 2}; pg8::AttProjOrder S{G, bx}; pg8::EpiAttProj E{(unsigned char*)QA, (unsigned char*)KVA, KR, 1.0f / WINSCALE};
          pg8::gemm_phase<pg8::EpiAttProj, pg8::AttProjOrder, PG8_ALIGN, PG8_SP2F8, 1>(lds, g, S, E); }
        if (BOTH(2)) GRID_BAR();
    }

    if (IN(3)) {
        PHASE_IDS();
        REP(30) { pg8::Gemm g{QA, WqbT, MTOK, 3072, QLORA / 2}; pg8::StaticOrder S; S.init(MTOK, 3072, G, bx); pg8::EpiF8A E{(unsigned char*)Qraw, 3072, 1.0f / WQBSCALE};
          pg8::gemm_phase<pg8::EpiF8A, pg8::StaticOrder, PG8_ALIGN, PG8_SP2F8, 1>(lds, g, S, E); }
        REP(31) { pg8::Gemm g{KVA, WkvbT, MALL, 4096, KVLORA / 2}; pg8::StaticOrder S; S.init(MALL, 4096, G, bx); pg8::EpiF8A E{(unsigned char*)KVraw, 4096, 1.0f / WKVBSCALE};
          pg8::gemm_phase<pg8::EpiF8A, pg8::StaticOrder, PG8_ALIGN, PG8_SP2F8, 1>(lds, g, S, E); }
        __syncthreads();
        REP(32) { hy::f2* KSb = KSall + (size_t)bx * 2 * hy::NF; const hy::Tw tw = hy::make_tw(tid);
          for (int c = vcu; c < HYW; c += G) hy::hyena_channel((LAS hy::f2*)lds, tid, c, HyT, (const bf16*)FiltT, hy_conv_w, hy_conv_b, hy_bias, KSb, YT, tw); }
        if (BOTH(3)) GRID_BAR();
    }

    if (IN(4)) {
        PHASE_IDS();
        REP(40) {
            LAS float* GQ = (LAS float*)lds; LAS float* GK = GQ + 192;
            LAS hy::f2* ROPE = (LAS hy::f2*)(lds + 2048);
            LAS unsigned char* VT = lds + 20480;
            for (int i = tid; i < 192; i += 512) { GQ[i] = q_norm_g[i]; GK[i] = k_norm_g[i]; }
            for (int i = tid; i < 2048; i += 512) { const float ang = (float)(i >> 4) * powf(10000.0f, -(float)(i & 15) / 16.0f); ROPE[i] = (hy::f2){cosf(ang), sinf(ang)}; }
            __syncthreads();
#define SUM16(v) do { v += __int_as_float(__builtin_amdgcn_update_dpp(0, __float_as_int(v), 0xB1, 0xf, 0xf, true)); v += __int_as_float(__builtin_amdgcn_update_dpp(0, __float_as_int(v), 0x4E, 0xf, 0xf, true)); \
                      v += __int_as_float(__builtin_amdgcn_update_dpp(0, __float_as_int(v), 0x124, 0xf, 0xf, true)); v += __int_as_float(__builtin_amdgcn_update_dpp(0, __float_as_int(v), 0x128, 0xf, 0xf, true)); } while (0)
            const int hl = lane >> 4, sub = lane & 15;
            float gk8[8], gk4[4], gq8[8], gq4[4];
#pragma unroll
            for (int i = 0; i < 8; ++i) { gk8[i] = GK[8 * sub + i]; gq8[i] = GQ[8 * sub + i]; }
#pragma unroll
            for (int j = 0; j < 4; ++j) { gk4[j] = GK[128 + 4 * sub + j]; gq4[j] = GQ[128 + 4 * sub + j]; }
            LAS float* STAT = (LAS float*)(lds + 57344) + wave * 16;
            int stat_tile = -1;
            const int nit = (G == 256) ? 4 + ((vcu & 7) == 0 ? 1 : 0) : 0;
            for (int n = 0; n < nit; ++n) {
                int hq, b, kt;
                if (n < 4) { hq = n; b = vcu >> 7; kt = 4 + (vcu & 127); } else { const int ci = vcu >> 3; hq = ci & 3; b = ci >> 4; kt = (ci >> 2) & 3; }
                const int tile = b * 132 + kt, h = hq * 4 + hl;
                const bool lat = kt >= 4;
                if (tile != stat_tile) { stat_tile = tile;
#pragma unroll 1
                    for (int e = 0; e < 8; ++e) {
                        const int key = kt * 64 + wave * 8 + e, t = key - LCTX; const int m = lat ? b * SEQ + t : MTOK + b * LCTX + key;
                        float rs_kv, rs_q = 0.f;
                        { typedef unsigned u32x2 __attribute__((ext_vector_type(2))); typedef float f32x2 __attribute__((ext_vector_type(2)));
                          const u32x2 v = *(const u32x2*)((const unsigned char*)KVA + (size_t)m * KVLORA + lane * 8); float s = 0.f;
#pragma unroll
                          for (int i = 0; i < 2; ++i) { const f32x2 a = __builtin_amdgcn_cvt_pk_f32_fp8((int)v[i], false), c = __builtin_amdgcn_cvt_pk_f32_fp8((int)v[i], true); s += (a.x * a.x + a.y * a.y) + (c.x * c.x + c.y * c.y); }
                          rs_kv = 1.0f / sqrtf(wave_sum(s) * (1.f / KVLORA) + EPS);
                          if (lat) { const v4u q = *(const v4u*)((const unsigned char*)QA + (size_t)m * QLORA + lane * 16); float s2 = 0.f;
#pragma unroll
                            for (int i = 0; i < 4; ++i) { const f32x2 a = __builtin_amdgcn_cvt_pk_f32_fp8((int)q[i], false), c = __builtin_amdgcn_cvt_pk_f32_fp8((int)q[i], true); s2 += (a.x * a.x + a.y * a.y) + (c.x * c.x + c.y * c.y); }
                            rs_q = 1.0f / sqrtf(wave_sum(s2) * (1.f / QLORA) + EPS); } }
                        if (lane == 0) { STAT[2 * e] = rs_kv; STAT[2 * e + 1] = rs_q; }
                    }
                    LDS_WAIT(); asm volatile("" ::: "memory");
                }
#pragma unroll 2
                for (int e = 0; e < 8; ++e) {
                    const int ki = wave * 8 + e, key = kt * 64 + ki, t = key - LCTX;
                    const int m = lat ? b * SEQ + t : MTOK + b * LCTX + key;
                    const float rs_kv = STAT[2 * e], rs_q = STAT[2 * e + 1];
                    float cs[4], sn[4];
#pragma unroll
                    for (int j = 0; j < 4; ++j) { cs[j] = 1.f; sn[j] = 0.f; }
                    if (lat) { const int pos = (sub >> 3) ? (t & 63) : (t >> 6);
#pragma unroll
                        for (int j = 0; j < 4; ++j) { const hy::f2 r = ROPE[pos * 16 + 4 * (sub & 3) + j]; cs[j] = r.x; sn[j] = (sub & 4) ? r.y : -r.y; } }
                    const f32x4 kr = *(const f32x4*)(KR + (size_t)m * 64 + 4 * sub);
                    float ss_r = (kr.x * kr.x + kr.y * kr.y) + (kr.z * kr.z + kr.w * kr.w); SUM16(ss_r);
                    typedef unsigned u32x2 __attribute__((ext_vector_type(2))); typedef float f32x2 __attribute__((ext_vector_type(2)));
                    const unsigned char* kvr = (const unsigned char*)KVraw + (size_t)m * 4096 + h * 256 + 8 * sub;
                    const u32x2 kn8 = *(const u32x2*)kvr, v8 = *(const u32x2*)(kvr + 128);
                    float kn[8], vv[8], ssk = 0.f;
#pragma unroll
                    for (int i = 0; i < 2; ++i) { const f32x2 a = __builtin_amdgcn_cvt_pk_f32_fp8((int)kn8[i], false), c = __builtin_amdgcn_cvt_pk_f32_fp8((int)kn8[i], true), d = __builtin_amdgcn_cvt_pk_f32_fp8((int)v8[i], false), f = __builtin_amdgcn_cvt_pk_f32_fp8((int)v8[i], true);
                        kn[4 * i] = a.x; kn[4 * i + 1] = a.y; kn[4 * i + 2] = c.x; kn[4 * i + 3] = c.y; vv[4 * i] = d.x; vv[4 * i + 1] = d.y; vv[4 * i + 2] = f.x; vv[4 * i + 3] = f.y; }
#pragma unroll
                    for (int i = 0; i < 8; ++i) { kn[i] *= rs_kv; vv[i] *= rs_kv; ssk += kn[i] * kn[i]; }
                    SUM16(ssk);
                    const float rk = 1.0f / sqrtf((ssk + ss_r) * (1.f / 192.f) + EPS);
                    float kx[4] = {kr.x, kr.y, kr.z, kr.w};
#pragma unroll
                    for (int j = 0; j < 4; ++j) { kx[j] = kx[j] * rk * gk4[j]; const float px = __int_as_float(__builtin_amdgcn_ds_swizzle(__float_as_int(kx[j]), (4 << 10) | 0x1f)); kx[j] = kx[j] * cs[j] + px * sn[j]; }
#pragma unroll
                    for (int i = 0; i < 8; ++i) kn[i] = kn[i] * rk * gk8[i];
                    unsigned char* kd = (unsigned char*)Kb + ((size_t)(b * NHEAD + h) * SKEYS + key) * 192;
                    { typedef unsigned u32x2 __attribute__((ext_vector_type(2))); u32x2 w; w.x = f8pack(kn[0], kn[1], kn[2], kn[3]); w.y = f8pack(kn[4], kn[5], kn[6], kn[7]);
                      *(u32x2*)(kd + 8 * sub) = w; *(unsigned*)(kd + 128 + 4 * sub) = f8pack(kx[0], kx[1], kx[2], kx[3]); }
                    { const int k5 = ki & 31, slot = 32 * ((k5 >> 2) & 1) + 16 * (ki >> 5) + (k5 & 3) + 4 * (k5 >> 3);
                      const unsigned w0 = f8pack(vv[0], vv[1], vv[2], vv[3]), w1 = f8pack(vv[4], vv[5], vv[6], vv[7]);
                      LAS unsigned char* vd = VT + hl * 8704 + sub * 68 + slot;
#pragma unroll
                      for (int i = 0; i < 4; ++i) { vd[i * 1088] = (unsigned char)(w0 >> (8 * i)); vd[(4 + i) * 1088] = (unsigned char)(w1 >> (8 * i)); } }
                    if (lat) {
                        const unsigned char* qrp = (const unsigned char*)Qraw + (size_t)m * 3072 + h * 192;
                        const u32x2 q8 = *(const u32x2*)(qrp + 8 * sub); const unsigned q4 = *(const unsigned*)(qrp + 128 + 4 * sub);
                        float qn[8], qx[4], ssq = 0.f;
#pragma unroll
                        for (int i = 0; i < 2; ++i) { const f32x2 a = __builtin_amdgcn_cvt_pk_f32_fp8((int)q8[i], false), c = __builtin_amdgcn_cvt_pk_f32_fp8((int)q8[i], true); qn[4 * i] = a.x; qn[4 * i + 1] = a.y; qn[4 * i + 2] = c.x; qn[4 * i + 3] = c.y; }
                        { const f32x2 a = __builtin_amdgcn_cvt_pk_f32_fp8((int)q4, false), c = __builtin_amdgcn_cvt_pk_f32_fp8((int)q4, true); qx[0] = a.x; qx[1] = a.y; qx[2] = c.x; qx[3] = c.y; }
#pragma unroll
                        for (int i = 0; i < 8; ++i) { qn[i] *= rs_q; ssq += qn[i] * qn[i]; }
#pragma unroll
                        for (int j = 0; j < 4; ++j) { qx[j] *= rs_q; ssq += qx[j] * qx[j]; }
                        SUM16(ssq);
                        const float rq = 1.0f / sqrtf(ssq * (1.f / 192.f) + EPS);
#pragma unroll
                        for (int j = 0; j < 4; ++j) { qx[j] = qx[j] * rq * gq4[j]; const float px = __int_as_float(__builtin_amdgcn_ds_swizzle(__float_as_int(qx[j]), (4 << 10) | 0x1f)); qx[j] = qx[j] * cs[j] + px * sn[j]; }
#pragma unroll
                        for (int i = 0; i < 8; ++i) qn[i] = qn[i] * rq * gq8[i];
                        unsigned char* qd = (unsigned char*)Qb + ((size_t)(b * NHEAD + h) * SEQ + t) * 192;
                        typedef unsigned u32x2 __attribute__((ext_vector_type(2))); u32x2 w; w.x = f8pack(qn[0], qn[1], qn[2], qn[3]); w.y = f8pack(qn[4], qn[5], qn[6], qn[7]);
                        *(u32x2*)(qd + 8 * sub) = w; *(unsigned*)(qd + 128 + 4 * sub) = f8pack(qx[0], qx[1], qx[2], qx[3]);
                    }
                }
                __syncthreads();
#pragma unroll
                for (int j = 0; j < 4; ++j) { const int id = tid + 512 * j, hh = id >> 9, within = id & 511;
                    const int col = within >> 2; const LAS unsigned* src = (const LAS unsigned*)(VT + hh * 8704 + ((col & 7) * 16 + (col >> 3)) * 68 + (within & 3) * 16);
                    *(v4u*)((unsigned char*)Vb + ((size_t)((b * NHEAD + hq * 4 + hh) * 132 + kt)) * 8192 + within * 16) = (v4u){src[0], src[1], src[2], src[3]}; }
                __syncthreads();
            }
#undef SUM16
        }
        REP(41) {
            LAS unsigned short* T = (LAS unsigned short*)(lds + 4096 + wave * 8704);
            for (int it = gw; it < 32 * 256; it += NGW) {
                const int c0 = (it & 31) * 64, tk0 = (it >> 5) * 64;
#pragma unroll 8
                for (int i = 0; i < 64; ++i) T[i * 66 + lane] = YT[(size_t)(c0 + i) * MTOK + tk0 + lane];
                LDS_WAIT(); asm volatile("" ::: "memory");
#pragma unroll 8
                for (int j = 0; j < 64; ++j) MIX[(size_t)(tk0 + j) * MIXLD + c0 + lane] = T[lane * 66 + j];
                LDS_WAIT(); asm volatile("" ::: "memory");
            }
        }
        if (BOTH(4)) GRID_BAR();
    }

    if (IN(5)) {
        PHASE_IDS();
        REP(5) for (int u = vcu; u < NB * NHEAD * (SEQ / 256); u += G) {
            const int bh = u >> 5, qb = u & 31, b = bh >> 4, h = bh & 15;
            att8::attn_unit((const unsigned char*)Qb + ((size_t)bh * SEQ + qb * 256) * 192, (const unsigned char*)Kb + (size_t)bh * SKEYS * 192, (const unsigned char*)Vb + (size_t)bh * SKEYS * 128,
                            (unsigned char*)MIX + ((size_t)b * SEQ + qb * 256) * (2 * MIXLD) + 2 * HYW + h * 128, SKEYS, (char*)lds_raw);
        }
        if (BOTH(5)) GRID_BAR();
    }

    if (IN(6)) {
        PHASE_IDS();
        REP(6) { pg8::Gemm g{MIX, WoutT, MTOK, DM, MIXLD, HYW / 64}; pg8::StaticOrder S; S.init(MTOK, DM, G, bx); pg8::EpiResGate E{x_in, out_p, MODS + 2 * DM, DM, 1.0f};
        pg8::gemm_phase<pg8::EpiResGate, pg8::StaticOrder, PG8_ALIGN, PG8_SP2F8, 3>(lds, g, S, E); }
        if (BOTH(6)) GRID_BAR();
    }

    if (IN(7) && DUP_ID != 100) {
        PHASE_IDS();
        REP(7) {
        LAS float* SH = (LAS float*)lds; LAS float* SC = (LAS float*)(lds + 32768); LAS float* GN = (LAS float*)(lds + 65536);
        for (int i = tid; i < 2 * DM; i += 512) { const int r = i / DM, col = i % DM; SH[i] = MODS[(size_t)r * NMODC + 3 * DM + col]; SC[i] = MODS[(size_t)r * NMODC + 4 * DM + col]; }
        for (int i = tid; i < DM; i += 512) GN[i] = norm2_g[i];
        __syncthreads();
        for (int m = gw; m < MTOK; m += NGW) { const int r = m / SEQ; modulate_row_mx6(out_p + (size_t)m * DM, (unsigned char*)H2 + (size_t)m * DM, GN, SH + r * DM, SC + r * DM, lane); }
        __syncthreads();
        }
        if (BOTH(7)) GRID_BAR();
    }

    if (IN(8) && DUP_ID != 100) {
        PHASE_IDS();
        REP(8) { pg8::Gemm g{H2, W1T, MTOK, FF, DM / 2}; pg8::StaticOrder S; S.init(MTOK, FF, G, bx); pg8::EpiF8Relu2 E{(unsigned char*)HID, FF, 1.0f};
        if (DUP_ID == 8 && GEXP != 0 && rep_ == 0) pg8::gemm_phase<pg8::EpiF8Relu2, pg8::StaticOrder, PG8_ALIGN, PG8_SP2F8, 2, GEXP>(lds, g, S, E); else
        pg8::gemm_phase<pg8::EpiF8Relu2, pg8::StaticOrder, PG8_ALIGN, PG8_SP2F8, 2>(lds, g, S, E); }
        if (BOTH(8)) GRID_BAR();
    }

    if (IN(9) && DUP_ID != 100) {
        PHASE_IDS();
        REP(9) { float* o9 = (DUP_ID == 9 && rep_ == 0) ? (float*)(ws + WS_WIN) : out_p;
        pg8::Gemm g{HID, W2T, MTOK, DM, FF / 2}; pg8::StaticOrder S; S.init(MTOK, DM, G, bx); pg8::EpiResGate E{out_p, o9, MODS + 5 * DM, DM, 1.0f / W2SCALE};
        if (DUP_ID == 9 && GEXP != 0 && rep_ == 0) pg8::gemm_phase<pg8::EpiResGate, pg8::StaticOrder, PG8_ALIGN, PG8_SP2F8, 1, GEXP>(lds, g, S, E); else
        pg8::gemm_phase<pg8::EpiResGate, pg8::StaticOrder, PG8_ALIGN, PG8_SP2F8, 1>(lds, g, S, E); }
    }
#undef PHASE_IDS
#undef IN
#undef BOTH
#undef GRID_BAR
#undef x_in
#undef cvec
#undef ctx
#undef c_ctx
#undef norm1_g
#undef norm2_g
#undef w_ada
#undef b_ada
#undef w_in
#undef hy_conv_w
#undef hy_conv_b
#undef hy_w1
#undef hy_b1
#undef hy_w2
#undef hy_b2
#undef hy_w3
#undef hy_freq
#undef hy_bias
#undef g_qa
#undef w_qb
#undef g_kva
#undef w_kvb
#undef q_norm_g
#undef k_norm_g
#undef w_out
#undef w_mlp1
#undef w_mlp2
#undef out_p
#undef MODP
#undef MODS
#undef TW1
#undef TW2
#undef W1T
#undef W2T
#undef WinT
#undef WinT8
#undef H8
#undef WqbT
#undef WkvbT
#undef Hh
#undef FiltT
#undef Hb
#undef HyT
#undef QA
#undef KVA
#undef KR
#undef Qraw
#undef KVraw
#undef YT
#undef KSall
#undef Qb
#undef Kb
#undef Vb
#undef MIX
#undef WoutT
#undef H2
#undef HID
}

extern "C" void kernel_launch(void* const* d_in, const int* in_sizes, int n_in, void* d_out, int out_size, void* d_ws, size_t ws_size, hipStream_t stream) {
    static int grid = 0;
    if (grid == 0) {
        if (n_in != 27 || out_size != MTOK * DM || ws_size < WS_END) { fprintf(stderr, "kernel_launch: unexpected shapes: n_in %d out %d ws %zu (need %zu)\n", n_in, out_size, ws_size, (size_t)WS_END); grid = -1; return; }
        int dev = 0, cus = 0, per_cu = 0;
        if (hipGetDevice(&dev) != hipSuccess || hipDeviceGetAttribute(&cus, hipDeviceAttributeMultiprocessorCount, dev) != hipSuccess) { grid = -1; return; }
        if (hipFuncSetAttribute((const void*)mega_fwd, hipFuncAttributeMaxDynamicSharedMemorySize, LDS_BYTES) != hipSuccess) { fprintf(stderr, "kernel_launch: hipFuncSetAttribute failed\n"); grid = -1; return; }
        if (hipOccupancyMaxActiveBlocksPerMultiprocessor(&per_cu, (const void*)mega_fwd, NWAVES * 64, LDS_BYTES) != hipSuccess || per_cu < 1) { fprintf(stderr, "kernel_launch: occupancy query reports %d\n", per_cu); }
        (void)hipGetLastError();
        if (cus != 256) { fprintf(stderr, "kernel_launch: built for 256 CUs (several phases deal their work in fixed per-workgroup shares of a 256-workgroup grid); this device has %d; nothing launched\n", cus); grid = -1; return; }
        grid = cus;
    }
    if (grid < 0) return;
    if (hipMemsetAsync((char*)d_ws + WS_CTL, 0, CTL_ZERO_BYTES, stream) != hipSuccess) return;
    Args a{};
    for (int i = 0; i < 27; ++i) a.in[i] = (const float*)d_in[i];
    a.out = (float*)d_out; a.ws = (unsigned char*)d_ws;
    for (int li = 0; li < N_LAUNCHES; ++li) {
        a.ph_lo = (N_LAUNCHES == 1) ? 0 : li; a.ph_hi = (N_LAUNCHES == 1) ? N_PHASES : li + 1; a.li = li; a.pad = 0;
        hipLaunchKernelGGL(mega_fwd, dim3(grid), dim3(NWAVES * 64), LDS_BYTES, stream, a);
        const hipError_t le = hipPeekAtLastError();
        if (le != hipSuccess) { fprintf(stderr, "kernel_launch: launch %d failed: %s\n", li, hipGetErrorName(le)); break; }
    }
}
```
